# Optimizing an MI355X kernel written in HIP

```python
import math
import jax, jax.numpy as jnp
from jax import lax
import numpy as np

D_MODEL = 2048
BATCH = 1
SEQ = 8192
DEPTH = 4

HEAD_DIM = 64
A_HEADS = 12
A_KV_HEADS = 4
WINDOW = 128
A_BLOCK = 128
B_HEADS = 4
B_DK = 128
B_DV = 128
B_CHUNK = 16
C_HEADS = 12
C_KV_HEADS = 4
C_BLOCK = 128
ROPE_THETA = 10000.0
GRID_W = 64
REL_BUCKETS = 32
REL_MAX_DIST = 128
D_FF = 5632
EPS = 1e-6
NEG = -1e30

A_Q = A_HEADS * HEAD_DIM
A_KV = A_KV_HEADS * HEAD_DIM
B_W = B_HEADS * B_DK
B_VW = B_HEADS * B_DV
C_Q = C_HEADS * HEAD_DIM
C_KV = C_KV_HEADS * HEAD_DIM
IN_SPLITS = [A_Q, A_KV, A_KV, B_W, B_W, B_W, B_VW, B_VW, C_Q, C_KV, C_KV]
D_IN = sum(IN_SPLITS)
D_MIX = A_Q + B_VW + C_Q

kernel_name = "hymba_style_bidir_hybrid_encoder"


def rms_norm(x, w):
    xf = x.astype(jnp.float32)
    y = xf * lax.rsqrt(jnp.mean(xf * xf, axis=-1, keepdims=True) + EPS)
    return (y * w.astype(jnp.float32)).astype(x.dtype)


def swiglu(x, wg, wu, wd):
    return (jax.nn.silu(x @ wg) * (x @ wu)) @ wd


def t5_bucket(rel):
    nb = REL_BUCKETS // 2
    max_exact = nb // 2
    n = jnp.abs(rel)
    nf = jnp.maximum(n, 1).astype(jnp.float32)
    large = max_exact + (jnp.log(nf / max_exact) / math.log(REL_MAX_DIST / max_exact)
                         * (nb - max_exact)).astype(jnp.int32)
    large = jnp.minimum(large, nb - 1)
    return jnp.where(rel > 0, nb, 0) + jnp.where(n < max_exact, n, large)


def axial_rope_tables(L):
    rows = L // GRID_W
    half = HEAD_DIM // 2
    inv = 1.0 / (ROPE_THETA ** (jnp.arange(0, half, 2, dtype=jnp.float32) / half))
    nf = inv.shape[0]
    row_ang = jnp.arange(rows, dtype=jnp.float32)[:, None] * inv
    col_ang = jnp.arange(GRID_W, dtype=jnp.float32)[:, None] * inv
    ang = jnp.concatenate([jnp.broadcast_to(row_ang[:, None, :], (rows, GRID_W, nf)),
                           jnp.broadcast_to(col_ang[None, :, :], (rows, GRID_W, nf))], axis=-1)
    ang = ang.reshape(L, 2 * nf)
    return jnp.cos(ang), jnp.sin(ang)


def apply_rope(x, cos, sin):
    xf = x.astype(jnp.float32).reshape(*x.shape[:-1], HEAD_DIM // 2, 2)
    x0, x1 = xf[..., 0], xf[..., 1]
    c = cos[None, :, None, :]
    s = sin[None, :, None, :]
    out = jnp.stack([x0 * c - x1 * s, x0 * s + x1 * c], axis=-1).reshape(x.shape)
    return out.astype(x.dtype)


def band_windows(t):
    B_, L = t.shape[0], t.shape[1]
    nb = L // A_BLOCK
    tp = jnp.pad(t, ((0, 0), (A_BLOCK, A_BLOCK), (0, 0), (0, 0)))
    tp = tp.reshape(B_, nb + 2, A_BLOCK, *t.shape[2:])
    return jnp.concatenate([tp[:, :-2], tp[:, 1:-1], tp[:, 2:]], axis=2)


def windowed_attention(q, k, v, sink, bias, valid):
    B_, L, _ = q.shape
    nb = L // A_BLOCK
    G = A_HEADS // A_KV_HEADS
    qb = q.reshape(B_, nb, A_BLOCK, A_KV_HEADS, G, HEAD_DIM)
    kw = band_windows(k.reshape(B_, L, A_KV_HEADS, HEAD_DIM))
    vw = band_windows(v.reshape(B_, L, A_KV_HEADS, HEAD_DIM))
    s = jnp.einsum('bnqkgd,bnskd->bnkgqs', qb, kw,
                   preferred_element_type=jnp.float32) * (HEAD_DIM ** -0.5)
    s = jnp.where(valid[None, :, None, None], s + bias, NEG)
    sink_col = jnp.broadcast_to(sink.astype(jnp.float32).reshape(A_KV_HEADS, G, 1, 1),
                                s.shape[:-1] + (1,))
    p = jax.nn.softmax(jnp.concatenate([s, sink_col], axis=-1), axis=-1)[..., :-1]
    o = jnp.einsum('bnkgqs,bnskd->bnqkgd', p.astype(v.dtype), vw)
    return o.reshape(B_, L, A_Q)


def chunked_linear_recurrence(q, k, v, log_f):
    B_, L, H, _ = q.shape
    n = L // B_CHUNK

    def chunks(a):
        return a.astype(jnp.float32).reshape(B_, n, B_CHUNK, H, a.shape[-1]).transpose(1, 0, 3, 2, 4)

    qc, kc, vc, gc = chunks(q), chunks(k), chunks(v), chunks(log_f)
    b = jnp.cumsum(gc, axis=-2)
    tri = jnp.tril(jnp.ones((B_CHUNK, B_CHUNK), dtype=bool))
    diff = jnp.where(tri[:, :, None], b[..., :, None, :] - b[..., None, :, :], -jnp.inf)
    att = jnp.einsum('nbhtc,nbhsc,nbhtsc->nbhts', qc, kc, jnp.exp(diff))
    intra = jnp.einsum('nbhts,nbhsv->nbhtv', att, vc)
    b_last = b[..., -1, :]
    chunk_kv = jnp.einsum('nbhsc,nbhsv->nbhcv', kc * jnp.exp(b_last[..., None, :] - b), vc)

    def step(S, inp):
        decay, kv = inp
        return decay[..., None] * S + kv, S

    S0 = jnp.zeros((B_, H, q.shape[-1], v.shape[-1]), jnp.float32)
    _, S_prev = lax.scan(step, S0, (jnp.exp(b_last), chunk_kv))
    inter = jnp.einsum('nbhtc,nbhcv->nbhtv', qc * jnp.exp(b), S_prev)
    return (intra + inter).transpose(1, 0, 3, 2, 4).reshape(B_, L, H, v.shape[-1])


def hgrn2_bidir(q_raw, zf, zb, i_raw, g_raw, lb, gnorm_w):
    B_, L, _ = q_raw.shape
    q = jax.nn.silu(q_raw).reshape(B_, L, B_HEADS, B_DK)
    v = i_raw.reshape(B_, L, B_HEADS, B_DV)

    def gates(z, lbd):
        z = z.astype(jnp.float32)
        lbd = lbd.astype(jnp.float32)
        log_f = jnp.logaddexp(jnp.log(lbd), jnp.log1p(-lbd) + jax.nn.log_sigmoid(z))
        kk = (1.0 - lbd) * jax.nn.sigmoid(-z)
        return (kk.reshape(B_, L, B_HEADS, B_DK), log_f.reshape(B_, L, B_HEADS, B_DK))

    kf, gf = gates(zf, lb[0])
    kb, gb = gates(zb, lb[1])
    o_fwd = chunked_linear_recurrence(q, kf, v, gf)
    flip = lambda a: jnp.flip(a, axis=1)
    o_bwd = flip(chunked_linear_recurrence(flip(q), flip(kb), flip(v), flip(gb)))
    o = rms_norm(o_fwd + o_bwd, gnorm_w) * jax.nn.silu(
        g_raw.astype(jnp.float32).reshape(B_, L, B_HEADS, B_DV))
    return o.reshape(B_, L, B_VW).astype(q_raw.dtype)


def axial_attention(q, k, v, qk_w, cos, sin):
    B_, L, _ = q.shape
    nb = L // C_BLOCK
    G = C_HEADS // C_KV_HEADS
    q = apply_rope(rms_norm(q.reshape(B_, L, C_HEADS, HEAD_DIM), qk_w[0]), cos, sin)
    k = apply_rope(rms_norm(k.reshape(B_, L, C_KV_HEADS, HEAD_DIM), qk_w[1]), cos, sin)
    v = v.reshape(B_, L, C_KV_HEADS, HEAD_DIM)
    qb = q.reshape(B_, nb, C_BLOCK, C_KV_HEADS, G, HEAD_DIM).transpose(1, 0, 2, 3, 4, 5)

    def block(qblk):
        s = jnp.einsum('bqkgd,bskd->bkgqs', qblk, k,
                       preferred_element_type=jnp.float32) * (HEAD_DIM ** -0.5)
        p = jax.nn.softmax(s, axis=-1)
        return jnp.einsum('bkgqs,bskd->bqkgd', p.astype(v.dtype), v)

    o = lax.map(block, qb)
    return o.transpose(1, 0, 2, 3, 4, 5).reshape(B_, L, C_Q)


def token_mix(h, w_in, w_out, sink, qk_w, lb, gnorm_w, bias, valid, cos, sin):
    proj = h @ w_in
    cuts = [int(c) for c in np.cumsum(IN_SPLITS)[:-1]]
    aq, ak, av, bq, bzf, bzb, bi, bg, cq, ck, cv = jnp.split(proj, cuts, axis=-1)
    ya = windowed_attention(aq, ak, av, sink, bias, valid)
    yb = hgrn2_bidir(bq, bzf, bzb, bi, bg, lb, gnorm_w)
    yc = axial_attention(cq, ck, cv, qk_w, cos, sin)
    return jnp.concatenate([ya, yb, yc], axis=-1) @ w_out


def setup_inputs(seed: int = 0) -> dict:
    key = jax.random.key(seed)
    ks = jax.random.split(key, 16)
    f32 = jnp.float32

    def nrm(k, shape, scale):
        return jax.random.normal(k, shape, f32) * scale

    return {
        "x": nrm(ks[0], (BATCH, SEQ, D_MODEL), 1.0),
        "w_in": nrm(ks[1], (DEPTH, D_MODEL, D_IN), D_MODEL ** -0.5),
        "w_out": nrm(ks[2], (DEPTH, D_MIX, D_MODEL), D_MIX ** -0.5),
        "ffn1_gate": nrm(ks[3], (DEPTH, D_MODEL, D_FF), D_MODEL ** -0.5),
        "ffn1_up": nrm(ks[4], (DEPTH, D_MODEL, D_FF), D_MODEL ** -0.5),
        "ffn1_down": nrm(ks[5], (DEPTH, D_FF, D_MODEL), D_FF ** -0.5),
        "ffn2_gate": nrm(ks[6], (DEPTH, D_MODEL, D_FF), D_MODEL ** -0.5),
        "ffn2_up": nrm(ks[7], (DEPTH, D_MODEL, D_FF), D_MODEL ** -0.5),
        "ffn2_down": nrm(ks[8], (DEPTH, D_FF, D_MODEL), D_FF ** -0.5),
        "norm_w": 1.0 + nrm(ks[9], (DEPTH, 6, D_MODEL), 0.02),
        "sink_logits": nrm(ks[10], (DEPTH, A_HEADS), 0.5),
        "qk_norm_w": 1.0 + nrm(ks[11], (DEPTH, 2, HEAD_DIM), 0.02),
        "hgrn_lb": nrm(ks[12], (DEPTH, 2, B_W), 0.1),
        "hgrn_norm_w": 1.0 + nrm(ks[13], (DEPTH, B_DV), 0.02),
        "rel_bias": nrm(ks[14], (REL_BUCKETS, A_HEADS), 0.1),
    }


def reference(x, w_in, w_out, ffn1_gate, ffn1_up, ffn1_down, ffn2_gate, ffn2_up, ffn2_down,
              norm_w, sink_logits, qk_norm_w, hgrn_lb, hgrn_norm_w, rel_bias):
    B_, L, _ = x.shape
    nb = L // A_BLOCK
    G = A_HEADS // A_KV_HEADS
    qi = jnp.arange(A_BLOCK)[:, None]
    sj = jnp.arange(3 * A_BLOCK)[None, :]
    rel = sj - A_BLOCK - qi
    band = jnp.abs(rel) <= WINDOW
    key_abs = (jnp.arange(nb)[:, None] - 1) * A_BLOCK + jnp.arange(3 * A_BLOCK)[None, :]
    in_range = (key_abs >= 0) & (key_abs < L)
    valid = band[None] & in_range[:, None, :]
    bias = rel_bias.astype(jnp.float32)[t5_bucket(rel)]
    bias = bias.transpose(2, 0, 1).reshape(A_KV_HEADS, G, A_BLOCK, 3 * A_BLOCK)
    cos, sin = axial_rope_tables(L)
    lb_c = jnp.cumsum(jax.nn.softmax(hgrn_lb.astype(jnp.float32), axis=0), axis=0)
    lbs = lb_c - lb_c[0:1]
    for l in range(DEPTH):
        h = rms_norm(x, norm_w[l, 0])
        x = x + 0.5 * rms_norm(swiglu(h, ffn1_gate[l], ffn1_up[l], ffn1_down[l]), norm_w[l, 1])
        h = rms_norm(x, norm_w[l, 2])
        y = token_mix(h, w_in[l], w_out[l], sink_logits[l], qk_norm_w[l], lbs[l],
                      hgrn_norm_w[l], bias, valid, cos, sin)
        x = x + rms_norm(y, norm_w[l, 3])
        h = rms_norm(x, norm_w[l, 4])
        x = x + 0.5 * rms_norm(swiglu(h, ffn2_gate[l], ffn2_up[l], ffn2_down[l]), norm_w[l, 5])
    return x
```

```cpp
#include <hip/hip_runtime.h>
#include <hip/hip_bf16.h>
#include <cstdio>
#include <cstdint>
#include <cmath>
namespace pg8 {
#define PG8_LAS __attribute__((address_space(3)))
typedef unsigned short bf16_t;
typedef short bf16x8 __attribute__((ext_vector_type(8)));
typedef float f32x4 __attribute__((ext_vector_type(4)));
typedef unsigned u32x4 __attribute__((ext_vector_type(4)));
constexpr int BM = 256, BK = 64, HALF = 128, HTB = HALF * BK * 2  , STAGE_BYTES = 8 * HTB, NXCD = 8, WGM = 8;

__host__ __device__ __forceinline__ int lds_byte(int r, int c) { const int st = (r >> 4) * 2 + (c >> 5), rr = r & 15, cc = c & 31, ob = rr * 64 + cc * 2; return st * 1024 + (ob ^ (((ob >> 9) & 1) << 5)); }
__host__ __device__ __forceinline__ void stage_rc(int b, int& R, int& C) { const int st = b / 1024, sb = b % 1024, swz = sb ^ (((sb >> 9) & 1) << 5); R = (st >> 1) * 16 + swz / 64; C = (st & 1) * 32 + (swz % 64) / 2; }
__host__ __device__ __forceinline__ int perm32(int rho) { const int n = rho >> 4, i = rho & 15; return 8 * (i >> 2) + 4 * n + (i & 3); }

struct Unit { int pm, pn; };
struct Gemm { const bf16_t* A; const bf16_t* Bt; int M, N, K; };

struct StaticOrder {
    int nM, nN, nwg, G, c;
    __host__ __device__ void init(int M, int N, int G_, int c_) { nM = M / BM; nN = N / BM; nwg = nM * nN; G = G_; c = c_; }
    __host__ __device__ bool next(int i, Unit& u) const {
        const long L = (long)i * G + c; if (L >= nwg) return false;
        int wgid = (int)L; { const int q = nwg / NXCD, r = nwg % NXCD, xcd = wgid % NXCD, off = wgid / NXCD; wgid = (xcd < r ? xcd * (q + 1) : r * (q + 1) + (xcd - r) * q) + off; }
        const int nig = WGM * nN, gid = wgid / nig, fm = gid * WGM, gsz = (nM - fm) < WGM ? (nM - fm) : WGM;
        u.pm = fm + ((wgid % nig) % gsz); u.pn = (wgid % nig) / gsz; return true;
    }
    __device__ __forceinline__ void a_ready(const Unit&) const {}
    __device__ __forceinline__ void done(const Unit&) const {}
};

__device__ __forceinline__ unsigned cvt_pk_bf16(float lo, float hi) { unsigned r; asm volatile("v_cvt_pk_bf16_f32 %0, %1, %2" : "=v"(r) : "v"(lo), "v"(hi)); return r; }
typedef float f32x2 __attribute__((ext_vector_type(2)));
constexpr float LOG2E = 1.4426950408889634f;
constexpr float QSCALE = 0.125f * 1.4426950408889634f;
__device__ __forceinline__ float sigmoid_f(float x) { return __builtin_amdgcn_rcpf(1.0f + __builtin_amdgcn_exp2f(-LOG2E * x)); }

struct EpiF32 {
    static constexpr bool PERM = false, AFTER_DRAIN = false;
    float* C; int ldc;
    __device__ __forceinline__ void operator()(const f32x4 (&acc)[2][2][4][2], const Unit& u, int wr, int wc, int fr, int fq) const {
        const int row0 = u.pm * BM + wr * 64 + fr, col0 = u.pn * BM + wc * 32 + 4 * fq;
#pragma unroll
        for (int ai = 0; ai < 2; ++ai)
#pragma unroll
            for (int m = 0; m < 4; ++m) { float* rowp = C + (size_t)(row0 + ai * HALF + m * 16) * ldc + col0;
#pragma unroll
                for (int bj = 0; bj < 2; ++bj)
#pragma unroll
                    for (int n = 0; n < 2; ++n) *(f32x4*)(rowp + bj * HALF + n * 16) = acc[ai][bj][m][n]; }
    }
};

struct EpiSwiGLU {
    static constexpr bool PERM = true, AFTER_DRAIN = false;
    bf16_t* O; int ldc;
    __device__ __forceinline__ void operator()(const f32x4 (&acc)[2][2][4][2], const Unit& u, int wr, int wc, int fr, int fq) const {
        const int row0 = u.pm * BM + wr * 64 + fr, col0 = u.pn * HALF + wc * 32 + 8 * fq;
#pragma unroll
        for (int ai = 0; ai < 2; ++ai)
#pragma unroll
            for (int m = 0; m < 4; ++m) { bf16_t* rowp = O + (size_t)(row0 + ai * HALF + m * 16) * ldc + col0;
                float o[8];
#pragma unroll
                for (int n = 0; n < 2; ++n)
#pragma unroll
                    for (int i = 0; i < 4; ++i) { const float g = acc[ai][0][m][n][i], up = acc[ai][1][m][n][i]; o[4 * n + i] = g * sigmoid_f(g) * up; }
                u32x4 w; w.x = cvt_pk_bf16(o[0], o[1]); w.y = cvt_pk_bf16(o[2], o[3]); w.z = cvt_pk_bf16(o[4], o[5]); w.w = cvt_pk_bf16(o[6], o[7]);
                *(u32x4*)rowp = w; }
    }
};

struct EpiWin {
    static constexpr bool PERM = true, AFTER_DRAIN = false;
    bf16_t *AQ, *AK, *AV, *CQ, *CK, *CV;
    float *BQ, *KF, *FF, *KB, *FB, *BI, *SG;
    const float* lb;
    const float* qkw;
    const float* rtab; const float* ctab;
    __device__ __forceinline__ void operator()(const f32x4 (&acc)[2][2][4][2], const Unit& u, int wr, int wc, int fr, int fq) const {
        const int pn = u.pn, row0 = u.pm * BM + wr * 64 + fr, cl = wc * 32 + 8 * fq;
        if (pn < 5 || pn == 19) {
            bf16_t* base; int ldc, colt; float sc = 1.f;
            if (pn < 3) { base = AQ; ldc = 768; colt = pn * 256; sc = QSCALE; } else if (pn == 3) { base = AK; ldc = 256; colt = 0; } else if (pn == 4) { base = AV; ldc = 256; colt = 0; } else { base = CV; ldc = 256; colt = 0; }
#pragma unroll
            for (int ai = 0; ai < 2; ++ai)
#pragma unroll
                for (int m = 0; m < 4; ++m) { bf16_t* rowp = base + (size_t)(row0 + ai * HALF + m * 16) * ldc + colt + cl;
#pragma unroll
                    for (int bj = 0; bj < 2; ++bj) { const f32x4 v0 = acc[ai][bj][m][0] * sc, v1 = acc[ai][bj][m][1] * sc;
                        u32x4 w; w.x = cvt_pk_bf16(v0[0], v0[1]); w.y = cvt_pk_bf16(v0[2], v0[3]); w.z = cvt_pk_bf16(v1[0], v1[1]); w.w = cvt_pk_bf16(v1[2], v1[3]);
                        *(u32x4*)(rowp + bj * HALF) = w; } }
        } else if (pn < 15) {
            const int sec = (pn - 5) >> 1, colt = ((pn - 5) & 1) * 256;
            float* o1 = sec == 0 ? BQ : sec == 1 ? KF : sec == 2 ? KB : sec == 3 ? BI : SG;
            float* o2 = sec == 1 ? FF : FB;
            const float* lbp = lb + (sec == 2 ? 512 : 0);
#pragma unroll
            for (int bj = 0; bj < 2; ++bj) {
                const int col = colt + bj * HALF + cl;
                f32x4 lv0 = (f32x4){0.f, 0.f, 0.f, 0.f}, lv1 = lv0;
                if (sec == 1 || sec == 2) { lv0 = *(const f32x4*)(lbp + col); lv1 = *(const f32x4*)(lbp + col + 4); }
#pragma unroll
                for (int ai = 0; ai < 2; ++ai)
#pragma unroll
                    for (int m = 0; m < 4; ++m) { const size_t off = (size_t)(row0 + ai * HALF + m * 16) * 512 + col;
                        const f32x4 a0 = acc[ai][bj][m][0], a1 = acc[ai][bj][m][1];
                        if (sec == 0 || sec == 4) { f32x4 r0, r1;
#pragma unroll
                            for (int i = 0; i < 4; ++i) { r0[i] = a0[i] * sigmoid_f(a0[i]); r1[i] = a1[i] * sigmoid_f(a1[i]); }
                            *(f32x4*)(o1 + off) = r0; *(f32x4*)(o1 + off + 4) = r1;
                        } else if (sec == 3) { *(f32x4*)(o1 + off) = a0; *(f32x4*)(o1 + off + 4) = a1;
                        } else { f32x4 k0, k1, f0, f1;
#pragma unroll
                            for (int i = 0; i < 4; ++i) { const float s0 = sigmoid_f(a0[i]), s1 = sigmoid_f(a1[i]), n0 = sigmoid_f(-a0[i]), n1 = sigmoid_f(-a1[i]);
                                f0[i] = lv0[i] + (1.f - lv0[i]) * s0; f1[i] = lv1[i] + (1.f - lv1[i]) * s1; k0[i] = (1.f - lv0[i]) * n0; k1[i] = (1.f - lv1[i]) * n1; }
                            *(f32x4*)(o1 + off) = k0; *(f32x4*)(o1 + off + 4) = k1; *(f32x4*)(o2 + off) = f0; *(f32x4*)(o2 + off + 4) = f1; } }
            }
        } else {
            const bool isq = pn < 18; bf16_t* base = isq ? CQ : CK; const int ldc = isq ? 768 : 256, head = (isq ? (pn - 15) * 4 : 0) + wc;
            const float* w = qkw + (isq ? 0 : 64); const float sc = isq ? QSCALE : 1.f;
            f32x4 wv[2][2];
#pragma unroll
            for (int bj = 0; bj < 2; ++bj)
#pragma unroll
                for (int n = 0; n < 2; ++n) wv[bj][n] = *(const f32x4*)(w + 32 * bj + 8 * fq + 4 * n) * sc;
#pragma unroll
            for (int ai = 0; ai < 2; ++ai)
#pragma unroll
                for (int m = 0; m < 4; ++m) { const int row = row0 + ai * HALF + m * 16;
                    float ss = 0.f;
#pragma unroll
                    for (int bj = 0; bj < 2; ++bj)
#pragma unroll
                        for (int n = 0; n < 2; ++n) { const f32x4 x = acc[ai][bj][m][n]; ss += (x[0] * x[0] + x[1] * x[1]) + (x[2] * x[2] + x[3] * x[3]); }
                    ss += __shfl_xor(ss, 16); ss += __shfl_xor(ss, 32);
                    const float r = 1.0f / sqrtf(ss * (1.0f / 64.0f) + 1e-6f);
                    bf16_t* rowp = base + (size_t)row * ldc + head * 64 + 8 * fq;
#pragma unroll
                    for (int bj = 0; bj < 2; ++bj) { const float* tab = bj == 0 ? rtab + (size_t)(row >> 6) * 32 : ctab + (size_t)(row & 63) * 32;
                        float o[8];
#pragma unroll
                        for (int n = 0; n < 2; ++n) { const f32x4 x = acc[ai][bj][m][n] * r * wv[bj][n]; const f32x4 cs = *(const f32x4*)(tab + (4 * fq + 2 * n) * 2);
                            o[4 * n + 0] = x[0] * cs[0] - x[1] * cs[1]; o[4 * n + 1] = x[0] * cs[1] + x[1] * cs[0];
                            o[4 * n + 2] = x[2] * cs[2] - x[3] * cs[3]; o[4 * n + 3] = x[2] * cs[3] + x[3] * cs[2]; }
                        u32x4 wd; wd.x = cvt_pk_bf16(o[0], o[1]); wd.y = cvt_pk_bf16(o[2], o[3]); wd.z = cvt_pk_bf16(o[4], o[5]); wd.w = cvt_pk_bf16(o[6], o[7]);
                        *(u32x4*)(rowp + 32 * bj) = wd; } }
        }
    }
};
template <class Epi, class Sched, bool ALIGN_EPI = false, bool SP2 = false>
__device__ __forceinline__ void gemm_phase(PG8_LAS unsigned char* lds, const Gemm g, const Sched& S, const Epi& E) {
    int tid_l = threadIdx.x; asm volatile("" : "+v"(tid_l)); const int tid = tid_l, wid = __builtin_amdgcn_readfirstlane(tid >> 6), lane = tid & 63, wr = wid >> 2, wc = wid & 3, fr = lane & 15, fq = lane >> 4;
    const int K = g.K, nt = K / BK;
    unsigned voffA[2], voffB[2];
#pragma unroll
    for (int i = 0; i < 2; ++i) { int R, C; stage_rc(tid * 16 + i * 8192, R, C); const int Rb = Epi::PERM ? ((R & ~31) + perm32(R & 31)) : R;
        voffA[i] = (unsigned)(R * K + C) * 2u; voffB[i] = (unsigned)(Rb * K + C) * 2u; }
    const size_t kstep = (size_t)(BK * 2);
    const size_t hstep = (size_t)HALF * K * 2;
    const size_t tstep = 2 * hstep;
    const unsigned ldsw = (unsigned)wid * 1024u;
    const int aoff = lds_byte(wr * 64 + fr, fq * 8), boff = lds_byte(wc * 32 + fr, fq * 8);
#define PG8_SA(b, h) (((b) * 2 + (h)) * HTB)
#define PG8_SB(b, h) ((4 + (b) * 2 + (h)) * HTB)
#define PG8_STAGE(bufoff, gbase, voff) do { _Pragma("unroll") for (int _i = 0; _i < 2; ++_i) \
        __builtin_amdgcn_global_load_lds((const unsigned*)((const char*)(gbase) + (voff)[_i]), (PG8_LAS unsigned*)(lds + (bufoff) + ldsw + _i * 8192), 16, 0, 0); } while (0)
#define PG8_LDA(dst, b, h) do { _Pragma("unroll") for (int m = 0; m < 4; ++m) _Pragma("unroll") for (int k = 0; k < 2; ++k) dst[m][k] = *(const PG8_LAS bf16x8*)(lds + PG8_SA(b, h) + aoff + m * 2048 + k * 1024); } while (0)
#define PG8_LDB(dst, b, h) do { _Pragma("unroll") for (int n = 0; n < 2; ++n) _Pragma("unroll") for (int k = 0; k < 2; ++k) dst[n][k] = *(const PG8_LAS bf16x8*)(lds + PG8_SB(b, h) + boff + n * 2048 + k * 1024); } while (0)
#define PG8_MMA(ai, bj, At, Bt) do { __builtin_amdgcn_s_setprio(1); _Pragma("unroll") for (int m = 0; m < 4; ++m) _Pragma("unroll") for (int n = 0; n < 2; ++n) _Pragma("unroll") for (int k = 0; k < 2; ++k) \
        acc[ai][bj][m][n] = __builtin_amdgcn_mfma_f32_16x16x32_bf16(Bt[n][k], At[m][k], acc[ai][bj][m][n], 0, 0, 0); __builtin_amdgcn_s_setprio(0); } while (0)
#define PG8_WAIT_V(n) asm volatile("s_waitcnt vmcnt(" #n ")" ::: "memory")
#define PG8_WAIT_L(n) asm volatile("s_waitcnt lgkmcnt(" #n ")" ::: "memory")
#define PG8_BAR __builtin_amdgcn_s_barrier()
#define PG8_SCHED __builtin_amdgcn_sched_barrier(0)
    Unit cur, nxt; int ui = 0;
    if (!S.next(0, cur)) return;
    f32x4 acc[2][2][4][2];
#pragma unroll
    for (int a = 0; a < 2; ++a)
#pragma unroll
        for (int b = 0; b < 2; ++b)
#pragma unroll
            for (int m = 0; m < 4; ++m)
#pragma unroll
                for (int n = 0; n < 2; ++n) acc[a][b][m][n] = (f32x4){0.f, 0.f, 0.f, 0.f};
    bf16x8 At[4][2], B0[2][2], B1[2][2];
    const char* cA = (const char*)g.A + (size_t)cur.pm * tstep; const char* cB = (const char*)g.Bt + (size_t)cur.pn * tstep;
    S.a_ready(cur);
    if constexpr (SP2) {
        PG8_STAGE(PG8_SB(0, 0), cB, voffB); PG8_STAGE(PG8_SB(0, 1), cB + hstep, voffB); PG8_STAGE(PG8_SA(0, 0), cA, voffA); PG8_STAGE(PG8_SA(0, 1), cA + hstep, voffA);
        if (wr == 1) PG8_BAR;
        PG8_WAIT_V(2); PG8_BAR;
        PG8_STAGE(PG8_SB(1, 0), cB + kstep, voffB); PG8_STAGE(PG8_SA(1, 0), cA + kstep, voffA); PG8_STAGE(PG8_SB(1, 1), cB + hstep + kstep, voffB);
        PG8_WAIT_V(6); PG8_BAR;
    } else {
        PG8_STAGE(PG8_SB(0, 0), cB, voffB); PG8_STAGE(PG8_SA(0, 0), cA, voffA); PG8_STAGE(PG8_SB(0, 1), cB + hstep, voffB); PG8_STAGE(PG8_SA(0, 1), cA + hstep, voffA);
        if (wr == 1) PG8_BAR;
        PG8_WAIT_V(4); PG8_BAR;
        PG8_STAGE(PG8_SB(1, 0), cB + kstep, voffB); PG8_STAGE(PG8_SA(1, 0), cA + kstep, voffA); PG8_STAGE(PG8_SB(1, 1), cB + hstep + kstep, voffB);
        PG8_WAIT_V(6); PG8_BAR;
    }
    for (;;) {
        const bool has_next = S.next(ui + 1, nxt);
        const char* nA = has_next ? (const char*)g.A + (size_t)nxt.pm * tstep : cA; const char* nB = has_next ? (const char*)g.Bt + (size_t)nxt.pn * tstep : cB;
        for (int t = 0; t < nt; t += 2) {
            const bool last = (t == nt - 2);
            const char* a1 = cA + (size_t)(t + 1) * kstep;
            const char* a2 = last ? nA : cA + (size_t)(t + 2) * kstep; const char* b2 = last ? nB : cB + (size_t)(t + 2) * kstep;
            const char* a3 = a2 + kstep; const char* b3 = b2 + kstep;
            if (last && has_next) S.a_ready(nxt);
            if constexpr (SP2) {
            PG8_LDB(B0, 0, 0); PG8_LDB(B1, 0, 1); PG8_SCHED; PG8_LDA(At, 0, 0); PG8_STAGE(PG8_SA(1, 1), a1 + hstep, voffA);
            PG8_WAIT_V(8); PG8_WAIT_L(0); PG8_BAR; PG8_MMA(0, 0, At, B0); PG8_MMA(0, 1, At, B1); PG8_BAR; PG8_SCHED;
            PG8_LDA(At, 0, 1); PG8_STAGE(PG8_SB(0, 0), b2, voffB); PG8_STAGE(PG8_SB(0, 1), b2 + hstep, voffB); PG8_STAGE(PG8_SA(0, 0), a2, voffA);
            PG8_WAIT_V(8); PG8_WAIT_L(0); PG8_BAR; PG8_MMA(1, 0, At, B0); PG8_MMA(1, 1, At, B1); PG8_BAR; PG8_SCHED;
            PG8_LDB(B0, 1, 0); PG8_LDB(B1, 1, 1); PG8_SCHED; PG8_LDA(At, 1, 0); PG8_STAGE(PG8_SA(0, 1), a2 + hstep, voffA);
            PG8_WAIT_V(8); PG8_WAIT_L(0); PG8_BAR; PG8_MMA(0, 0, At, B0); PG8_MMA(0, 1, At, B1); PG8_BAR; PG8_SCHED;
            PG8_LDA(At, 1, 1); PG8_STAGE(PG8_SB(1, 0), b3, voffB); PG8_STAGE(PG8_SB(1, 1), b3 + hstep, voffB); PG8_STAGE(PG8_SA(1, 0), a3, voffA);
            PG8_WAIT_V(8); PG8_WAIT_L(0); PG8_BAR; PG8_MMA(1, 0, At, B0); PG8_MMA(1, 1, At, B1); PG8_BAR; PG8_SCHED;
            } else {
            PG8_LDB(B0, 0, 0); PG8_SCHED; PG8_LDA(At, 0, 0); PG8_STAGE(PG8_SA(1, 1), a1 + hstep, voffA);
            PG8_WAIT_L(8); PG8_BAR; PG8_WAIT_L(0); PG8_MMA(0, 0, At, B0); PG8_BAR; PG8_SCHED;
            PG8_LDB(B1, 0, 1); PG8_STAGE(PG8_SB(0, 0), b2, voffB);
            PG8_BAR; PG8_WAIT_L(0); PG8_MMA(0, 1, At, B1); PG8_BAR;
            PG8_LDA(At, 0, 1); PG8_STAGE(PG8_SA(0, 0), a2, voffA);
            PG8_BAR; PG8_WAIT_L(0); PG8_MMA(1, 0, At, B0); PG8_BAR; PG8_SCHED;
            PG8_STAGE(PG8_SB(0, 1), b2 + hstep, voffB);
            PG8_WAIT_V(6); PG8_BAR; PG8_MMA(1, 1, At, B1); PG8_BAR;
            PG8_LDB(B0, 1, 0); PG8_SCHED; PG8_LDA(At, 1, 0); PG8_STAGE(PG8_SA(0, 1), a2 + hstep, voffA);
            PG8_WAIT_L(8); PG8_BAR; PG8_WAIT_L(0); PG8_MMA(0, 0, At, B0); PG8_BAR; PG8_SCHED;
            PG8_LDB(B1, 1, 1); PG8_STAGE(PG8_SB(1, 0), b3, voffB);
            PG8_BAR; PG8_WAIT_L(0); PG8_MMA(0, 1, At, B1); PG8_BAR;
            PG8_LDA(At, 1, 1); PG8_STAGE(PG8_SA(1, 0), a3, voffA);
            PG8_BAR; PG8_WAIT_L(0); PG8_MMA(1, 0, At, B0); PG8_BAR; PG8_SCHED;
            PG8_STAGE(PG8_SB(1, 1), b3 + hstep, voffB);
            PG8_WAIT_V(6); PG8_BAR; PG8_MMA(1, 1, At, B1); PG8_BAR;
            }
        }
        if constexpr (ALIGN_EPI) { if (wr == 0) PG8_BAR; }
        if constexpr (!Epi::AFTER_DRAIN) { E(acc, cur, wr, wc, fr, fq); S.done(cur); }
        if (!has_next) break;
#pragma unroll
        for (int a = 0; a < 2; ++a)
#pragma unroll
            for (int b = 0; b < 2; ++b)
#pragma unroll
                for (int m = 0; m < 4; ++m)
#pragma unroll
                    for (int n = 0; n < 2; ++n) acc[a][b][m][n] = (f32x4){0.f, 0.f, 0.f, 0.f};
        cur = nxt; cA = nA; cB = nB; ++ui;
        if constexpr (ALIGN_EPI) { if (wr == 1) PG8_BAR; }
    }
    PG8_WAIT_V(0);
    if constexpr (!ALIGN_EPI) { if (wr == 0) PG8_BAR; }
    PG8_BAR;
    if constexpr (Epi::AFTER_DRAIN) { E.fused(acc, cur, wr, wc, fr, fq, lds, wid, lane); S.done(cur); }
#undef PG8_SA
#undef PG8_SB
#undef PG8_STAGE
#undef PG8_LDA
#undef PG8_LDB
#undef PG8_MMA
#undef PG8_WAIT_V
#undef PG8_WAIT_L
#undef PG8_BAR
#undef PG8_SCHED
}
}

#include <hip/hip_bf16.h>
#include <cmath>
namespace attn_body {
using bf16=__hip_bfloat16;
using bf16x8=__attribute__((ext_vector_type(8)))short;
using s16x4=__attribute__((ext_vector_type(4)))short;
using f32x16=__attribute__((ext_vector_type(16)))float;
using u32x4=__attribute__((ext_vector_type(4)))unsigned;
constexpr int SEQ=8192,D=64;
constexpr int NW=8,QBLK=32,QB=QBLK*NW,KVBLK=64;
constexpr int ATTN_UNIT_ROWS=QB;
__device__ __forceinline__ int crow(int r,int hi){return (r&3)+8*(r>>2)+4*hi;}
#define SBAR() __builtin_amdgcn_sched_barrier(0)
__device__ __forceinline__ void cmask(f32x16&p0,f32x16&p1,int jb,int qrel,int hi){
  const float NEG=-INFINITY; int kb=64*jb+4*hi;
  #pragma unroll
  for(int r=0;r<16;++r){int kv=kb+(r&3)+8*(r>>2); if(kv>qrel)p0[r]=NEG; if(kv+32>qrel)p1[r]=NEG;}
}

constexpr int NSLOT=3, SLOTB=8192;
constexpr int LDS_K=0, LDS_V=NSLOT*SLOTB, LDS_WS=2*NSLOT*SLOTB, LDS_OST=LDS_WS+NW*64*4, LDS_BYTES=LDS_OST+NW*4096;
constexpr int LDS_TB=LDS_BYTES;
template<int MODE> __device__ __forceinline__ void wmask(f32x16&p0,f32x16&p1,int kb,int qabs,int hi,const __attribute__((address_space(3))) float*tbl){
  if constexpr(MODE==1){ const int base=kb+4*hi-qabs+128;
    #pragma unroll
    for(int r=0;r<16;++r){ const int i0=base+(r&3)+8*(r>>2),i1=i0+32; const bool v0=(unsigned)i0<=256u,v1=(unsigned)i1<=256u;
      const float b0=tbl[v0?i0:0],b1=tbl[v1?i1:0]; p0[r]=v0?p0[r]+b0:-INFINITY; p1[r]=v1?p1[r]+b1:-INFINITY; } }
}
constexpr float C2=0.125f*1.4426950408889634f;
__device__ __forceinline__ void glds16(const void*gsrc,unsigned lds_dst){unsigned keep;
  asm volatile("s_mov_b32 %0, m0\n\ts_mov_b32 m0, %2\n\ts_nop 0\n\tglobal_load_lds_dwordx4 %1, off\n\ts_mov_b32 m0, %0":"=&s"(keep):"v"(gsrc),"s"(lds_dst):"memory");}
__device__ __forceinline__ float max3f(float a,float b,float c){float r;asm("v_max3_f32 %0, %1, %2, %3":"=v"(r):"v"(a),"v"(b),"v"(c));return r;}
__device__ __forceinline__ float max2f(float a,float b){float r;asm("v_max_f32_e32 %0, %1, %2":"=v"(r):"v"(a),"v"(b));return r;}
__device__ __forceinline__ float fadd_s(float a,float b){float r;asm("v_add_f32_e32 %0, %1, %2":"=v"(r):"v"(a),"v"(b));return r;}
__device__ __forceinline__ float fsub_s(float a,float b){float r;asm("v_sub_f32_e32 %0, %1, %2":"=v"(r):"v"(a),"v"(b));return r;}
typedef float f32x2_t __attribute__((ext_vector_type(2))); typedef __bf16 bf16x2_t __attribute__((ext_vector_type(2)));
__device__ __forceinline__ unsigned cvtpk_s(float lo,float hi){f32x2_t v={lo,hi};bf16x2_t b=__builtin_convertvector(v,bf16x2_t);return __builtin_bit_cast(unsigned,b);}
#define WAIT_BAR(N) asm volatile("s_waitcnt vmcnt(" #N ") lgkmcnt(0)\n\ts_barrier":::"memory")

__device__ __forceinline__ void qkt(f32x16&p0,f32x16&p1,const char*Kslot,const bf16x8*qr,const f32x16&negm,int r32,int hi){
  const char*kb=Kslot+hi*1024+r32*16;
  #pragma unroll
  for(int d0=0;d0<4;++d0){
    const bf16x8 b0=*reinterpret_cast<const bf16x8*>(kb+d0*2048);
    const bf16x8 b1=*reinterpret_cast<const bf16x8*>(kb+d0*2048+512);
    if(d0==0){p0=__builtin_amdgcn_mfma_f32_32x32x16_bf16(b0,qr[0],negm,0,0,0);p1=__builtin_amdgcn_mfma_f32_32x32x16_bf16(b1,qr[0],negm,0,0,0);}
    else{p0=__builtin_amdgcn_mfma_f32_32x32x16_bf16(b0,qr[d0],p0,0,0,0);p1=__builtin_amdgcn_mfma_f32_32x32x16_bf16(b1,qr[d0],p1,0,0,0);}}
}
typedef __attribute__((address_space(3))) const char* lds_cptr;
typedef short v4i16_t __attribute__((ext_vector_type(4)));
__device__ __forceinline__ void kload8(bf16x8*kf,lds_cptr kp){
  kf[0]=*(const __attribute__((address_space(3))) bf16x8*)(kp);      kf[1]=*(const __attribute__((address_space(3))) bf16x8*)(kp+512);
  kf[2]=*(const __attribute__((address_space(3))) bf16x8*)(kp+2048); kf[3]=*(const __attribute__((address_space(3))) bf16x8*)(kp+2560);
  kf[4]=*(const __attribute__((address_space(3))) bf16x8*)(kp+4096); kf[5]=*(const __attribute__((address_space(3))) bf16x8*)(kp+4608);
  kf[6]=*(const __attribute__((address_space(3))) bf16x8*)(kp+6144); kf[7]=*(const __attribute__((address_space(3))) bf16x8*)(kp+6656);
}
__device__ __forceinline__ void kload2(bf16x8*kf,lds_cptr kp,int j){ kf[2*j]=*(const __attribute__((address_space(3))) bf16x8*)(kp+j*2048); kf[2*j+1]=*(const __attribute__((address_space(3))) bf16x8*)(kp+j*2048+512); }
__device__ __forceinline__ s16x4 vtr(lds_cptr p){ return __builtin_bit_cast(s16x4,__builtin_amdgcn_ds_read_tr16_b64_v4i16((__attribute__((address_space(3))) v4i16_t*)p)); }
__device__ __forceinline__ float rowmax(const f32x16&p0,const f32x16&p1){
  float a=max3f(p0[0],p0[1],p1[0]),b=max3f(p0[2],p0[3],p1[1]);a=max3f(a,p1[2],p1[3]);
  #pragma unroll
  for(int r=4;r<16;r+=4){a=max3f(a,p0[r],p0[r+1]);b=max3f(b,p0[r+2],p0[r+3]);a=max3f(a,p1[r],p1[r+1]);b=max3f(b,p1[r+2],p1[r+3]);}
  const float m=max2f(a,b);
  auto rr=__builtin_amdgcn_permlane32_swap(__float_as_uint(m),__float_as_uint(m),false,false);
  return max2f(__uint_as_float(rr[0]),__uint_as_float(rr[1]));
}
__device__ __forceinline__ void pv(f32x16*o,int vb,bf16x8 pa0,bf16x8 pa1,bf16x8 pa2,bf16x8 pa3){
  #pragma unroll
  for(int d0=0;d0<2;++d0){s16x4 lo[4],hi[4];
    #pragma unroll
    for(int ks=0;ks<4;++ks){
      asm volatile("ds_read_b64_tr_b16 %0,%1 offset:%c2":"=&v"(lo[ks]):"v"(vb),"i"(d0*4096+ks*1024):"memory");
      asm volatile("ds_read_b64_tr_b16 %0,%1 offset:%c2":"=&v"(hi[ks]):"v"(vb),"i"(d0*4096+ks*1024+512):"memory");}
    asm volatile("s_waitcnt lgkmcnt(0)":::"memory");SBAR();
    #define PK(k) (bf16x8){lo[k][0],lo[k][1],lo[k][2],lo[k][3],hi[k][0],hi[k][1],hi[k][2],hi[k][3]}
    o[d0]=__builtin_amdgcn_mfma_f32_32x32x16_bf16(pa0,PK(0),o[d0],0,0,0);
    o[d0]=__builtin_amdgcn_mfma_f32_32x32x16_bf16(pa1,PK(1),o[d0],0,0,0);
    o[d0]=__builtin_amdgcn_mfma_f32_32x32x16_bf16(pa2,PK(2),o[d0],0,0,0);
    o[d0]=__builtin_amdgcn_mfma_f32_32x32x16_bf16(pa3,PK(3),o[d0],0,0,0);
    #undef PK
  }
}

#ifndef ATTN_STORE16
#define ATTN_STORE16(p,v) (*(u32x4*)(p)=(v))
#endif
template<int THRL,int QP,int KP,int OP,int MODE> __device__ __forceinline__ void attn_unit(int q0,int NT,const bf16*Qh,const bf16*__restrict__ Kh,const bf16*__restrict__ Vh,bf16*Oh,char*shm,const float*tbg=nullptr,float sink2=0.f,int kb0=0){
  int tid_l=threadIdx.x; asm volatile("":"+v"(tid_l)); const int tid=tid_l,lane=tid&63,r32=lane&31,hi=lane>>5; const int wid=__builtin_amdgcn_readfirstlane(tid>>6);
  __attribute__((address_space(3))) float* tblL=(__attribute__((address_space(3))) float*)((__attribute__((address_space(3))) char*)shm+LDS_TB);
  if constexpr(MODE==1){ if(tid<257)tblL[tid]=tbg[tid]; }

  const bf16*Qw=Qh+(long)(q0+wid*QBLK)*QP;

  const unsigned lds0=(unsigned)(uintptr_t)shm;
  float*wsf=(float*)(shm+LDS_WS)+wid*64;
  const bf16*ksrc=Kh+(long)lane*KP+wid*8;
  const bf16*vsrc=Vh+(long)(16*(wid&3)+(lane>>2))*KP+(wid>>2)*32+(lane&3)*8;
  const unsigned kdst=lds0+LDS_K+wid*1024, vdst=lds0+LDS_V+wid*1024;
  #define DMA_K(t,slot) glds16(ksrc+(long)(t)*KVBLK*KP,(unsigned)__builtin_amdgcn_readfirstlane(kdst+(slot)))
  #define DMA_V(t,slot) glds16(vsrc+(long)(t)*KVBLK*KP,(unsigned)__builtin_amdgcn_readfirstlane(vdst+(slot)))
  const int vb0=(int)(lds0+LDS_V)+((lane>>4)&1)*32+(lane&3)*8+(4*hi+((lane&15)>>2))*64;
  const char*Kbase=shm+LDS_K; bf16x8 kf[8];
  const lds_cptr shm3=(lds_cptr)shm; const lds_cptr kp0=shm3+LDS_K+hi*1024+r32*16; const lds_cptr vp0=shm3+LDS_V+((lane>>4)&1)*32+(lane&3)*8+(4*hi+((lane&15)>>2))*64;

  DMA_K(0,0);DMA_V(0,0);DMA_K(1,SLOTB);
  bf16x8 qr[4];
  #pragma unroll
  for(int d0=0;d0<4;++d0)qr[d0]=*reinterpret_cast<const bf16x8*>(&Qw[(long)r32*QP+d0*16+hi*8]);
  float mhat=0.f,l_reg=0.f;f32x16 o[2];o[0]=f32x16{};o[1]=f32x16{};f32x16 negm=f32x16{};asm volatile("":"+v"(negm));
  const int qrel=wid*QBLK+r32; const int qabs=q0+qrel;
  #define CMASK(P0,P1,t) wmask<MODE>(P0,P1,kb0+(t)*64,qabs,hi,tblL)
  bool resc=false;
  #define START(P0,P1) do{ float rm=rowmax(P0,P1); if constexpr(MODE==1) rm=__builtin_fmaxf(rm,sink2); resc=false; \
    { const float dl=rm; mhat=fadd_s(mhat,dl); \
      _Pragma("unroll") for(int r=0;r<16;++r){P0[r]=fsub_s(P0[r],dl);P1[r]=fsub_s(P1[r],dl);} \
      _Pragma("unroll") for(int r=0;r<16;++r)negm[r]=-mhat; asm volatile("":"+v"(negm)); } \
    _Pragma("unroll") for(int r=0;r<16;++r)P0[r]=__builtin_amdgcn_exp2f(P0[r]); }while(0)
  #define RESC() do{ if(resc){ asm volatile("s_waitcnt lgkmcnt(0)":::"memory"); \
      _Pragma("unroll") for(int d_=0;d_<2;++d_) _Pragma("unroll") for(int r=0;r<16;++r)o[d_][r]*=wsf[crow(r,hi)]; } }while(0)
  f32x16 pA0,pA1,pB0,pB1;
  int sl_prev=0,sl_cur=0,sl_next=SLOTB;
  #define ROT() do{sl_prev=sl_cur;sl_cur=sl_next;sl_next=(sl_next==(NSLOT-1)*SLOTB)?0:sl_next+SLOTB;}while(0)
  DMA_K(2,2*SLOTB);
  WAIT_BAR(3);
  qkt(pA0,pA1,Kbase,qr,negm,r32,hi);asm volatile("s_nop 15\n\ts_nop 7":"+v"(pA0),"+v"(pA1));CMASK(pA0,pA1,0);
  START(pA0,pA1);
  _Pragma("unroll") for(int r=0;r<16;++r)pA1[r]=__builtin_amdgcn_exp2f(pA1[r]);
  WAIT_BAR(0);
  DMA_K(3,0);DMA_V(1,SLOTB);
  ROT();
  kload8(kf,kp0+sl_cur);
  WAIT_BAR(2);
  s16x4 vlo[8],vhi[8]; u32x4 pw0,pw1,pw2,pw3;
  #define PKW(P,B) cvtpk_s(P[B],P[B+1])
  #define PAF(k) __builtin_bit_cast(bf16x8,pw##k)
  #define VFR(i) (bf16x8){vlo[i][0],vlo[i][1],vlo[i][2],vlo[i][3],vhi[i][0],vhi[i][1],vhi[i][2],vhi[i][3]}
  #define PIN(x) asm volatile("":"+v"(x))
  #define MX3(a,b,c) __builtin_fmaxf(__builtin_fmaxf((a),(b)),(c))
  #define GAPA(MF,A0,A1,A2,A3,W0,W1,PW) do{ MF; sacc+=A0; sacc+=A1; sacc+=A2; sacc+=A3; PIN(sacc); W0; W1; PIN(PW); SBAR(); }while(0)
  #define EX(v) __builtin_amdgcn_exp2f(v)
  #define GAPB(MF,X,B) do{ MF; X[B]=EX(X[B]); X[B+1]=EX(X[B+1]); X[B+2]=EX(X[B+2]); X[B+3]=EX(X[B+3]); PIN(X); SBAR(); }while(0)
  #define VRD(i) do{ vlo[i]=vtr(vp_+(((i)>>2)*4096+((i)&3)*1024)); vhi[i]=vtr(vp_+(((i)>>2)*4096+((i)&3)*1024+512)); }while(0)
  #define KRD(G,j) do{ if(G){ kload2(kf,kp0+sl_next,j); SBAR(); } }while(0)
  #define STEP(C0,C1,P0,P1,t,GK,GV,GL) do{ SBAR(); \
    const lds_cptr vp_=vp0+sl_prev; \
    VRD(0); SBAR(); float sacc=(P0[0]+P0[1]); \
    GAPA(C0=__builtin_amdgcn_mfma_f32_32x32x16_bf16(kf[0],qr[0],negm,0,0,0), P0[2],P0[3],P0[4],P0[5],     pw0[0]=PKW(P0,0), pw0[1]=PKW(P0,2), pw0); \
    VRD(4); SBAR(); GAPA(C1=__builtin_amdgcn_mfma_f32_32x32x16_bf16(kf[1],qr[0],negm,0,0,0), P0[6],P0[7],P0[8],P0[9],     pw0[2]=PKW(P0,4), pw0[3]=PKW(P0,6), pw0); \
    VRD(1); SBAR(); GAPA(C0=__builtin_amdgcn_mfma_f32_32x32x16_bf16(kf[2],qr[1],C0,0,0,0),   P0[10],P0[11],P0[12],P0[13], pw1[0]=PKW(P0,8), pw1[1]=PKW(P0,10), pw1); \
    VRD(5); SBAR(); GAPA(C1=__builtin_amdgcn_mfma_f32_32x32x16_bf16(kf[3],qr[1],C1,0,0,0),   P0[14],P0[15],P1[0],P1[1],   pw1[2]=PKW(P0,12),pw1[3]=PKW(P0,14), pw1); \
    VRD(2); SBAR(); GAPA(C0=__builtin_amdgcn_mfma_f32_32x32x16_bf16(kf[4],qr[2],C0,0,0,0),   P1[2],P1[3],P1[4],P1[5],     pw2[0]=PKW(P1,0), pw2[1]=PKW(P1,2), pw2); \
    VRD(6); SBAR(); GAPA(C1=__builtin_amdgcn_mfma_f32_32x32x16_bf16(kf[5],qr[2],C1,0,0,0),   P1[6],P1[7],P1[8],P1[9],     pw2[2]=PKW(P1,4), pw2[3]=PKW(P1,6), pw2); \
    VRD(3); SBAR(); GAPA(C0=__builtin_amdgcn_mfma_f32_32x32x16_bf16(kf[6],qr[3],C0,0,0,0),   P1[10],P1[11],P1[12],P1[13], pw3[0]=PKW(P1,8), pw3[1]=PKW(P1,10), pw3); \
    VRD(7); SBAR(); GAPA(C1=__builtin_amdgcn_mfma_f32_32x32x16_bf16(kf[7],qr[3],C1,0,0,0),   P1[14],P1[15],0.f,0.f,       pw3[2]=PKW(P1,12),pw3[3]=PKW(P1,14), pw3); \
    l_reg+=sacc; \
    if(GK){DMA_K((t)+3,sl_cur);} if(GV){DMA_V((t)+1,sl_next);} \
    CMASK(C0,C1,t); \
    { float a=MX3(C0[0],C0[1],C1[0]),b=MX3(C0[2],C0[3],C1[1]); a=MX3(a,C1[2],C1[3]); \
      _Pragma("unroll") for(int r=4;r<16;r+=4){a=MX3(a,C0[r],C0[r+1]);b=MX3(b,C0[r+2],C0[r+3]);a=MX3(a,C1[r],C1[r+1]);b=MX3(b,C1[r+2],C1[r+3]);} \
      float rm=__builtin_fmaxf(a,b); { auto rr=__builtin_amdgcn_permlane32_swap(__float_as_uint(rm),__float_as_uint(rm),false,false); rm=__builtin_fmaxf(__uint_as_float(rr[0]),__uint_as_float(rr[1])); } \
      resc=false; \
      if(__builtin_expect(__any(rm>(float)THRL),0)){ const float dl=__builtin_fmaxf(rm,0.f); mhat+=dl; \
        _Pragma("unroll") for(int r=0;r<16;++r){C0[r]-=dl;C1[r]-=dl;} \
        _Pragma("unroll") for(int r=0;r<16;++r)negm[r]=-mhat; asm volatile("":"+v"(negm)); \
        const float f=__builtin_amdgcn_exp2f(-dl); l_reg*=f; if(hi==0)wsf[r32]=f; resc=true; } } \
    SBAR(); \
    GAPB(o[0]=__builtin_amdgcn_mfma_f32_32x32x16_bf16(PAF(0),VFR(0),o[0],0,0,0), C0,0); \
    GAPB(o[1]=__builtin_amdgcn_mfma_f32_32x32x16_bf16(PAF(0),VFR(4),o[1],0,0,0), C0,4); \
    KRD(GL,0); GAPB(o[0]=__builtin_amdgcn_mfma_f32_32x32x16_bf16(PAF(1),VFR(1),o[0],0,0,0), C0,8); \
    KRD(GL,1); GAPB(o[1]=__builtin_amdgcn_mfma_f32_32x32x16_bf16(PAF(1),VFR(5),o[1],0,0,0), C0,12); \
    KRD(GL,2); GAPB(o[0]=__builtin_amdgcn_mfma_f32_32x32x16_bf16(PAF(2),VFR(2),o[0],0,0,0), C1,0); \
    KRD(GL,3); GAPB(o[1]=__builtin_amdgcn_mfma_f32_32x32x16_bf16(PAF(2),VFR(6),o[1],0,0,0), C1,4); \
    GAPB(o[0]=__builtin_amdgcn_mfma_f32_32x32x16_bf16(PAF(3),VFR(3),o[0],0,0,0), C1,8); \
    GAPB(o[1]=__builtin_amdgcn_mfma_f32_32x32x16_bf16(PAF(3),VFR(7),o[1],0,0,0), C1,12); \
    }while(0)
  int t=1;
  #undef CMASK
  #define CMASK(P0,P1,t) wmask<MODE>(P0,P1,kb0+(t)*64,qabs,hi,tblL)
  for(;t+5<NT;t+=2){
    STEP(pB0,pB1,pA0,pA1,t,true,true,true);     WAIT_BAR(2); RESC(); ROT();
    STEP(pA0,pA1,pB0,pB1,t+1,true,true,true);   WAIT_BAR(2); RESC(); ROT();
  }
  #undef CMASK
  #define CMASK(P0,P1,t) wmask<MODE>(P0,P1,kb0+(t)*64,qabs,hi,tblL)
  #define ENDW(tt) do{ if((tt)+3<NT){WAIT_BAR(2);} else if((tt)+2<NT){WAIT_BAR(1);} else {WAIT_BAR(0);} }while(0)
  for(;t+1<NT;t+=2){
    STEP(pB0,pB1,pA0,pA1,t,(t+3<NT),(t+1<NT),(t+1<NT));       ENDW(t);   RESC(); ROT();
    STEP(pA0,pA1,pB0,pB1,t+1,(t+4<NT),(t+2<NT),(t+2<NT));     ENDW(t+1); RESC(); ROT();
  }
  STEP(pB0,pB1,pA0,pA1,NT-1,false,false,false); RESC();
  { float sacc=pB0[0]+pB0[1]; _Pragma("unroll") for(int r=2;r<16;++r)sacc+=pB0[r]; _Pragma("unroll") for(int r=0;r<16;++r)sacc+=pB1[r]; l_reg+=sacc;
    pw0=(u32x4){PKW(pB0,0),PKW(pB0,2),PKW(pB0,4),PKW(pB0,6)};pw1=(u32x4){PKW(pB0,8),PKW(pB0,10),PKW(pB0,12),PKW(pB0,14)};pw2=(u32x4){PKW(pB1,0),PKW(pB1,2),PKW(pB1,4),PKW(pB1,6)};pw3=(u32x4){PKW(pB1,8),PKW(pB1,10),PKW(pB1,12),PKW(pB1,14)};
    SBAR(); pv(o,vb0+sl_cur,PAF(0),PAF(1),PAF(2),PAF(3)); }
  #undef PKW
  #undef PAF
  #undef VFR
  #undef PIN
  #undef MX3
  #undef GAPA
  #undef GAPB
  #undef EX
  #undef VRD
  #undef KRD
  #undef STEP
  #undef ENDW
  {auto rr=__builtin_amdgcn_permlane32_swap(__float_as_uint(l_reg),__float_as_uint(l_reg),false,false);l_reg=__uint_as_float(rr[0])+__uint_as_float(rr[1]);}
  if constexpr(MODE==1) l_reg+=__builtin_amdgcn_exp2f(sink2-mhat);
  if(hi==0)wsf[32+r32]=l_reg;asm volatile("s_waitcnt lgkmcnt(0)":::"memory");
  float rli[16];
  #pragma unroll
  for(int r=0;r<16;++r)rli[r]=__builtin_amdgcn_rcpf(wsf[32+crow(r,hi)]);
  bf16*Ow=Oh+(long)(q0+wid*QBLK)*OP;
  { bf16*stg=(bf16*)(shm+LDS_OST)+wid*2048;
    #pragma unroll
    for(int r=0;r<16;++r){const int orow=crow(r,hi);
      #pragma unroll
      for(int d0=0;d0<2;++d0)stg[orow*64+d0*32+r32]=__float2bfloat16(o[d0][r]*rli[r]);}
    asm volatile("s_waitcnt lgkmcnt(0)":::"memory");
    #pragma unroll
    for(int i=0;i<4;++i){const int row=i*8+(lane>>3),ch=lane&7; const u32x4 v=*(const u32x4*)(stg+row*64+ch*8); ATTN_STORE16(Ow+(long)row*OP+ch*8,v);} }
  asm volatile("s_waitcnt lgkmcnt(0)\n\ts_barrier":::"memory");
  #undef DMA_K
  #undef DMA_V
  #undef CMASK
  #undef START
  #undef RESC
  #undef ROT
}
constexpr int ATTN_LDS_BYTES=LDS_BYTES+1056;
#undef SBAR
#undef WAIT_BAR
}

namespace hg {
typedef short s16x4 __attribute__((ext_vector_type(4)));
typedef short s16x8 __attribute__((ext_vector_type(8)));
typedef float f32x4 __attribute__((ext_vector_type(4)));
typedef unsigned u32x4 __attribute__((ext_vector_type(4)));
typedef unsigned u32x2 __attribute__((ext_vector_type(2)));
#define HG_LAS __attribute__((address_space(3)))
constexpr int T = 8192, SEG = 128, NSEG = 64, HW = 512;
constexpr int PV = 272;
typedef float f32x2_t __attribute__((ext_vector_type(2))); typedef __bf16 bf16x2_t __attribute__((ext_vector_type(2)));
__device__ __forceinline__ unsigned pk(float lo, float hi) { f32x2_t v = {lo, hi}; bf16x2_t b = __builtin_convertvector(v, bf16x2_t); return __builtin_bit_cast(unsigned, b); }
#define HG_DPP_ADD(v, ctrl) v += __builtin_bit_cast(float, __builtin_amdgcn_update_dpp(0, __builtin_bit_cast(int, v), ctrl, 0xF, 0xF, true))
__device__ __forceinline__ float row16_sum(float v) { HG_DPP_ADD(v, 0xB1); HG_DPP_ADD(v, 0x4E); HG_DPP_ADD(v, 0x124); HG_DPP_ADD(v, 0x128); return v; }

__device__ __forceinline__ void pass1(int G, int bid, const float* FF, const float* KF, const float* FB, const float* KB, const float* BI, float* P, float* Dg, HG_LAS unsigned char* lds) {
    int tid_l = threadIdx.x; asm volatile("" : "+v"(tid_l));
    const int tid = tid_l, lane = tid & 63, w = __builtin_amdgcn_readfirstlane(tid >> 6), l16 = lane & 15, g = lane >> 4, c = tid & 127, qt = tid >> 7;
    constexpr int VT = 0, KT = 128 * PV, TQ = 3 * 128 * PV;
    for (int u = bid; u < 4 * NSEG; u += G) {
        const int h = u >> 6, seg = u & 63, tok0 = seg * SEG;
        const size_t ub = (size_t)tok0 * HW + h * 128; const int lo = 32 * qt * HW + c;
        {
            const float* vb = BI + ub;
#pragma unroll
            for (int jj = 0; jj < 4; ++jj) { float x[8];
#pragma unroll
                for (int j = 0; j < 8; ++j) x[j] = (vb + (8 * jj + j) * HW)[lo];
                u32x4 o; o.x = pk(x[0], x[1]); o.y = pk(x[2], x[3]); o.z = pk(x[4], x[5]); o.w = pk(x[6], x[7]);
                *(HG_LAS u32x4*)(lds + VT + c * PV + (32 * qt + 8 * jj) * 2) = o; }
        }
        float kw0[32], kw1[32];
        {
            float f[32];
#pragma unroll
            for (int j = 0; j < 32; ++j) { f[j] = (FF + ub + j * HW)[lo]; kw0[j] = (KF + ub + j * HW)[lo]; }
            float run = 1.f;
#pragma unroll
            for (int j = 31; j >= 0; --j) { kw0[j] *= run; run *= f[j]; }
            *(HG_LAS float*)(lds + TQ + (0 * 4 + qt) * 512 + c * 4) = run;
        }
        {
            float f[32];
#pragma unroll
            for (int j = 0; j < 32; ++j) { f[j] = (FB + ub + j * HW)[lo]; kw1[j] = (KB + ub + j * HW)[lo]; }
            float run = 1.f;
#pragma unroll
            for (int j = 0; j < 32; ++j) { kw1[j] *= run; run *= f[j]; }
            *(HG_LAS float*)(lds + TQ + (1 * 4 + qt) * 512 + c * 4) = run;
        }
        __syncthreads();
        {
            float t0[4], t1[4];
#pragma unroll
            for (int q = 0; q < 4; ++q) { t0[q] = *(HG_LAS float*)(lds + TQ + (0 * 4 + q) * 512 + c * 4); t1[q] = *(HG_LAS float*)(lds + TQ + (1 * 4 + q) * 512 + c * 4); }
            float x0 = 1.f, x1 = 1.f;
#pragma unroll
            for (int q = 0; q < 4; ++q) { if (q > qt) x0 *= t0[q]; if (q < qt) x1 *= t1[q]; }
            if (qt == 0) { Dg[((size_t)(h * 2 + 0) * NSEG + seg) * 128 + c] = (t0[0] * t0[1]) * (t0[2] * t0[3]); Dg[((size_t)(h * 2 + 1) * NSEG + seg) * 128 + c] = (t1[0] * t1[1]) * (t1[2] * t1[3]); }
#pragma unroll
            for (int jj = 0; jj < 4; ++jj) { u32x4 o0, o1;
                o0.x = pk(kw0[8 * jj + 0] * x0, kw0[8 * jj + 1] * x0); o0.y = pk(kw0[8 * jj + 2] * x0, kw0[8 * jj + 3] * x0); o0.z = pk(kw0[8 * jj + 4] * x0, kw0[8 * jj + 5] * x0); o0.w = pk(kw0[8 * jj + 6] * x0, kw0[8 * jj + 7] * x0);
                o1.x = pk(kw1[8 * jj + 0] * x1, kw1[8 * jj + 1] * x1); o1.y = pk(kw1[8 * jj + 2] * x1, kw1[8 * jj + 3] * x1); o1.z = pk(kw1[8 * jj + 4] * x1, kw1[8 * jj + 5] * x1); o1.w = pk(kw1[8 * jj + 6] * x1, kw1[8 * jj + 7] * x1);
                *(HG_LAS u32x4*)(lds + KT + c * PV + (32 * qt + 8 * jj) * 2) = o0;
                *(HG_LAS u32x4*)(lds + KT + 128 * PV + c * PV + (32 * qt + 8 * jj) * 2) = o1; }
        }
        __syncthreads();
        {
            s16x8 bfr[4];
#pragma unroll
            for (int kk = 0; kk < 4; ++kk) bfr[kk] = *(const HG_LAS s16x8*)(lds + VT + (16 * w + l16) * PV + (32 * kk + 8 * g) * 2);
#pragma unroll
            for (int dir = 0; dir < 2; ++dir) {
                float* Pp = P + ((size_t)(h * 2 + dir) * NSEG + seg) * 16384 + 16 * w; const int plo = 4 * g * 128 + l16;
#pragma unroll
                for (int i = 0; i < 8; ++i) { f32x4 acc = (f32x4){0.f, 0.f, 0.f, 0.f};
#pragma unroll
                    for (int kk = 0; kk < 4; ++kk) { const s16x8 a = *(const HG_LAS s16x8*)(lds + KT + dir * 128 * PV + (16 * i + l16) * PV + (32 * kk + 8 * g) * 2);
                        acc = __builtin_amdgcn_mfma_f32_16x16x32_bf16(a, bfr[kk], acc, 0, 0, 0); }
#pragma unroll
                    for (int r = 0; r < 4; ++r) (Pp + (16 * i + r) * 128)[plo] = acc[r]; }
            }
        }
        __syncthreads();
    }
}

__device__ __forceinline__ void scan(int G, int vcu, const float* P, const float* Dg, float* SS) {
    int tid_l = threadIdx.x; asm volatile("" : "+v"(tid_l));
    for (int e = vcu * 512 + tid_l; e < 8 * 16384; e += G * 512) {
        const int hd = e >> 14, cv = e & 16383, c = cv >> 7, dir = hd & 1;
        float Sv = 0.f;
        for (int s0 = 0; s0 < NSEG; s0 += 8) { float p[8], d[8];
#pragma unroll
            for (int j = 0; j < 8; ++j) { const int sg = dir ? NSEG - 1 - (s0 + j) : s0 + j; p[j] = P[((size_t)hd * NSEG + sg) * 16384 + cv]; d[j] = Dg[((size_t)hd * NSEG + sg) * 128 + c]; }
#pragma unroll
            for (int j = 0; j < 8; ++j) { const int sg = dir ? NSEG - 1 - (s0 + j) : s0 + j; SS[((size_t)hd * NSEG + sg) * 16384 + cv] = Sv; Sv = d[j] * Sv + p[j]; } }
    }
}

__device__ __forceinline__ void pass2(int G, int bid, const float* BQ, const float* KF, const float* FF, const float* KB, const float* FB, const float* BI, const float* SGt, const float* SS,
                                      const float* gnw, unsigned short* MIX, HG_LAS unsigned char* lds) {
    int tid_l = threadIdx.x; asm volatile("" : "+v"(tid_l));
    const int tid = tid_l, lane = tid & 63, w = __builtin_amdgcn_readfirstlane(tid >> 6), l16 = lane & 15, g = lane >> 4, c = tid & 127, ch_t = tid >> 7;
    constexpr int VT = 0, QT = 128 * PV, KT = QT + 64 * PV, KPT = KT + 64 * PV, KPP = 144, DCH = KPT + 128 * KPP, NRM = DCH + 2048, RSTD = NRM + 4096;
    for (int u = bid; u < 4 * NSEG; u += G) {
        const int h = u >> 6, seg = u & 63, tok0 = seg * SEG;
        {
            const float* vb = BI + (size_t)tok0 * HW + h * 128; const int lo = 32 * ch_t * HW + c;
#pragma unroll
            for (int jj = 0; jj < 4; ++jj) { float x[8];
#pragma unroll
                for (int j = 0; j < 8; ++j) x[j] = (vb + (8 * jj + j) * HW)[lo];
                u32x4 o; o.x = pk(x[0], x[1]); o.y = pk(x[2], x[3]); o.z = pk(x[4], x[5]); o.w = pk(x[6], x[7]);
                *(HG_LAS u32x4*)(lds + VT + c * PV + (32 * ch_t + 8 * jj) * 2) = o; }
        }
        f32x4 O[8];
#pragma unroll
        for (int i = 0; i < 8; ++i) O[i] = (f32x4){0.f, 0.f, 0.f, 0.f};
#pragma unroll
        for (int dir = 0; dir < 2; ++dir) {
            const float* Fp = dir ? FB : FF; const float* Kp = dir ? KB : KF;
            f32x4 St[8];
            { const float* sp = SS + ((size_t)(h * 2 + dir) * NSEG + seg) * 16384 + 16 * w; const int lo = 4 * g * 128 + l16;
              asm volatile("" ::: "memory");
#pragma unroll
              for (int i = 0; i < 8; ++i)
#pragma unroll
                  for (int r = 0; r < 4; ++r) St[i][r] = (sp + (16 * i + r) * 128)[lo]; }
#pragma unroll
            for (int hq = 0; hq < 2; ++hq) {
                const int hh = dir ? 1 - hq : hq;
                {
                    const size_t ub = (size_t)(tok0 + 64 * hh) * HW + h * 128; const int lo = 16 * ch_t * HW + c;
                    float f[16], k[16], q[16];
                    asm volatile("" ::: "memory");
#pragma unroll
                    for (int j = 0; j < 16; ++j) { f[j] = (Fp + ub + j * HW)[lo]; k[j] = (Kp + ub + j * HW)[lo]; q[j] = (BQ + ub + j * HW)[lo]; }
                    float kp[16]; float cum = 1.f, run = 1.f;
                    if (dir == 0) {
#pragma unroll
                        for (int j = 0; j < 16; ++j) { cum *= f[j]; q[j] *= cum; const float kk = k[j]; k[j] = kk * __builtin_amdgcn_rcpf(fmaxf(cum, 1e-30f)); kp[j] = kk; }
#pragma unroll
                        for (int j = 15; j >= 0; --j) { kp[j] *= run; run *= f[j]; }
                    } else {
#pragma unroll
                        for (int j = 15; j >= 0; --j) { cum *= f[j]; q[j] *= cum; const float kk = k[j]; k[j] = kk * __builtin_amdgcn_rcpf(fmaxf(cum, 1e-30f)); kp[j] = kk; }
#pragma unroll
                        for (int j = 0; j < 16; ++j) { kp[j] *= run; run *= f[j]; }
                    }
#pragma unroll
                    for (int j = 0; j < 16; ++j) { *(HG_LAS unsigned short*)(lds + QT + (16 * ch_t + j) * PV + c * 2) = (unsigned short)(pk(q[j], 0.f) & 0xffffu);
                                                   *(HG_LAS unsigned short*)(lds + KT + (16 * ch_t + j) * PV + c * 2) = (unsigned short)(pk(k[j], 0.f) & 0xffffu); }
                    u32x4 o0, o1; o0.x = pk(kp[0], kp[1]); o0.y = pk(kp[2], kp[3]); o0.z = pk(kp[4], kp[5]); o0.w = pk(kp[6], kp[7]); o1.x = pk(kp[8], kp[9]); o1.y = pk(kp[10], kp[11]); o1.z = pk(kp[12], kp[13]); o1.w = pk(kp[14], kp[15]);
                    *(HG_LAS u32x4*)(lds + KPT + c * KPP + (16 * ch_t) * 2) = o0; *(HG_LAS u32x4*)(lds + KPT + c * KPP + (16 * ch_t) * 2 + 16) = o1;
                    *(HG_LAS float*)(lds + DCH + ch_t * 512 + c * 4) = cum;
                }
                __syncthreads();
#pragma unroll
                for (int cq = 0; cq < 4; ++cq) {
                    const int ch = dir ? 3 - cq : cq, tr = 16 * ch, cg = 4 * hh + ch;
                    f32x4 at = (f32x4){0.f, 0.f, 0.f, 0.f};
#pragma unroll
                    for (int m = 0; m < 4; ++m) { const s16x8 a = *(const HG_LAS s16x8*)(lds + KT + (tr + l16) * PV + (32 * m + 8 * g) * 2); const s16x8 b = *(const HG_LAS s16x8*)(lds + QT + (tr + l16) * PV + (32 * m + 8 * g) * 2);
                        at = __builtin_amdgcn_mfma_f32_16x16x32_bf16(a, b, at, 0, 0, 0); }
#pragma unroll
                    for (int r = 0; r < 4; ++r) { const int s = 4 * g + r; const bool keep = dir ? (s >= l16) : (s <= l16); at[r] = keep ? at[r] : 0.f; }
                    u32x4 pa4; pa4.x = pk(at[0], at[1]); pa4.y = pk(at[2], at[3]); pa4.z = 0u; pa4.w = 0u; const s16x8 pa = __builtin_bit_cast(s16x8, pa4);
                    const u32x2 bv2 = *(const HG_LAS u32x2*)(lds + VT + (16 * w + l16) * PV + (64 * hh + tr + 4 * g) * 2);
                    u32x4 bv4; bv4.x = bv2.x; bv4.y = bv2.y; bv4.z = 0u; bv4.w = 0u; const s16x8 bv = __builtin_bit_cast(s16x8, bv4);
                    f32x4 o = O[cg];
                    o = __builtin_amdgcn_mfma_f32_16x16x32_bf16(pa, bv, o, 0, 0, 0);
#pragma unroll
                    for (int m = 0; m < 4; ++m) { u32x4 sb; sb.x = pk(St[2 * m][0], St[2 * m][1]); sb.y = pk(St[2 * m][2], St[2 * m][3]); sb.z = pk(St[2 * m + 1][0], St[2 * m + 1][1]); sb.w = pk(St[2 * m + 1][2], St[2 * m + 1][3]);
                        const u32x2 qa = *(const HG_LAS u32x2*)(lds + QT + (tr + l16) * PV + (32 * m + 4 * g) * 2), qb = *(const HG_LAS u32x2*)(lds + QT + (tr + l16) * PV + (32 * m + 16 + 4 * g) * 2);
                        u32x4 qq; qq.x = qa.x; qq.y = qa.y; qq.z = qb.x; qq.w = qb.y;
                        o = __builtin_amdgcn_mfma_f32_16x16x32_bf16(__builtin_bit_cast(s16x8, qq), __builtin_bit_cast(s16x8, sb), o, 0, 0, 0); }
                    O[cg] = o;
#pragma unroll
                    for (int i = 0; i < 8; ++i) { const f32x4 dv = *(const HG_LAS f32x4*)(lds + DCH + ch * 512 + (16 * i + 4 * g) * 4);
                        const u32x2 a2 = *(const HG_LAS u32x2*)(lds + KPT + (16 * i + l16) * KPP + (tr + 4 * g) * 2);
                        u32x4 a4; a4.x = a2.x; a4.y = a2.y; a4.z = 0u; a4.w = 0u;
                        St[i] = __builtin_amdgcn_mfma_f32_16x16x32_bf16(__builtin_bit_cast(s16x8, a4), bv, St[i] * dv, 0, 0, 0); }
                }
                __syncthreads();
            }
        }
#pragma unroll
        for (int cg = 0; cg < 8; ++cg)
#pragma unroll
            for (int r = 0; r < 4; ++r) { const float s = row16_sum(O[cg][r] * O[cg][r]); if (l16 == 0) *(HG_LAS float*)(lds + NRM + w * 512 + (16 * cg + 4 * g + r) * 4) = s; }
        __syncthreads();
        if (tid < 128) { float s = 0.f;
#pragma unroll
            for (int ww = 0; ww < 8; ++ww) s += *(HG_LAS float*)(lds + NRM + ww * 512 + tid * 4);
            *(HG_LAS float*)(lds + RSTD + tid * 4) = 1.0f / sqrtf(s * (1.0f / 128.0f) + 1e-6f); }
        __syncthreads();
        {
            const float gw = gnw[16 * w + l16];
            const float* sgb = SGt + (size_t)tok0 * HW + h * 128 + 16 * w; const int slo = 4 * g * HW + l16;
            unsigned short* mb = MIX + (size_t)tok0 * 2048 + 768 + h * 128 + 16 * w; const int mlo = 4 * g * 2048 + l16;
            asm volatile("" ::: "memory");
#pragma unroll
            for (int cg = 0; cg < 8; ++cg) { const f32x4 rs = *(const HG_LAS f32x4*)(lds + RSTD + (16 * cg + 4 * g) * 4);
#pragma unroll
                for (int r = 0; r < 4; ++r) {
                    const float y = O[cg][r] * rs[r] * gw * (sgb + (16 * cg + r) * HW)[slo];
                    (mb + (16 * cg + r) * 2048)[mlo] = (unsigned short)(pk(y, 0.f) & 0xffffu); } }
        }
        __syncthreads();
    }
}
#undef HG_DPP_ADD
}

constexpr int NWAVES = 8;
#ifndef MK_SPLIT
#define MK_SPLIT 0
#endif
constexpr int S = 8192, DM = 2048, DFF = 5632, DIN = 5120, NL = 4;
constexpr int NGU = 2 * DFF;
constexpr float EPS = 1e-6f;
constexpr size_t MiB = 1u << 20;
constexpr size_t WS_CTL = 0, CTL_ZERO_BYTES = 1 * MiB;
constexpr size_t WS_TAB = 1 * MiB;
constexpr size_t TAB_RT = 0, TAB_CT = 16384, TAB_TB = 24576, TAB_LB = 40960;
constexpr size_t WS_W = 2 * MiB;
constexpr size_t W_GU1 = 0, W_DN1 = 44 * MiB, W_WIN = 66 * MiB, W_WOUT = 86 * MiB, W_GU2 = 94 * MiB, W_DN2 = 138 * MiB, W_LAYER = 160 * MiB;
constexpr size_t WS_X = WS_W + NL * W_LAYER;
constexpr size_t WS_Y = WS_X + 64 * MiB;
constexpr size_t WS_H = WS_Y + 64 * MiB;
constexpr size_t WS_ACT = WS_H + 32 * MiB;
constexpr size_t WS_MIX = WS_ACT + 88 * MiB;
constexpr size_t WS_AQ = WS_MIX + 32 * MiB, WS_AK = WS_AQ + 12 * MiB, WS_AV = WS_AK + 4 * MiB, WS_CQ = WS_AV + 4 * MiB, WS_CK = WS_CQ + 12 * MiB, WS_CV = WS_CK + 4 * MiB;
constexpr size_t WS_B = WS_CV + 4 * MiB;
constexpr size_t BSZ = 16 * MiB;
constexpr size_t WS_SS = WS_B + 9 * BSZ;
constexpr size_t WS_DG = WS_SS + 32 * MiB;
constexpr size_t WS_END = WS_DG + 1 * MiB;
constexpr int CW_BAR = 4096;
constexpr int RING_OFF = 0, RING_BYTES = 131072;
constexpr int LDSCTL_OFF = RING_BYTES, MISC_OFF = LDSCTL_OFF + 320;
constexpr int LDS_BYTES = 147456;

#define GAS __attribute__((address_space(1)))
#define LAS __attribute__((address_space(3)))
typedef unsigned short bf16;
typedef unsigned v4u __attribute__((ext_vector_type(4)));
typedef unsigned v2u __attribute__((ext_vector_type(2)));
typedef float f32x4 __attribute__((ext_vector_type(4)));
typedef GAS unsigned gu32;
#define RLX_AGENT __ATOMIC_RELAXED, __HIP_MEMORY_SCOPE_AGENT
#define LDS_WAIT() asm volatile("s_waitcnt lgkmcnt(0)" ::: "memory")
#define VM_WAIT() asm volatile("s_waitcnt vmcnt(0)" ::: "memory")
__device__ __forceinline__ unsigned f2bf(float f) { unsigned u = __builtin_bit_cast(unsigned, f); return (u + 0x7fffu + ((u >> 16) & 1u)) >> 16; }
__device__ __forceinline__ unsigned pk2(float lo, float hi) { return f2bf(lo) | (f2bf(hi) << 16); }
__device__ __forceinline__ float bf2f(bf16 b) { return __uint_as_float((unsigned)b << 16); }

#define XB_TMO      128
#define XB_XCNT(j)  (256  + 64 * (j))
#define XB_XSUB(j)  (1280 + 64 * (j))
#define XB_XGEN(j)  (2304 + 64 * (j))
#define XB_TOP      3328
#define XB_TOPGEN   3392
#define XCD_BAR_WORDS 3456
#define XB_SPIN_CAP (1u << 18)

__device__ __forceinline__ unsigned xb_ld(unsigned* p)              { return __hip_atomic_load(p, __ATOMIC_RELAXED, __HIP_MEMORY_SCOPE_AGENT); }
__device__ __forceinline__ unsigned xb_add(unsigned* p, unsigned v) { return __hip_atomic_fetch_add(p, v, __ATOMIC_RELAXED, __HIP_MEMORY_SCOPE_AGENT); }
__device__ __forceinline__ unsigned xb_xcc_id() { return (unsigned)__builtin_amdgcn_s_getreg((3 << 11) | 20) & 0xFu; }
#define XB_SPIN(cond, bar) do { unsigned _sp = 0; while (cond) { __builtin_amdgcn_s_sleep(1); \
    if ((++_sp & 255u) == 0u) { if (xb_ld(&(bar)[XB_TMO])) break; if (_sp > XB_SPIN_CAP) { atomicAdd(&(bar)[XB_TMO], 1u); break; } } } } while (0)

struct XcdBarrier {
    unsigned* bar; unsigned x;
    volatile LAS unsigned* st;
};

__device__ __forceinline__ XcdBarrier xcd_barrier_post(unsigned* bar, volatile LAS unsigned* st) {
    XcdBarrier b; b.bar = bar; b.x = xb_xcc_id(); b.st = st;
    if (threadIdx.x == 0) (void)xb_add(&bar[XB_XCNT(b.x)], 1u);
    return b;
}
__device__ __forceinline__ void xcd_barrier_complete(unsigned* bar, unsigned x, unsigned& nloc, unsigned& nx) {
    const unsigned G = gridDim.x * gridDim.y * gridDim.z;
    unsigned sum, cnt, mine, sp = 0u;
    for (;;) {
        sum = 0u; cnt = 0u; mine = 0u;
#pragma unroll
        for (unsigned j = 0; j < 16; ++j) { const unsigned c = xb_ld(&bar[XB_XCNT(j)]); sum += c; cnt += (c > 0u) ? 1u : 0u; mine = (j == x) ? c : mine; }
        if (sum == G) break;
        __builtin_amdgcn_s_sleep(1);
        if ((++sp & 255u) == 0u) { if (xb_ld(&bar[XB_TMO])) break; if (sp > XB_SPIN_CAP) { atomicAdd(&bar[XB_TMO], 1u); break; } }
    }
    nloc = mine > 0u ? mine : 1u; nx = cnt > 0u ? cnt : 1u;
}

__device__ __forceinline__ void xcd_barrier(const XcdBarrier& b) {
    asm volatile("s_waitcnt vmcnt(0)" ::: "memory");
    __syncthreads();
    if (threadIdx.x == 0) {
        unsigned* bar = b.bar;
        __builtin_amdgcn_s_waitcnt(0);
        unsigned nloc = b.st[0], nx = b.st[1];
        if (nloc == 0u) { xcd_barrier_complete(bar, b.x, nloc, nx); b.st[0] = nloc; b.st[1] = nx; }
        const unsigned old = xb_add(&bar[XB_XSUB(b.x)], 1u);
        const unsigned gen = old / nloc;
        if (old + 1u == (gen + 1u) * nloc) {
            __builtin_amdgcn_fence(__ATOMIC_RELEASE, "agent");
            asm volatile("s_waitcnt vmcnt(0)" ::: "memory");
            const unsigned og = xb_add(&bar[XB_TOP], 1u);
            const unsigned tg = og / nx;
            if (og + 1u == (tg + 1u) * nx) xb_add(&bar[XB_TOPGEN], 1u);
            else XB_SPIN(xb_ld(&bar[XB_TOPGEN]) == tg, bar);
            __builtin_amdgcn_fence(__ATOMIC_ACQUIRE, "agent");
            xb_add(&bar[XB_XGEN(b.x)], 1u);
            asm volatile("s_waitcnt vmcnt(0)" ::: "memory");
        } else {
            XB_SPIN(xb_ld(&bar[XB_XGEN(b.x)]) == gen, bar);
            __builtin_amdgcn_fence(__ATOMIC_ACQUIRE, "agent");
            asm volatile("s_waitcnt vmcnt(0)" ::: "memory");
        }
    }
    __syncthreads();
}


struct Frame {
    LAS unsigned char* lds;
    volatile LAS unsigned* MISC;
    gu32* ctl;
    int tid, lane, wave, vcu, G;
};
__device__ __forceinline__ float wave_sum(float v) {
#pragma unroll
    for (int o = 1; o < 64; o <<= 1) v += __shfl_xor(v, o);
    return v;
}
__device__ __forceinline__ float wave_max(float v) {
#pragma unroll
    for (int o = 1; o < 64; o <<= 1) v = fmaxf(v, __shfl_xor(v, o));
    return v;
}
#define DPP_ADD(v, ctrl) v += __builtin_bit_cast(float, __builtin_amdgcn_update_dpp(0, __builtin_bit_cast(int, v), ctrl, 0xF, 0xF, true))
__device__ __forceinline__ float wave_sum_fast(float v) {
    DPP_ADD(v, 0xB1); DPP_ADD(v, 0x4E); DPP_ADD(v, 0x124); DPP_ADD(v, 0x128);
    { auto rr = __builtin_amdgcn_permlane16_swap(__float_as_uint(v), __float_as_uint(v), false, false); v = __uint_as_float(rr[0]) + __uint_as_float(rr[1]); }
    { auto rr = __builtin_amdgcn_permlane32_swap(__float_as_uint(v), __float_as_uint(v), false, false); v = __uint_as_float(rr[0]) + __uint_as_float(rr[1]); }
    return v;
}

__device__ __forceinline__ void p0_transpose_item(const float* W, int K, int N, bf16* WT, int k0, int n0, int drow, LAS float* scr, int lane) {
#pragma unroll 8
    for (int i = 0; i < 32; ++i) { const int kk = 2 * i + (lane >> 5); scr[kk * 33 + (lane & 31)] = W[(size_t)(k0 + kk) * N + n0 + (lane & 31)]; }
    LDS_WAIT(); asm volatile("" ::: "memory");
    const int c = lane & 7;
#pragma unroll
    for (int j = 0; j < 4; ++j) { const int n = (lane >> 3) + 8 * j; const LAS float* s = scr + (8 * c) * 33 + n;
        v4u o; o.x = pk2(s[0 * 33], s[1 * 33]); o.y = pk2(s[2 * 33], s[3 * 33]); o.z = pk2(s[4 * 33], s[5 * 33]); o.w = pk2(s[6 * 33], s[7 * 33]);
        *(GAS v4u*)(WT + (size_t)(drow + n) * K + k0 + 8 * c) = o; }
    LDS_WAIT(); asm volatile("" ::: "memory");
}
__device__ __forceinline__ int t5_bucket(int rel) {
    const int n = rel < 0 ? -rel : rel;
    int b;
    if (n < 8) b = n; else { const int lg = 31 - __builtin_clz((unsigned)(n * n)); b = 8 + (lg - 6); if (b > 15) b = 15; }
    return (rel > 0 ? 16 : 0) + b;
}

struct Args { const float* in[15]; float* out; unsigned char* ws; int ph_lo, ph_hi; };

__device__ __forceinline__ void row_phase(const Frame& F, const float* X, const float* Y, float* Xout, bf16* Hout, const float* wpost, const float* wnext, float coef) {
    const int gw = F.vcu * NWAVES + F.wave, NGW = F.G * NWAVES;
    for (int r = gw; r < S; r += NGW) {
        const GAS f32x4* yr = (const GAS f32x4*)(Y + (size_t)r * DM) + F.lane; const GAS f32x4* xr = (const GAS f32x4*)(X + (size_t)r * DM) + F.lane;
        f32x4 y[8], x[8]; float s = 0.f;
#pragma unroll
        for (int j = 0; j < 8; ++j) { y[j] = yr[64 * j]; x[j] = xr[64 * j]; s += (y[j].x * y[j].x + y[j].y * y[j].y) + (y[j].z * y[j].z + y[j].w * y[j].w); }
        const float r1 = coef / sqrtf(wave_sum(s) * (1.f / DM) + EPS); float s2 = 0.f;
        GAS f32x4* xo = (GAS f32x4*)(Xout + (size_t)r * DM) + F.lane;
#pragma unroll
        for (int j = 0; j < 8; ++j) { const f32x4 w = *((const GAS f32x4*)wpost + F.lane + 64 * j); x[j] = x[j] + y[j] * r1 * w; xo[64 * j] = x[j];
            s2 += (x[j].x * x[j].x + x[j].y * x[j].y) + (x[j].z * x[j].z + x[j].w * x[j].w); }
        if (Hout) { const float r2 = 1.f / sqrtf(wave_sum(s2) * (1.f / DM) + EPS);
            GAS v2u* ho = (GAS v2u*)(Hout + (size_t)r * DM) + F.lane;
#pragma unroll
            for (int j = 0; j < 8; ++j) { const f32x4 w = *((const GAS f32x4*)wnext + F.lane + 64 * j); const f32x4 v = x[j] * r2 * w; v2u o; o.x = pk2(v.x, v.y); o.y = pk2(v.z, v.w); ho[64 * j] = o; } }
    }
}
__device__ __forceinline__ void row_first(const Frame& F, const float* Xin, float* Xout, bf16* Hout, const float* wnext) {
    const int gw = F.vcu * NWAVES + F.wave, NGW = F.G * NWAVES;
    for (int r = gw; r < S; r += NGW) {
        const GAS f32x4* xr = (const GAS f32x4*)(Xin + (size_t)r * DM) + F.lane; GAS f32x4* xo = (GAS f32x4*)(Xout + (size_t)r * DM) + F.lane;
        f32x4 x[8]; float s2 = 0.f;
#pragma unroll
        for (int j = 0; j < 8; ++j) { x[j] = xr[64 * j]; xo[64 * j] = x[j]; s2 += (x[j].x * x[j].x + x[j].y * x[j].y) + (x[j].z * x[j].z + x[j].w * x[j].w); }
        const float r2 = 1.f / sqrtf(wave_sum(s2) * (1.f / DM) + EPS);
        GAS v2u* ho = (GAS v2u*)(Hout + (size_t)r * DM) + F.lane;
#pragma unroll
        for (int j = 0; j < 8; ++j) { const f32x4 w = *((const GAS f32x4*)wnext + F.lane + 64 * j); const f32x4 v = x[j] * r2 * w; v2u o; o.x = pk2(v.x, v.y); o.y = pk2(v.z, v.w); ho[64 * j] = o; }
    }
}

#define WSL() ({ GAS unsigned char* p_ = (GAS unsigned char*)args.ws; asm volatile("" : "+s"(p_)); (unsigned char*)p_; })
#define BID() ({ int b_ = (int)blockIdx.x; asm volatile("" : "+s"(b_)); b_; })
#define GRD() ({ int g_ = (int)gridDim.x; asm volatile("" : "+s"(g_)); g_; })
#define INP(i) ({ int i_ = (i); asm volatile("" : "+s"(i_)); (const float*)(const GAS float*)args.in[i_]; })
#define PHASE_FRAME() Frame F = F0; { asm volatile("" : "+s"(F.vcu), "+s"(F.G)); int t_ = threadIdx.x; asm volatile("" : "+v"(t_)); F.tid = t_; F.lane = t_ & 63; F.wave = __builtin_amdgcn_readfirstlane(t_ >> 6); }
__global__ void __launch_bounds__(NWAVES * 64, 2) fwd(Args args) {
    extern __shared__ __attribute__((aligned(16))) unsigned char lds[];
    Frame F0;
    F0.lds = (LAS unsigned char*)lds;
    F0.MISC = (volatile LAS unsigned*)(F0.lds + MISC_OFF);
    F0.tid = threadIdx.x; F0.lane = F0.tid & 63; F0.wave = __builtin_amdgcn_readfirstlane(F0.tid >> 6);
    F0.G = gridDim.x; { const int bx = blockIdx.x; F0.vcu = (F0.G % 8 == 0) ? (bx % 8) * (F0.G / 8) + bx / 8 : bx; }
    F0.ctl = (gu32*)(args.ws + WS_CTL);
    for (int u = F0.tid; u < (LDS_BYTES - LDSCTL_OFF) / 4; u += NWAVES * 64) ((LAS unsigned*)(F0.lds + LDSCTL_OFF))[u] = 0u;
    __syncthreads();
    const int lo = args.ph_lo, hi = args.ph_hi;
    XcdBarrier bar; bar.bar = (unsigned*)(F0.ctl + CW_BAR); bar.x = 0; bar.st = nullptr;
    if (hi - lo > 1) bar = xcd_barrier_post((unsigned*)(F0.ctl + CW_BAR), F0.MISC + 8);
    int ph = 0;
#define PH_ON (lo <= ph && ph < hi)
#define PH_END do { if (lo <= ph && ph + 1 < hi) { XcdBarrier b2_ = bar; { GAS unsigned* bp_ = (GAS unsigned*)bar.bar; asm volatile("" : "+s"(bp_), "+s"(b2_.x)); b2_.bar = (unsigned*)bp_; } xcd_barrier(b2_); } ++ph; } while (0)

    if (PH_ON) {
        PHASE_FRAME(); unsigned char* ws = WSL();
        const float* w_in = INP(1); const float* w_out = INP(2); const float* f1g = INP(3); const float* f1u = INP(4); const float* f1d = INP(5);
        const float* f2g = INP(6); const float* f2u = INP(7); const float* f2d = INP(8);
        LAS float* scr = (LAS float*)(F.lds + RING_OFF + F.wave * 16384);
        const int gw = F.vcu * NWAVES + F.wave, NGW = F.G * NWAVES;
        constexpr int I_G = (DM / 64) * (DFF / 32), I_D = (DFF / 64) * (DM / 32), I_IN = (DM / 64) * (DIN / 32), I_OUT = (DM / 64) * (DM / 32);
        constexpr int I_LAYER = 6 * I_G + I_IN + I_OUT;
        static_assert(I_D == I_G, "item counts");
        for (int it = gw; it < NL * I_LAYER; it += NGW) {
            const int l = it / I_LAYER; int r = it - l * I_LAYER;
            unsigned char* wl = ws + WS_W + (size_t)l * W_LAYER;
            if (r < 2 * I_G || (r >= 3 * I_G + I_IN + I_OUT && r < 5 * I_G + I_IN + I_OUT)) {
                const bool second = r >= 2 * I_G; if (second) r -= 3 * I_G + I_IN + I_OUT;
                const bool up = r >= I_G; if (up) r -= I_G;
                const float* W = (second ? (up ? f2u : f2g) : (up ? f1u : f1g)) + (size_t)l * DM * DFF;
                const int nblk = DFF / 32, kb = r / nblk, nb = r - kb * nblk, n0 = 32 * nb;
                const int drow = (n0 >> 7) * 256 + (n0 & 127) + (up ? 128 : 0);
                p0_transpose_item(W, DM, DFF, (bf16*)(wl + (second ? W_GU2 : W_GU1)), 64 * kb, n0, drow, scr, F.lane);
            } else if (r < 3 * I_G) {
                r -= 2 * I_G; const int nblk = DM / 32, kb = r / nblk, nb = r - kb * nblk;
                p0_transpose_item(f1d + (size_t)l * DFF * DM, DFF, DM, (bf16*)(wl + W_DN1), 64 * kb, 32 * nb, 32 * nb, scr, F.lane);
            } else if (r < 3 * I_G + I_IN) {
                r -= 3 * I_G; const int nblk = DIN / 32, kb = r / nblk, nb = r - kb * nblk, n0 = 32 * nb, tile = n0 >> 8, q = n0 & 255;
                const int qq = (tile >= 15 && tile <= 18) ? (((q & 63) >> 5) * 128 + (q >> 6) * 32) : q;
                p0_transpose_item(w_in + (size_t)l * DM * DIN, DM, DIN, (bf16*)(wl + W_WIN), 64 * kb, n0, tile * 256 + qq, scr, F.lane);
            } else if (r < 3 * I_G + I_IN + I_OUT) {
                r -= 3 * I_G + I_IN; const int nblk = DM / 32, kb = r / nblk, nb = r - kb * nblk;
                p0_transpose_item(w_out + (size_t)l * DM * DM, DM, DM, (bf16*)(wl + W_WOUT), 64 * kb, 32 * nb, 32 * nb, scr, F.lane);
            } else {
                r -= 5 * I_G + I_IN + I_OUT; const int nblk = DM / 32, kb = r / nblk, nb = r - kb * nblk;
                p0_transpose_item(f2d + (size_t)l * DFF * DM, DFF, DM, (bf16*)(wl + W_DN2), 64 * kb, 32 * nb, 32 * nb, scr, F.lane);
            }
        }
        {
            float* rtab = (float*)(ws + WS_TAB + TAB_RT); float* ctab = (float*)(ws + WS_TAB + TAB_CT); float* tbt = (float*)(ws + WS_TAB + TAB_TB); float* lbs = (float*)(ws + WS_TAB + TAB_LB);
            const float* hg_lb = INP(12); const float* rel_b = INP(14);
            const int gid = F.vcu * (NWAVES * 64) + F.tid;
            if (gid < 3072) {
                const int pos = gid >> 4, j = gid & 15; const int p = pos < 128 ? pos : pos - 128;
                const float inv = 1.0f / exp2f((float)j * (1.0f / 16.0f) * 13.287712379549449f);
                const float ang = (float)p * inv;
                double rev = (double)ang * 0.15915494309189535; rev -= rint(rev); const float rv = (float)rev;
                float* dst = (pos < 128 ? rtab + pos * 32 : ctab + p * 32) + 2 * j;
                dst[0] = __builtin_amdgcn_cosf(rv); dst[1] = __builtin_amdgcn_sinf(rv);
            }
            if (gid < 12 * 257) { const int h = gid / 257, r = gid - h * 257; tbt[h * 260 + r] = rel_b[t5_bucket(r - 128) * 12 + h] * pg8::LOG2E; }
            if (gid < 1024) {
                float v[NL], mx = -INFINITY;
#pragma unroll
                for (int l = 0; l < NL; ++l) { v[l] = hg_lb[l * 1024 + gid]; mx = fmaxf(mx, v[l]); }
                float sum = 0.f;
#pragma unroll
                for (int l = 0; l < NL; ++l) { v[l] = __expf(v[l] - mx); sum += v[l]; }
                float c = 0.f; lbs[gid] = 0.f;
#pragma unroll
                for (int l = 1; l < NL; ++l) { c += v[l] / sum; lbs[l * 1024 + gid] = c; }
            }
        }
        row_first(F, INP(0), (float*)(ws + WS_X), (bf16*)(ws + WS_H), INP(9));
    }
    PH_END;

    for (int l = 0; l < NL; ++l) {
        if (PH_ON) { unsigned char* ws = WSL(); const unsigned char* wl = ws + WS_W + (size_t)l * W_LAYER;
            pg8::Gemm g{(const bf16*)(ws + WS_H), (const bf16*)(wl + W_GU1), S, NGU, DM}; pg8::StaticOrder so; so.init(S, NGU, GRD(), BID());
            pg8::EpiSwiGLU E{(bf16*)(ws + WS_ACT), DFF}; pg8::gemm_phase<pg8::EpiSwiGLU, pg8::StaticOrder, true, true>(F0.lds + RING_OFF, g, so, E); }
        PH_END;
        if (PH_ON) { unsigned char* ws = WSL(); const unsigned char* wl = ws + WS_W + (size_t)l * W_LAYER;
            pg8::Gemm g{(const bf16*)(ws + WS_ACT), (const bf16*)(wl + W_DN1), S, DM, DFF}; pg8::StaticOrder so; so.init(S, DM, GRD(), BID());
            pg8::EpiF32 E{(float*)(ws + WS_Y), DM}; pg8::gemm_phase<pg8::EpiF32, pg8::StaticOrder, true, true>(F0.lds + RING_OFF, g, so, E); }
        PH_END;
        if (PH_ON) { PHASE_FRAME(); unsigned char* ws = WSL(); const float* nw = INP(9) + (size_t)l * 6 * DM;
            row_phase(F, (float*)(ws + WS_X), (float*)(ws + WS_Y), (float*)(ws + WS_X), (bf16*)(ws + WS_H), nw + 1 * DM, nw + 2 * DM, 0.5f); }
        PH_END;
        if (PH_ON) { unsigned char* ws = WSL(); const unsigned char* wl = ws + WS_W + (size_t)l * W_LAYER;
            pg8::Gemm g{(const bf16*)(ws + WS_H), (const bf16*)(wl + W_WIN), S, DIN, DM}; pg8::StaticOrder so; so.init(S, DIN, GRD(), BID());
            float* Bb = (float*)(ws + WS_B); constexpr size_t BE = BSZ / 4;
            pg8::EpiWin E{(bf16*)(ws + WS_AQ), (bf16*)(ws + WS_AK), (bf16*)(ws + WS_AV), (bf16*)(ws + WS_CQ), (bf16*)(ws + WS_CK), (bf16*)(ws + WS_CV),
                          Bb, Bb + BE, Bb + 2 * BE, Bb + 3 * BE, Bb + 4 * BE, Bb + 5 * BE, Bb + 6 * BE,
                          (const float*)(ws + WS_TAB + TAB_LB) + l * 1024, INP(11) + l * 128, (const float*)(ws + WS_TAB + TAB_RT), (const float*)(ws + WS_TAB + TAB_CT)};
            pg8::gemm_phase<pg8::EpiWin, pg8::StaticOrder, true, true>(F0.lds + RING_OFF, g, so, E); }
        PH_END;
        if (PH_ON) {
            { unsigned char* ws = WSL(); float* Bb = (float*)(ws + WS_B); constexpr size_t BE = BSZ / 4;
              hg::pass1(GRD(), BID(), Bb + 2 * BE, Bb + BE, Bb + 4 * BE, Bb + 3 * BE, Bb + 5 * BE, Bb + 7 * BE, (float*)(ws + WS_DG), F0.lds + RING_OFF); }
            { unsigned char* ws = WSL();
              const attn_body::bf16* CQ = (const attn_body::bf16*)(ws + WS_CQ); const attn_body::bf16* CK = (const attn_body::bf16*)(ws + WS_CK); const attn_body::bf16* CV = (const attn_body::bf16*)(ws + WS_CV);
              attn_body::bf16* MIXo = (attn_body::bf16*)(ws + WS_MIX);
              const int gA = GRD(); for (int u = BID(); u < 384; u += gA) { const int h = u >> 5, qb = u & 31, kvh = h / 3;
                attn_body::attn_unit<8, 768, 256, 2048, 0>(qb * 256, S / 64, CQ + h * 64, CK + kvh * 64, CV + kvh * 64, MIXo + 1280 + h * 64, (char*)lds + RING_OFF); } }
            { unsigned char* ws = WSL();
              const attn_body::bf16* AQp = (const attn_body::bf16*)(ws + WS_AQ); const attn_body::bf16* AKp = (const attn_body::bf16*)(ws + WS_AK); const attn_body::bf16* AVp = (const attn_body::bf16*)(ws + WS_AV);
              attn_body::bf16* MIXo = (attn_body::bf16*)(ws + WS_MIX); const float* tbp = (const float*)(ws + WS_TAB + TAB_TB); const float* skp = INP(10) + l * 12;
              const int gB = GRD(); for (int u = BID(); u < 384; u += gB) { const int h = u >> 5, qb = u & 31, kvh = h / 3;
                const int t_lo = qb * 4 - 2 < 0 ? 0 : qb * 4 - 2, t_hi = qb * 4 + 6 > S / 64 ? S / 64 : qb * 4 + 6;
                attn_body::attn_unit<8, 768, 256, 2048, 1>(qb * 256, t_hi - t_lo, AQp + h * 64, AKp + kvh * 64 + (size_t)t_lo * 64 * 256, AVp + kvh * 64 + (size_t)t_lo * 64 * 256, MIXo + h * 64, (char*)lds + RING_OFF,
                                                           tbp + h * 260, skp[h] * pg8::LOG2E, t_lo * 64); } }
        }
        PH_END;
        if (PH_ON) { unsigned char* ws = WSL(); hg::scan(GRD(), ({ int v_ = F0.vcu; asm volatile("" : "+s"(v_)); v_; }), (const float*)(ws + WS_B + 7 * BSZ), (const float*)(ws + WS_DG), (float*)(ws + WS_SS)); }
        PH_END;
        if (PH_ON) { unsigned char* ws = WSL(); float* Bb = (float*)(ws + WS_B); constexpr size_t BE = BSZ / 4;
            hg::pass2(GRD(), BID(), Bb, Bb + BE, Bb + 2 * BE, Bb + 3 * BE, Bb + 4 * BE, Bb + 5 * BE, Bb + 6 * BE, (const float*)(ws + WS_SS), INP(13) + l * 128, (bf16*)(ws + WS_MIX), F0.lds + RING_OFF); }
        PH_END;
        if (PH_ON) { unsigned char* ws = WSL(); const unsigned char* wl = ws + WS_W + (size_t)l * W_LAYER;
            pg8::Gemm g{(const bf16*)(ws + WS_MIX), (const bf16*)(wl + W_WOUT), S, DM, DM}; pg8::StaticOrder so; so.init(S, DM, GRD(), BID());
            pg8::EpiF32 E{(float*)(ws + WS_Y), DM}; pg8::gemm_phase<pg8::EpiF32, pg8::StaticOrder, true, true>(F0.lds + RING_OFF, g, so, E); }
        PH_END;
        if (PH_ON) { PHASE_FRAME(); unsigned char* ws = WSL(); const float* nw = INP(9) + (size_t)l * 6 * DM;
            row_phase(F, (float*)(ws + WS_X), (float*)(ws + WS_Y), (float*)(ws + WS_X), (bf16*)(ws + WS_H), nw + 3 * DM, nw + 4 * DM, 1.0f); }
        PH_END;
        if (PH_ON) { unsigned char* ws = WSL(); const unsigned char* wl = ws + WS_W + (size_t)l * W_LAYER;
            pg8::Gemm g{(const bf16*)(ws + WS_H), (const bf16*)(wl + W_GU2), S, NGU, DM}; pg8::StaticOrder so; so.init(S, NGU, GRD(), BID());
            pg8::EpiSwiGLU E{(bf16*)(ws + WS_ACT), DFF}; pg8::gemm_phase<pg8::EpiSwiGLU, pg8::StaticOrder, true, true>(F0.lds + RING_OFF, g, so, E); }
        PH_END;
        if (PH_ON) { unsigned char* ws = WSL(); const unsigned char* wl = ws + WS_W + (size_t)l * W_LAYER;
            pg8::Gemm g{(const bf16*)(ws + WS_ACT), (const bf16*)(wl + W_DN2), S, DM, DFF}; pg8::StaticOrder so; so.init(S, DM, GRD(), BID());
            pg8::EpiF32 E{(float*)(ws + WS_Y), DM}; pg8::gemm_phase<pg8::EpiF32, pg8::StaticOrder, true, true>(F0.lds + RING_OFF, g, so, E); }
        PH_END;
        if (PH_ON) { PHASE_FRAME(); unsigned char* ws = WSL(); const float* nw = INP(9) + (size_t)l * 6 * DM; const bool lastl = (l == NL - 1);
            row_phase(F, (float*)(ws + WS_X), (float*)(ws + WS_Y), lastl ? (float*)(GAS float*)args.out : (float*)(ws + WS_X), lastl ? (bf16*)nullptr : (bf16*)(ws + WS_H), nw + 5 * DM, nw + 6 * DM, 0.5f); }
        PH_END;
    }
#undef PH_ON
#undef PH_END
}
constexpr int N_PHASES = 1 + NL * 12;

extern "C" void kernel_launch(void* const* d_in, const int* in_sizes, int n_in, void* d_out, int out_size, void* d_ws, size_t ws_size, hipStream_t stream) {
    static int grid = 0;
    if (grid == 0) {
        if (n_in != 15 || in_sizes[0] != S * DM || out_size != S * DM || ws_size < WS_END) { fprintf(stderr, "kernel_launch: unexpected shapes / workspace (n_in %d, in0 %d, out %d, ws %zu < %zu); nothing launched\n", n_in, n_in > 0 ? in_sizes[0] : -1, out_size, ws_size, (size_t)WS_END); grid = -1; return; }
        int dev = 0, cus = 0, per_cu = 0;
        if (hipGetDevice(&dev) != hipSuccess || hipDeviceGetAttribute(&cus, hipDeviceAttributeMultiprocessorCount, dev) != hipSuccess) { grid = -1; return; }
        if (hipFuncSetAttribute((const void*)fwd, hipFuncAttributeMaxDynamicSharedMemorySize, LDS_BYTES) != hipSuccess) { fprintf(stderr, "kernel_launch: hipFuncSetAttribute failed\n"); grid = -1; return; }
        if (hipOccupancyMaxActiveBlocksPerMultiprocessor(&per_cu, (const void*)fwd, NWAVES * 64, LDS_BYTES) != hipSuccess || per_cu < 1)
            fprintf(stderr, "kernel_launch: note: occupancy query reports %d workgroups per CU\n", per_cu);
        (void)hipGetLastError();
        grid = cus;
    }
    if (grid < 0) return;
    if (hipMemsetAsync((char*)d_ws + WS_CTL, 0, CTL_ZERO_BYTES, stream) != hipSuccess) { fprintf(stderr, "kernel_launch: memset failed\n"); return; }
    Args a{};
    for (int i = 0; i < 15; ++i) a.in[i] = (const float*)d_in[i];
    a.out = (float*)d_out; a.ws = (unsigned char*)d_ws;
#if MK_SPLIT
    for (int p = 0; p < N_PHASES; ++p) { a.ph_lo = p; a.ph_hi = p + 1; hipLaunchKernelGGL(fwd, dim3(grid), dim3(NWAVES * 64), LDS_BYTES, stream, a); }
#else
    a.ph_lo = 0; a.ph_hi = N_PHASES;
    hipLaunchKernelGGL(fwd, dim3(grid), dim3(NWAVES * 64), LDS_BYTES, stream, a);
#endif
    const hipError_t le = hipPeekAtLastError();
    if (le != hipSuccess) fprintf(stderr, "kernel_launch: launch failed: %s\n", hipGetErrorName(le));
}
```

```cpp
#include <hip/hip_runtime.h>
#include <hip/hip_bf16.h>
#include <cstdio>
#include <cstdint>
#include <cmath>
namespace pg8 {
#define PG8_LAS __attribute__((address_space(3)))
typedef unsigned short bf16_t;
typedef short bf16x8 __attribute__((ext_vector_type(8)));
typedef float f32x4 __attribute__((ext_vector_type(4)));
typedef unsigned u32x4 __attribute__((ext_vector_type(4)));
constexpr int BM = 256, BK = 64, HALF = 128, HTB = HALF * BK * 2  , STAGE_BYTES = 8 * HTB, NXCD = 8, WGM = 8;

__host__ __device__ __forceinline__ int lds_byte(int r, int c) { const int st = (r >> 4) * 2 + (c >> 5), rr = r & 15, cc = c & 31, ob = rr * 64 + cc * 2; return st * 1024 + (ob ^ (((ob >> 9) & 1) << 5)); }
__host__ __device__ __forceinline__ void stage_rc(int b, int& R, int& C) { const int st = b / 1024, sb = b % 1024, swz = sb ^ (((sb >> 9) & 1) << 5); R = (st >> 1) * 16 + swz / 64; C = (st & 1) * 32 + (swz % 64) / 2; }
__host__ __device__ __forceinline__ int perm32(int rho) { const int n = rho >> 4, i = rho & 15; return 8 * (i >> 2) + 4 * n + (i & 3); }

struct Unit { int pm, pn; };
struct Gemm { const bf16_t* A; const bf16_t* Bt; int M, N, K; };

struct StaticOrder {
    int nM, nN, nwg, G, c;
    __host__ __device__ void init(int M, int N, int G_, int c_) { nM = M / BM; nN = N / BM; nwg = nM * nN; G = G_; c = c_; }
    __host__ __device__ bool next(int i, Unit& u) const {
        const long L = (long)i * G + c; if (L >= nwg) return false;
        int wgid = (int)L; { const int q = nwg / NXCD, r = nwg % NXCD, xcd = wgid % NXCD, off = wgid / NXCD; wgid = (xcd < r ? xcd * (q + 1) : r * (q + 1) + (xcd - r) * q) + off; }
        const int nig = WGM * nN, gid = wgid / nig, fm = gid * WGM, gsz = (nM - fm) < WGM ? (nM - fm) : WGM;
        u.pm = fm + ((wgid % nig) % gsz); u.pn = (wgid % nig) / gsz; return true;
    }
    __device__ __forceinline__ void a_ready(const Unit&) const {}
    __device__ __forceinline__ void done(const Unit&) const {}
};

__device__ __forceinline__ unsigned cvt_pk_bf16(float lo, float hi) { unsigned r; asm volatile("v_cvt_pk_bf16_f32 %0, %1, %2" : "=v"(r) : "v"(lo), "v"(hi)); return r; }
typedef float f32x2 __attribute__((ext_vector_type(2)));
constexpr float LOG2E = 1.4426950408889634f;
constexpr float QSCALE = 0.125f * 1.4426950408889634f;
__device__ __forceinline__ float sigmoid_f(float x) { return __builtin_amdgcn_rcpf(1.0f + __builtin_amdgcn_exp2f(-LOG2E * x)); }

struct EpiF32 {
    static constexpr bool PERM = false, AFTER_DRAIN = false;
    float* C; int ldc;
    __device__ __forceinline__ void operator()(const f32x4 (&acc)[2][2][4][2], const Unit& u, int wr, int wc, int fr, int fq) const {
        const int row0 = u.pm * BM + wr * 64 + fr, col0 = u.pn * BM + wc * 32 + 4 * fq;
#pragma unroll
        for (int ai = 0; ai < 2; ++ai)
#pragma unroll
            for (int m = 0; m < 4; ++m) { float* rowp = C + (size_t)(row0 + ai * HALF + m * 16) * ldc + col0;
#pragma unroll
                for (int bj = 0; bj < 2; ++bj)
#pragma unroll
                    for (int n = 0; n < 2; ++n) *(f32x4*)(rowp + bj * HALF + n * 16) = acc[ai][bj][m][n]; }
    }
};

struct EpiSwiGLU {
    static constexpr bool PERM = true, AFTER_DRAIN = false;
    bf16_t* O; int ldc;
    __device__ __forceinline__ void operator()(const f32x4 (&acc)[2][2][4][2], const Unit& u, int wr, int wc, int fr, int fq) const {
        const int row0 = u.pm * BM + wr * 64 + fr, col0 = u.pn * HALF + wc * 32 + 8 * fq;
#pragma unroll
        for (int ai = 0; ai < 2; ++ai)
#pragma unroll
            for (int m = 0; m < 4; ++m) { bf16_t* rowp = O + (size_t)(row0 + ai * HALF + m * 16) * ldc + col0;
                float o[8];
#pragma unroll
                for (int n = 0; n < 2; ++n)
#pragma unroll
                    for (int i = 0; i < 4; ++i) { const float g = acc[ai][0][m][n][i], up = acc[ai][1][m][n][i]; o[4 * n + i] = g * sigmoid_f(g) * up; }
                u32x4 w; w.x = cvt_pk_bf16(o[0], o[1]); w.y = cvt_pk_bf16(o[2], o[3]); w.z = cvt_pk_bf16(o[4], o[5]); w.w = cvt_pk_bf16(o[6], o[7]);
                *(u32x4*)rowp = w; }
    }
};

struct EpiWin {
    static constexpr bool PERM = true, AFTER_DRAIN = false;
    bf16_t *AQ, *AK, *AV, *CQ, *CK, *CV;
    float *BQ, *KF, *FF, *KB, *FB, *BI, *SG;
    const float* lb;
    const float* qkw;
    const float* rtab; const float* ctab;
    __device__ __forceinline__ void operator()(const f32x4 (&acc)[2][2][4][2], const Unit& u, int wr, int wc, int fr, int fq) const {
        const int pn = u.pn, row0 = u.pm * BM + wr * 64 + fr, cl = wc * 32 + 8 * fq;
        if (pn < 5 || pn == 19) {
            bf16_t* base; int ldc, colt; float sc = 1.f;
            if (pn < 3) { base = AQ; ldc = 768; colt = pn * 256; sc = QSCALE; } else if (pn == 3) { base = AK; ldc = 256; colt = 0; } else if (pn == 4) { base = AV; ldc = 256; colt = 0; } else { base = CV; ldc = 256; colt = 0; }
#pragma unroll
            for (int ai = 0; ai < 2; ++ai)
#pragma unroll
                for (int m = 0; m < 4; ++m) { bf16_t* rowp = base + (size_t)(row0 + ai * HALF + m * 16) * ldc + colt + cl;
#pragma unroll
                    for (int bj = 0; bj < 2; ++bj) { const f32x4 v0 = acc[ai][bj][m][0] * sc, v1 = acc[ai][bj][m][1] * sc;
                        u32x4 w; w.x = cvt_pk_bf16(v0[0], v0[1]); w.y = cvt_pk_bf16(v0[2], v0[3]); w.z = cvt_pk_bf16(v1[0], v1[1]); w.w = cvt_pk_bf16(v1[2], v1[3]);
                        *(u32x4*)(rowp + bj * HALF) = w; } }
        } else if (pn < 15) {
            const int sec = (pn - 5) >> 1, colt = ((pn - 5) & 1) * 256;
            float* o1 = sec == 0 ? BQ : sec == 1 ? KF : sec == 2 ? KB : sec == 3 ? BI : SG;
            float* o2 = sec == 1 ? FF : FB;
            const float* lbp = lb + (sec == 2 ? 512 : 0);
#pragma unroll
            for (int bj = 0; bj < 2; ++bj) {
                const int col = colt + bj * HALF + cl;
                f32x4 lv0 = (f32x4){0.f, 0.f, 0.f, 0.f}, lv1 = lv0;
                if (sec == 1 || sec == 2) { lv0 = *(const f32x4*)(lbp + col); lv1 = *(const f32x4*)(lbp + col + 4); }
#pragma unroll
                for (int ai = 0; ai < 2; ++ai)
#pragma unroll
                    for (int m = 0; m < 4; ++m) { const size_t off = (size_t)(row0 + ai * HALF + m * 16) * 512 + col;
                        const f32x4 a0 = acc[ai][bj][m][0], a1 = acc[ai][bj][m][1];
                        if (sec == 0 || sec == 4) { f32x4 r0, r1;
#pragma unroll
                            for (int i = 0; i < 4; ++i) { r0[i] = a0[i] * sigmoid_f(a0[i]); r1[i] = a1[i] * sigmoid_f(a1[i]); }
                            *(f32x4*)(o1 + off) = r0; *(f32x4*)(o1 + off + 4) = r1;
                        } else if (sec == 3) { *(f32x4*)(o1 + off) = a0; *(f32x4*)(o1 + off + 4) = a1;
                        } else { f32x4 k0, k1, f0, f1;
#pragma unroll
                            for (int i = 0; i < 4; ++i) { const float s0 = sigmoid_f(a0[i]), s1 = sigmoid_f(a1[i]), n0 = sigmoid_f(-a0[i]), n1 = sigmoid_f(-a1[i]);
                                f0[i] = lv0[i] + (1.f - lv0[i]) * s0; f1[i] = lv1[i] + (1.f - lv1[i]) * s1; k0[i] = (1.f - lv0[i]) * n0; k1[i] = (1.f - lv1[i]) * n1; }
                            *(f32x4*)(o1 + off) = k0; *(f32x4*)(o1 + off + 4) = k1; *(f32x4*)(o2 + off) = f0; *(f32x4*)(o2 + off + 4) = f1; } }
            }
        } else {
            const bool isq = pn < 18; bf16_t* base = isq ? CQ : CK; const int ldc = isq ? 768 : 256, head = (isq ? (pn - 15) * 4 : 0) + wc;
            const float* w = qkw + (isq ? 0 : 64); const float sc = isq ? QSCALE : 1.f;
            f32x4 wv[2][2];
#pragma unroll
            for (int bj = 0; bj < 2; ++bj)
#pragma unroll
                for (int n = 0; n < 2; ++n) wv[bj][n] = *(const f32x4*)(w + 32 * bj + 8 * fq + 4 * n) * sc;
#pragma unroll
            for (int ai = 0; ai < 2; ++ai)
#pragma unroll
                for (int m = 0; m < 4; ++m) { const int row = row0 + ai * HALF + m * 16;
                    float ss = 0.f;
#pragma unroll
                    for (int bj = 0; bj < 2; ++bj)
#pragma unroll
                        for (int n = 0; n < 2; ++n) { const f32x4 x = acc[ai][bj][m][n]; ss += (x[0] * x[0] + x[1] * x[1]) + (x[2] * x[2] + x[3] * x[3]); }
                    ss += __shfl_xor(ss, 16); ss += __shfl_xor(ss, 32);
                    const float r = 1.0f / sqrtf(ss * (1.0f / 64.0f) + 1e-6f);
                    bf16_t* rowp = base + (size_t)row * ldc + head * 64 + 8 * fq;
#pragma unroll
                    for (int bj = 0; bj < 2; ++bj) { const float* tab = bj == 0 ? rtab + (size_t)(row >> 6) * 32 : ctab + (size_t)(row & 63) * 32;
                        float o[8];
#pragma unroll
                        for (int n = 0; n < 2; ++n) { const f32x4 x = acc[ai][bj][m][n] * r * wv[bj][n]; const f32x4 cs = *(const f32x4*)(tab + (4 * fq + 2 * n) * 2);
                            o[4 * n + 0] = x[0] * cs[0] - x[1] * cs[1]; o[4 * n + 1] = x[0] * cs[1] + x[1] * cs[0];
                            o[4 * n + 2] = x[2] * cs[2] - x[3] * cs[3]; o[4 * n + 3] = x[2] * cs[3] + x[3] * cs[2]; }
                        u32x4 wd; wd.x = cvt_pk_bf16(o[0], o[1]); wd.y = cvt_pk_bf16(o[2], o[3]); wd.z = cvt_pk_bf16(o[4], o[5]); wd.w = cvt_pk_bf16(o[6], o[7]);
                        *(u32x4*)(rowp + 32 * bj) = wd; } }
        }
    }
};
template <class Epi, class Sched, bool ALIGN_EPI = false, bool SP2 = false>
__device__ __forceinline__ void gemm_phase(PG8_LAS unsigned char* lds, const Gemm g, const Sched& S, const Epi& E) {
    int tid_l = threadIdx.x; asm volatile("" : "+v"(tid_l)); const int tid = tid_l, wid = __builtin_amdgcn_readfirstlane(tid >> 6), lane = tid & 63, wr = wid >> 2, wc = wid & 3, fr = lane & 15, fq = lane >> 4;
    const int K = g.K, nt = K / BK;
    unsigned voffA[2], voffB[2];
#pragma unroll
    for (int i = 0; i < 2; ++i) { int R, C; stage_rc(tid * 16 + i * 8192, R, C); const int Rb = Epi::PERM ? ((R & ~31) + perm32(R & 31)) : R;
        voffA[i] = (unsigned)(R * K + C) * 2u; voffB[i] = (unsigned)(Rb * K + C) * 2u; }
    const size_t kstep = (size_t)(BK * 2);
    const size_t hstep = (size_t)HALF * K * 2;
    const size_t tstep = 2 * hstep;
    const unsigned ldsw = (unsigned)wid * 1024u;
    const int aoff = lds_byte(wr * 64 + fr, fq * 8), boff = lds_byte(wc * 32 + fr, fq * 8);
#define PG8_SA(b, h) (((b) * 2 + (h)) * HTB)
#define PG8_SB(b, h) ((4 + (b) * 2 + (h)) * HTB)
#define PG8_STAGE(bufoff, gbase, voff) do { _Pragma("unroll") for (int _i = 0; _i < 2; ++_i) \
        __builtin_amdgcn_global_load_lds((const unsigned*)((const char*)(gbase) + (voff)[_i]), (PG8_LAS unsigned*)(lds + (bufoff) + ldsw + _i * 8192), 16, 0, 0); } while (0)
#define PG8_LDA(dst, b, h) do { _Pragma("unroll") for (int m = 0; m < 4; ++m) _Pragma("unroll") for (int k = 0; k < 2; ++k) dst[m][k] = *(const PG8_LAS bf16x8*)(lds + PG8_SA(b, h) + aoff + m * 2048 + k * 1024); } while (0)
#define PG8_LDB(dst, b, h) do { _Pragma("unroll") for (int n = 0; n < 2; ++n) _Pragma("unroll") for (int k = 0; k < 2; ++k) dst[n][k] = *(const PG8_LAS bf16x8*)(lds + PG8_SB(b, h) + boff + n * 2048 + k * 1024); } while (0)
#define PG8_MMA(ai, bj, At, Bt) do { __builtin_amdgcn_s_setprio(1); _Pragma("unroll") for (int m = 0; m < 4; ++m) _Pragma("unroll") for (int n = 0; n < 2; ++n) _Pragma("unroll") for (int k = 0; k < 2; ++k) \
        acc[ai][bj][m][n] = __builtin_amdgcn_mfma_f32_16x16x32_bf16(Bt[n][k], At[m][k], acc[ai][bj][m][n], 0, 0, 0); __builtin_amdgcn_s_setprio(0); } while (0)
#define PG8_WAIT_V(n) asm volatile("s_waitcnt vmcnt(" #n ")" ::: "memory")
#define PG8_WAIT_L(n) asm volatile("s_waitcnt lgkmcnt(" #n ")" ::: "memory")
#define PG8_BAR __builtin_amdgcn_s_barrier()
#define PG8_SCHED __builtin_amdgcn_sched_barrier(0)
    Unit cur, nxt; int ui = 0;
    if (!S.next(0, cur)) return;
    f32x4 acc[2][2][4][2];
#pragma unroll
    for (int a = 0; a < 2; ++a)
#pragma unroll
        for (int b = 0; b < 2; ++b)
#pragma unroll
            for (int m = 0; m < 4; ++m)
#pragma unroll
                for (int n = 0; n < 2; ++n) acc[a][b][m][n] = (f32x4){0.f, 0.f, 0.f, 0.f};
    bf16x8 At[4][2], B0[2][2], B1[2][2];
    const char* cA = (const char*)g.A + (size_t)cur.pm * tstep; const char* cB = (const char*)g.Bt + (size_t)cur.pn * tstep;
    S.a_ready(cur);
    if constexpr (SP2) {
        PG8_STAGE(PG8_SB(0, 0), cB, voffB); PG8_STAGE(PG8_SB(0, 1), cB + hstep, voffB); PG8_STAGE(PG8_SA(0, 0), cA, voffA); PG8_STAGE(PG8_SA(0, 1), cA + hstep, voffA);
        if (wr == 1) PG8_BAR;
        PG8_WAIT_V(2); PG8_BAR;
        PG8_STAGE(PG8_SB(1, 0), cB + kstep, voffB); PG8_STAGE(PG8_SA(1, 0), cA + kstep, voffA); PG8_STAGE(PG8_SB(1, 1), cB + hstep + kstep, voffB);
        PG8_WAIT_V(6); PG8_BAR;
    } else {
        PG8_STAGE(PG8_SB(0, 0), cB, voffB); PG8_STAGE(PG8_SA(0, 0), cA, voffA); PG8_STAGE(PG8_SB(0, 1), cB + hstep, voffB); PG8_STAGE(PG8_SA(0, 1), cA + hstep, voffA);
        if (wr == 1) PG8_BAR;
        PG8_WAIT_V(4); PG8_BAR;
        PG8_STAGE(PG8_SB(1, 0), cB + kstep, voffB); PG8_STAGE(PG8_SA(1, 0), cA + kstep, voffA); PG8_STAGE(PG8_SB(1, 1), cB + hstep + kstep, voffB);
        PG8_WAIT_V(6); PG8_BAR;
    }
    for (;;) {
        const bool has_next = S.next(ui + 1, nxt);
        const char* nA = has_next ? (const char*)g.A + (size_t)nxt.pm * tstep : cA; const char* nB = has_next ? (const char*)g.Bt + (size_t)nxt.pn * tstep : cB;
        for (int t = 0; t < nt; t += 2) {
            const bool last = (t == nt - 2);
            const char* a1 = cA + (size_t)(t + 1) * kstep;
            const char* a2 = last ? nA : cA + (size_t)(t + 2) * kstep; const char* b2 = last ? nB : cB + (size_t)(t + 2) * kstep;
            const char* a3 = a2 + kstep; const char* b3 = b2 + kstep;
            if (last && has_next) S.a_ready(nxt);
            if constexpr (SP2) {
            PG8_LDB(B0, 0, 0); PG8_LDB(B1, 0, 1); PG8_SCHED; PG8_LDA(At, 0, 0); PG8_STAGE(PG8_SA(1, 1), a1 + hstep, voffA);
            PG8_WAIT_V(8); PG8_WAIT_L(0); PG8_BAR; PG8_MMA(0, 0, At, B0); PG8_MMA(0, 1, At, B1); PG8_BAR; PG8_SCHED;
            PG8_LDA(At, 0, 1); PG8_STAGE(PG8_SB(0, 0), b2, voffB); PG8_STAGE(PG8_SB(0, 1), b2 + hstep, voffB); PG8_STAGE(PG8_SA(0, 0), a2, voffA);
            PG8_WAIT_V(8); PG8_WAIT_L(0); PG8_BAR; PG8_MMA(1, 0, At, B0); PG8_MMA(1, 1, At, B1); PG8_BAR; PG8_SCHED;
            PG8_LDB(B0, 1, 0); PG8_LDB(B1, 1, 1); PG8_SCHED; PG8_LDA(At, 1, 0); PG8_STAGE(PG8_SA(0, 1), a2 + hstep, voffA);
            PG8_WAIT_V(8); PG8_WAIT_L(0); PG8_BAR; PG8_MMA(0, 0, At, B0); PG8_MMA(0, 1, At, B1); PG8_BAR; PG8_SCHED;
            PG8_LDA(At, 1, 1); PG8_STAGE(PG8_SB(1, 0), b3, voffB); PG8_STAGE(PG8_SB(1, 1), b3 + hstep, voffB); PG8_STAGE(PG8_SA(1, 0), a3, voffA);
            PG8_WAIT_V(8); PG8_WAIT_L(0); PG8_BAR; PG8_MMA(1, 0, At, B0); PG8_MMA(1, 1, At, B1); PG8_BAR; PG8_SCHED;
            } else {
            PG8_LDB(B0, 0, 0); PG8_SCHED; PG8_LDA(At, 0, 0); PG8_STAGE(PG8_SA(1, 1), a1 + hstep, voffA);
            PG8_WAIT_L(8); PG8_BAR; PG8_WAIT_L(0); PG8_MMA(0, 0, At, B0); PG8_BAR; PG8_SCHED;
            PG8_LDB(B1, 0, 1); PG8_STAGE(PG8_SB(0, 0), b2, voffB);
            PG8_BAR; PG8_WAIT_L(0); PG8_MMA(0, 1, At, B1); PG8_BAR;
            PG8_LDA(At, 0, 1); PG8_STAGE(PG8_SA(0, 0), a2, voffA);
            PG8_BAR; PG8_WAIT_L(0); PG8_MMA(1, 0, At, B0); PG8_BAR; PG8_SCHED;
            PG8_STAGE(PG8_SB(0, 1), b2 + hstep, voffB);
            PG8_WAIT_V(6); PG8_BAR; PG8_MMA(1, 1, At, B1); PG8_BAR;
            PG8_LDB(B0, 1, 0); PG8_SCHED; PG8_LDA(At, 1, 0); PG8_STAGE(PG8_SA(0, 1), a2 + hstep, voffA);
            PG8_WAIT_L(8); PG8_BAR; PG8_WAIT_L(0); PG8_MMA(0, 0, At, B0); PG8_BAR; PG8_SCHED;
            PG8_LDB(B1, 1, 1); PG8_STAGE(PG8_SB(1, 0), b3, voffB);
            PG8_BAR; PG8_WAIT_L(0); PG8_MMA(0, 1, At, B1); PG8_BAR;
            PG8_LDA(At, 1, 1); PG8_STAGE(PG8_SA(1, 0), a3, voffA);
            PG8_BAR; PG8_WAIT_L(0); PG8_MMA(1, 0, At, B0); PG8_BAR; PG8_SCHED;
            PG8_STAGE(PG8_SB(1, 1), b3 + hstep, voffB);
            PG8_WAIT_V(6); PG8_BAR; PG8_MMA(1, 1, At, B1); PG8_BAR;
            }
        }
        if constexpr (ALIGN_EPI) { if (wr == 0) PG8_BAR; }
        if constexpr (!Epi::AFTER_DRAIN) { E(acc, cur, wr, wc, fr, fq); S.done(cur); }
        if (!has_next) break;
#pragma unroll
        for (int a = 0; a < 2; ++a)
#pragma unroll
            for (int b = 0; b < 2; ++b)
#pragma unroll
                for (int m = 0; m < 4; ++m)
#pragma unroll
                    for (int n = 0; n < 2; ++n) acc[a][b][m][n] = (f32x4){0.f, 0.f, 0.f, 0.f};
        cur = nxt; cA = nA; cB = nB; ++ui;
        if constexpr (ALIGN_EPI) { if (wr == 1) PG8_BAR; }
    }
    PG8_WAIT_V(0);
    if constexpr (!ALIGN_EPI) { if (wr == 0) PG8_BAR; }
    PG8_BAR;
    if constexpr (Epi::AFTER_DRAIN) { E.fused(acc, cur, wr, wc, fr, fq, lds, wid, lane); S.done(cur); }
#undef PG8_SA
#undef PG8_SB
#undef PG8_STAGE
#undef PG8_LDA
#undef PG8_LDB
#undef PG8_MMA
#undef PG8_WAIT_V
#undef PG8_WAIT_L
#undef PG8_BAR
#undef PG8_SCHED
}
}

#include <hip/hip_bf16.h>
#include <cmath>
namespace attn_body {
using bf16=__hip_bfloat16;
using bf16x8=__attribute__((ext_vector_type(8)))short;
using s16x4=__attribute__((ext_vector_type(4)))short;
using f32x16=__attribute__((ext_vector_type(16)))float;
using u32x4=__attribute__((ext_vector_type(4)))unsigned;
constexpr int SEQ=8192,D=64;
constexpr int NW=8,QBLK=32,QB=QBLK*NW,KVBLK=64;
constexpr int ATTN_UNIT_ROWS=QB;
__device__ __forceinline__ int crow(int r,int hi){return (r&3)+8*(r>>2)+4*hi;}
#define SBAR() __builtin_amdgcn_sched_barrier(0)
__device__ __forceinline__ void cmask(f32x16&p0,f32x16&p1,int jb,int qrel,int hi){
  const float NEG=-INFINITY; int kb=64*jb+4*hi;
  #pragma unroll
  for(int r=0;r<16;++r){int kv=kb+(r&3)+8*(r>>2); if(kv>qrel)p0[r]=NEG; if(kv+32>qrel)p1[r]=NEG;}
}

constexpr int NSLOT=3, SLOTB=8192;
constexpr int LDS_K=0, LDS_V=NSLOT*SLOTB, LDS_WS=2*NSLOT*SLOTB, LDS_OST=LDS_WS+NW*64*4, LDS_BYTES=LDS_OST+NW*4096;
constexpr int LDS_TB=LDS_BYTES;
template<int MODE> __device__ __forceinline__ void wmask(f32x16&p0,f32x16&p1,int kb,int qabs,int hi,const __attribute__((address_space(3))) float*tbl){
  if constexpr(MODE==1){ const int base=kb+4*hi-qabs+128;
    #pragma unroll
    for(int r=0;r<16;++r){ const int i0=base+(r&3)+8*(r>>2),i1=i0+32; const bool v0=(unsigned)i0<=256u,v1=(unsigned)i1<=256u;
      const float b0=tbl[v0?i0:0],b1=tbl[v1?i1:0]; p0[r]=v0?p0[r]+b0:-INFINITY; p1[r]=v1?p1[r]+b1:-INFINITY; } }
}
constexpr float C2=0.125f*1.4426950408889634f;
__device__ __forceinline__ void glds16(const void*gsrc,unsigned lds_dst){unsigned keep;
  asm volatile("s_mov_b32 %0, m0\n\ts_mov_b32 m0, %2\n\ts_nop 0\n\tglobal_load_lds_dwordx4 %1, off\n\ts_mov_b32 m0, %0":"=&s"(keep):"v"(gsrc),"s"(lds_dst):"memory");}
__device__ __forceinline__ float max3f(float a,float b,float c){float r;asm("v_max3_f32 %0, %1, %2, %3":"=v"(r):"v"(a),"v"(b),"v"(c));return r;}
__device__ __forceinline__ float max2f(float a,float b){float r;asm("v_max_f32_e32 %0, %1, %2":"=v"(r):"v"(a),"v"(b));return r;}
__device__ __forceinline__ float fadd_s(float a,float b){float r;asm("v_add_f32_e32 %0, %1, %2":"=v"(r):"v"(a),"v"(b));return r;}
__device__ __forceinline__ float fsub_s(float a,float b){float r;asm("v_sub_f32_e32 %0, %1, %2":"=v"(r):"v"(a),"v"(b));return r;}
typedef float f32x2_t __attribute__((ext_vector_type(2))); typedef __bf16 bf16x2_t __attribute__((ext_vector_type(2)));
__device__ __forceinline__ unsigned cvtpk_s(float lo,float hi){f32x2_t v={lo,hi};bf16x2_t b=__builtin_convertvector(v,bf16x2_t);return __builtin_bit_cast(unsigned,b);}
#define WAIT_BAR(N) asm volatile("s_waitcnt vmcnt(" #N ") lgkmcnt(0)\n\ts_barrier":::"memory")

__device__ __forceinline__ void qkt(f32x16&p0,f32x16&p1,const char*Kslot,const bf16x8*qr,const f32x16&negm,int r32,int hi){
  const char*kb=Kslot+hi*1024+r32*16;
  #pragma unroll
  for(int d0=0;d0<4;++d0){
    const bf16x8 b0=*reinterpret_cast<const bf16x8*>(kb+d0*2048);
    const bf16x8 b1=*reinterpret_cast<const bf16x8*>(kb+d0*2048+512);
    if(d0==0){p0=__builtin_amdgcn_mfma_f32_32x32x16_bf16(b0,qr[0],negm,0,0,0);p1=__builtin_amdgcn_mfma_f32_32x32x16_bf16(b1,qr[0],negm,0,0,0);}
    else{p0=__builtin_amdgcn_mfma_f32_32x32x16_bf16(b0,qr[d0],p0,0,0,0);p1=__builtin_amdgcn_mfma_f32_32x32x16_bf16(b1,qr[d0],p1,0,0,0);}}
}
typedef __attribute__((address_space(3))) const char* lds_cptr;
typedef short v4i16_t __attribute__((ext_vector_type(4)));
__device__ __forceinline__ void kload8(bf16x8*kf,lds_cptr kp){
  kf[0]=*(const __attribute__((address_space(3))) bf16x8*)(kp);      kf[1]=*(const __attribute__((address_space(3))) bf16x8*)(kp+512);
  kf[2]=*(const __attribute__((address_space(3))) bf16x8*)(kp+2048); kf[3]=*(const __attribute__((address_space(3))) bf16x8*)(kp+2560);
  kf[4]=*(const __attribute__((address_space(3))) bf16x8*)(kp+4096); kf[5]=*(const __attribute__((address_space(3))) bf16x8*)(kp+4608);
  kf[6]=*(const __attribute__((address_space(3))) bf16x8*)(kp+6144); kf[7]=*(const __attribute__((address_space(3))) bf16x8*)(kp+6656);
}
__device__ __forceinline__ void kload2(bf16x8*kf,lds_cptr kp,int j){ kf[2*j]=*(const __attribute__((address_space(3))) bf16x8*)(kp+j*2048); kf[2*j+1]=*(const __attribute__((address_space(3))) bf16x8*)(kp+j*2048+512); }
__device__ __forceinline__ s16x4 vtr(lds_cptr p){ return __builtin_bit_cast(s16x4,__builtin_amdgcn_ds_read_tr16_b64_v4i16((__attribute__((address_space(3))) v4i16_t*)p)); }
__device__ __forceinline__ float rowmax(const f32x16&p0,const f32x16&p1){
  float a=max3f(p0[0],p0[1],p1[0]),b=max3f(p0[2],p0[3],p1[1]);a=max3f(a,p1[2],p1[3]);
  #pragma unroll
  for(int r=4;r<16;r+=4){a=max3f(a,p0[r],p0[r+1]);b=max3f(b,p0[r+2],p0[r+3]);a=max3f(a,p1[r],p1[r+1]);b=max3f(b,p1[r+2],p1[r+3]);}
  const float m=max2f(a,b);
  auto rr=__builtin_amdgcn_permlane32_swap(__float_as_uint(m),__float_as_uint(m),false,false);
  return max2f(__uint_as_float(rr[0]),__uint_as_float(rr[1]));
}
__device__ __forceinline__ void pv(f32x16*o,int vb,bf16x8 pa0,bf16x8 pa1,bf16x8 pa2,bf16x8 pa3){
  #pragma unroll
  for(int d0=0;d0<2;++d0){s16x4 lo[4],hi[4];
    #pragma unroll
    for(int ks=0;ks<4;++ks){
      asm volatile("ds_read_b64_tr_b16 %0,%1 offset:%c2":"=&v"(lo[ks]):"v"(vb),"i"(d0*4096+ks*1024):"memory");
      asm volatile("ds_read_b64_tr_b16 %0,%1 offset:%c2":"=&v"(hi[ks]):"v"(vb),"i"(d0*4096+ks*1024+512):"memory");}
    asm volatile("s_waitcnt lgkmcnt(0)":::"memory");SBAR();
    #define PK(k) (bf16x8){lo[k][0],lo[k][1],lo[k][2],lo[k][3],hi[k][0],hi[k][1],hi[k][2],hi[k][3]}
    o[d0]=__builtin_amdgcn_mfma_f32_32x32x16_bf16(pa0,PK(0),o[d0],0,0,0);
    o[d0]=__builtin_amdgcn_mfma_f32_32x32x16_bf16(pa1,PK(1),o[d0],0,0,0);
    o[d0]=__builtin_amdgcn_mfma_f32_32x32x16_bf16(pa2,PK(2),o[d0],0,0,0);
    o[d0]=__builtin_amdgcn_mfma_f32_32x32x16_bf16(pa3,PK(3),o[d0],0,0,0);
    #undef PK
  }
}

#ifndef ATTN_STORE16
#define ATTN_STORE16(p,v) (*(u32x4*)(p)=(v))
#endif
template<int THRL,int QP,int KP,int OP,int MODE,bool PART=false> __device__ __forceinline__ void attn_unit(int q0,int NT,const bf16*Qh,const bf16*__restrict__ Kh,const bf16*__restrict__ Vh,bf16*Oh,char*shm,const float*tbg=nullptr,float sink2=0.f,int kb0=0,float*Po=nullptr,float*Pml=nullptr){
  int tid_l=threadIdx.x; asm volatile("":"+v"(tid_l)); const int tid=tid_l,lane=tid&63,r32=lane&31,hi=lane>>5; const int wid=__builtin_amdgcn_readfirstlane(tid>>6);
  __attribute__((address_space(3))) float* tblL=(__attribute__((address_space(3))) float*)((__attribute__((address_space(3))) char*)shm+LDS_TB);
  if constexpr(MODE==1){ if(tid<257)tblL[tid]=tbg[tid]; }

  const bf16*Qw=Qh+(long)(q0+wid*QBLK)*QP;

  const unsigned lds0=(unsigned)(uintptr_t)shm;
  float*wsf=(float*)(shm+LDS_WS)+wid*64;
  const bf16*ksrc=Kh+(long)lane*KP+wid*8;
  const bf16*vsrc=Vh+(long)(16*(wid&3)+(lane>>2))*KP+(wid>>2)*32+(lane&3)*8;
  const unsigned kdst=lds0+LDS_K+wid*1024, vdst=lds0+LDS_V+wid*1024;
  #define DMA_K(t,slot) glds16(ksrc+(long)(t)*KVBLK*KP,(unsigned)__builtin_amdgcn_readfirstlane(kdst+(slot)))
  #define DMA_V(t,slot) glds16(vsrc+(long)(t)*KVBLK*KP,(unsigned)__builtin_amdgcn_readfirstlane(vdst+(slot)))
  const int vb0=(int)(lds0+LDS_V)+((lane>>4)&1)*32+(lane&3)*8+(4*hi+((lane&15)>>2))*64;
  const char*Kbase=shm+LDS_K; bf16x8 kf[8];
  const lds_cptr shm3=(lds_cptr)shm; const lds_cptr kp0=shm3+LDS_K+hi*1024+r32*16; const lds_cptr vp0=shm3+LDS_V+((lane>>4)&1)*32+(lane&3)*8+(4*hi+((lane&15)>>2))*64;

  DMA_K(0,0);DMA_V(0,0);DMA_K(1,SLOTB);
  bf16x8 qr[4];
  #pragma unroll
  for(int d0=0;d0<4;++d0)qr[d0]=*reinterpret_cast<const bf16x8*>(&Qw[(long)r32*QP+d0*16+hi*8]);
  float mhat=0.f,l_reg=0.f;f32x16 o[2];o[0]=f32x16{};o[1]=f32x16{};f32x16 negm=f32x16{};asm volatile("":"+v"(negm));
  const int qrel=wid*QBLK+r32; const int qabs=q0+qrel;
  #define CMASK(P0,P1,t) wmask<MODE>(P0,P1,kb0+(t)*64,qabs,hi,tblL)
  bool resc=false;
  #define START(P0,P1) do{ float rm=rowmax(P0,P1); if constexpr(MODE==1) rm=__builtin_fmaxf(rm,sink2); resc=false; \
    { const float dl=rm; mhat=fadd_s(mhat,dl); \
      _Pragma("unroll") for(int r=0;r<16;++r){P0[r]=fsub_s(P0[r],dl);P1[r]=fsub_s(P1[r],dl);} \
      _Pragma("unroll") for(int r=0;r<16;++r)negm[r]=-mhat; asm volatile("":"+v"(negm)); } \
    _Pragma("unroll") for(int r=0;r<16;++r)P0[r]=__builtin_amdgcn_exp2f(P0[r]); }while(0)
  #define RESC() do{ if(resc){ asm volatile("s_waitcnt lgkmcnt(0)":::"memory"); \
      _Pragma("unroll") for(int d_=0;d_<2;++d_) _Pragma("unroll") for(int r=0;r<16;++r)o[d_][r]*=wsf[crow(r,hi)]; } }while(0)
  f32x16 pA0,pA1,pB0,pB1;
  int sl_prev=0,sl_cur=0,sl_next=SLOTB;
  #define ROT() do{sl_prev=sl_cur;sl_cur=sl_next;sl_next=(sl_next==(NSLOT-1)*SLOTB)?0:sl_next+SLOTB;}while(0)
  DMA_K(2,2*SLOTB);
  WAIT_BAR(3);
  qkt(pA0,pA1,Kbase,qr,negm,r32,hi);asm volatile("s_nop 15\n\ts_nop 7":"+v"(pA0),"+v"(pA1));CMASK(pA0,pA1,0);
  START(pA0,pA1);
  _Pragma("unroll") for(int r=0;r<16;++r)pA1[r]=__builtin_amdgcn_exp2f(pA1[r]);
  WAIT_BAR(0);
  DMA_K(3,0);DMA_V(1,SLOTB);
  ROT();
  kload8(kf,kp0+sl_cur);
  WAIT_BAR(2);
  s16x4 vlo[8],vhi[8]; u32x4 pw0,pw1,pw2,pw3;
  #define PKW(P,B) cvtpk_s(P[B],P[B+1])
  #define PAF(k) __builtin_bit_cast(bf16x8,pw##k)
  #define VFR(i) (bf16x8){vlo[i][0],vlo[i][1],vlo[i][2],vlo[i][3],vhi[i][0],vhi[i][1],vhi[i][2],vhi[i][3]}
  #define PIN(x) asm volatile("":"+v"(x))
  #define MX3(a,b,c) __builtin_fmaxf(__builtin_fmaxf((a),(b)),(c))
  #define GAPA(MF,A0,A1,A2,A3,W0,W1,PW) do{ MF; sacc+=A0; sacc+=A1; sacc+=A2; sacc+=A3; PIN(sacc); W0; W1; PIN(PW); SBAR(); }while(0)
  #define EX(v) __builtin_amdgcn_exp2f(v)
  #define GAPB(MF,X,B) do{ MF; X[B]=EX(X[B]); X[B+1]=EX(X[B+1]); X[B+2]=EX(X[B+2]); X[B+3]=EX(X[B+3]); PIN(X); SBAR(); }while(0)
  #define VRD(i) do{ vlo[i]=vtr(vp_+(((i)>>2)*4096+((i)&3)*1024)); vhi[i]=vtr(vp_+(((i)>>2)*4096+((i)&3)*1024+512)); }while(0)
  #define KRD(G,j) do{ if(G){ kload2(kf,kp0+sl_next,j); SBAR(); } }while(0)
  #define STEP(C0,C1,P0,P1,t,GK,GV,GL) do{ SBAR(); \
    const lds_cptr vp_=vp0+sl_prev; \
    VRD(0); SBAR(); float sacc=(P0[0]+P0[1]); \
    GAPA(C0=__builtin_amdgcn_mfma_f32_32x32x16_bf16(kf[0],qr[0],negm,0,0,0), P0[2],P0[3],P0[4],P0[5],     pw0[0]=PKW(P0,0), pw0[1]=PKW(P0,2), pw0); \
    VRD(4); SBAR(); GAPA(C1=__builtin_amdgcn_mfma_f32_32x32x16_bf16(kf[1],qr[0],negm,0,0,0), P0[6],P0[7],P0[8],P0[9],     pw0[2]=PKW(P0,4), pw0[3]=PKW(P0,6), pw0); \
    VRD(1); SBAR(); GAPA(C0=__builtin_amdgcn_mfma_f32_32x32x16_bf16(kf[2],qr[1],C0,0,0,0),   P0[10],P0[11],P0[12],P0[13], pw1[0]=PKW(P0,8), pw1[1]=PKW(P0,10), pw1); \
    VRD(5); SBAR(); GAPA(C1=__builtin_amdgcn_mfma_f32_32x32x16_bf16(kf[3],qr[1],C1,0,0,0),   P0[14],P0[15],P1[0],P1[1],   pw1[2]=PKW(P0,12),pw1[3]=PKW(P0,14), pw1); \
    VRD(2); SBAR(); GAPA(C0=__builtin_amdgcn_mfma_f32_32x32x16_bf16(kf[4],qr[2],C0,0,0,0),   P1[2],P1[3],P1[4],P1[5],     pw2[0]=PKW(P1,0), pw2[1]=PKW(P1,2), pw2); \
    VRD(6); SBAR(); GAPA(C1=__builtin_amdgcn_mfma_f32_32x32x16_bf16(kf[5],qr[2],C1,0,0,0),   P1[6],P1[7],P1[8],P1[9],     pw2[2]=PKW(P1,4), pw2[3]=PKW(P1,6), pw2); \
    VRD(3); SBAR(); GAPA(C0=__builtin_amdgcn_mfma_f32_32x32x16_bf16(kf[6],qr[3],C0,0,0,0),   P1[10],P1[11],P1[12],P1[13], pw3[0]=PKW(P1,8), pw3[1]=PKW(P1,10), pw3); \
    VRD(7); SBAR(); GAPA(C1=__builtin_amdgcn_mfma_f32_32x32x16_bf16(kf[7],qr[3],C1,0,0,0),   P1[14],P1[15],0.f,0.f,       pw3[2]=PKW(P1,12),pw3[3]=PKW(P1,14), pw3); \
    l_reg+=sacc; \
    if(GK){DMA_K((t)+3,sl_cur);} if(GV){DMA_V((t)+1,sl_next);} \
    CMASK(C0,C1,t); \
    { float a=MX3(C0[0],C0[1],C1[0]),b=MX3(C0[2],C0[3],C1[1]); a=MX3(a,C1[2],C1[3]); \
      _Pragma("unroll") for(int r=4;r<16;r+=4){a=MX3(a,C0[r],C0[r+1]);b=MX3(b,C0[r+2],C0[r+3]);a=MX3(a,C1[r],C1[r+1]);b=MX3(b,C1[r+2],C1[r+3]);} \
      float rm=__builtin_fmaxf(a,b); { auto rr=__builtin_amdgcn_permlane32_swap(__float_as_uint(rm),__float_as_uint(rm),false,false); rm=__builtin_fmaxf(__uint_as_float(rr[0]),__uint_as_float(rr[1])); } \
      resc=false; \
      if(__builtin_expect(__any(rm>(float)THRL),0)){ const float dl=__builtin_fmaxf(rm,0.f); mhat+=dl; \
        _Pragma("unroll") for(int r=0;r<16;++r){C0[r]-=dl;C1[r]-=dl;} \
        _Pragma("unroll") for(int r=0;r<16;++r)negm[r]=-mhat; asm volatile("":"+v"(negm)); \
        const float f=__builtin_amdgcn_exp2f(-dl); l_reg*=f; if(hi==0)wsf[r32]=f; resc=true; } } \
    SBAR(); \
    GAPB(o[0]=__builtin_amdgcn_mfma_f32_32x32x16_bf16(PAF(0),VFR(0),o[0],0,0,0), C0,0); \
    GAPB(o[1]=__builtin_amdgcn_mfma_f32_32x32x16_bf16(PAF(0),VFR(4),o[1],0,0,0), C0,4); \
    KRD(GL,0); GAPB(o[0]=__builtin_amdgcn_mfma_f32_32x32x16_bf16(PAF(1),VFR(1),o[0],0,0,0), C0,8); \
    KRD(GL,1); GAPB(o[1]=__builtin_amdgcn_mfma_f32_32x32x16_bf16(PAF(1),VFR(5),o[1],0,0,0), C0,12); \
    KRD(GL,2); GAPB(o[0]=__builtin_amdgcn_mfma_f32_32x32x16_bf16(PAF(2),VFR(2),o[0],0,0,0), C1,0); \
    KRD(GL,3); GAPB(o[1]=__builtin_amdgcn_mfma_f32_32x32x16_bf16(PAF(2),VFR(6),o[1],0,0,0), C1,4); \
    GAPB(o[0]=__builtin_amdgcn_mfma_f32_32x32x16_bf16(PAF(3),VFR(3),o[0],0,0,0), C1,8); \
    GAPB(o[1]=__builtin_amdgcn_mfma_f32_32x32x16_bf16(PAF(3),VFR(7),o[1],0,0,0), C1,12); \
    }while(0)
  int t=1;
  #undef CMASK
  #define CMASK(P0,P1,t) wmask<MODE>(P0,P1,kb0+(t)*64,qabs,hi,tblL)
  for(;t+5<NT;t+=2){
    STEP(pB0,pB1,pA0,pA1,t,true,true,true);     WAIT_BAR(2); RESC(); ROT();
    STEP(pA0,pA1,pB0,pB1,t+1,true,true,true);   WAIT_BAR(2); RESC(); ROT();
  }
  #undef CMASK
  #define CMASK(P0,P1,t) wmask<MODE>(P0,P1,kb0+(t)*64,qabs,hi,tblL)
  #define ENDW(tt) do{ if((tt)+3<NT){WAIT_BAR(2);} else if((tt)+2<NT){WAIT_BAR(1);} else {WAIT_BAR(0);} }while(0)
  for(;t+1<NT;t+=2){
    STEP(pB0,pB1,pA0,pA1,t,(t+3<NT),(t+1<NT),(t+1<NT));       ENDW(t);   RESC(); ROT();
    STEP(pA0,pA1,pB0,pB1,t+1,(t+4<NT),(t+2<NT),(t+2<NT));     ENDW(t+1); RESC(); ROT();
  }
  STEP(pB0,pB1,pA0,pA1,NT-1,false,false,false); RESC();
  { float sacc=pB0[0]+pB0[1]; _Pragma("unroll") for(int r=2;r<16;++r)sacc+=pB0[r]; _Pragma("unroll") for(int r=0;r<16;++r)sacc+=pB1[r]; l_reg+=sacc;
    pw0=(u32x4){PKW(pB0,0),PKW(pB0,2),PKW(pB0,4),PKW(pB0,6)};pw1=(u32x4){PKW(pB0,8),PKW(pB0,10),PKW(pB0,12),PKW(pB0,14)};pw2=(u32x4){PKW(pB1,0),PKW(pB1,2),PKW(pB1,4),PKW(pB1,6)};pw3=(u32x4){PKW(pB1,8),PKW(pB1,10),PKW(pB1,12),PKW(pB1,14)};
    SBAR(); pv(o,vb0+sl_cur,PAF(0),PAF(1),PAF(2),PAF(3)); }
  #undef PKW
  #undef PAF
  #undef VFR
  #undef PIN
  #undef MX3
  #undef GAPA
  #undef GAPB
  #undef EX
  #undef VRD
  #undef KRD
  #undef STEP
  #undef ENDW
  {auto rr=__builtin_amdgcn_permlane32_swap(__float_as_uint(l_reg),__float_as_uint(l_reg),false,false);l_reg=__uint_as_float(rr[0])+__uint_as_float(rr[1]);}
  if constexpr(MODE==1) l_reg+=__builtin_amdgcn_exp2f(sink2-mhat);
  if constexpr(PART){
    if(hi==0){ Pml[(wid*QBLK+r32)*2]=mhat; Pml[(wid*QBLK+r32)*2+1]=l_reg; }
    float*Pw=Po+(long)(wid*QBLK)*64+r32;
    #pragma unroll
    for(int r=0;r<16;++r){ Pw[crow(r,hi)*64]=o[0][r]; Pw[crow(r,hi)*64+32]=o[1][r]; }
  } else {
  if(hi==0)wsf[32+r32]=l_reg;asm volatile("s_waitcnt lgkmcnt(0)":::"memory");
  float rli[16];
  #pragma unroll
  for(int r=0;r<16;++r)rli[r]=__builtin_amdgcn_rcpf(wsf[32+crow(r,hi)]);
  bf16*Ow=Oh+(long)(q0+wid*QBLK)*OP;
  { bf16*stg=(bf16*)(shm+LDS_OST)+wid*2048;
    #pragma unroll
    for(int r=0;r<16;++r){const int orow=crow(r,hi);
      #pragma unroll
      for(int d0=0;d0<2;++d0)stg[orow*64+d0*32+r32]=__float2bfloat16(o[d0][r]*rli[r]);}
    asm volatile("s_waitcnt lgkmcnt(0)":::"memory");
    #pragma unroll
    for(int i=0;i<4;++i){const int row=i*8+(lane>>3),ch=lane&7; const u32x4 v=*(const u32x4*)(stg+row*64+ch*8); ATTN_STORE16(Ow+(long)row*OP+ch*8,v);} }
  }
  asm volatile("s_waitcnt lgkmcnt(0)\n\ts_barrier":::"memory");
  #undef DMA_K
  #undef DMA_V
  #undef CMASK
  #undef START
  #undef RESC
  #undef ROT
}
constexpr int ATTN_LDS_BYTES=LDS_BYTES+1056;
#undef SBAR
#undef WAIT_BAR
}

namespace hg {
typedef short s16x4 __attribute__((ext_vector_type(4)));
typedef short s16x8 __attribute__((ext_vector_type(8)));
typedef float f32x4 __attribute__((ext_vector_type(4)));
typedef unsigned u32x4 __attribute__((ext_vector_type(4)));
typedef unsigned u32x2 __attribute__((ext_vector_type(2)));
#define HG_LAS __attribute__((address_space(3)))
constexpr int T = 8192, SEG = 128, NSEG = 64, HW = 512;
constexpr int PV = 272;
typedef float f32x2_t __attribute__((ext_vector_type(2))); typedef __bf16 bf16x2_t __attribute__((ext_vector_type(2)));
__device__ __forceinline__ unsigned pk(float lo, float hi) { f32x2_t v = {lo, hi}; bf16x2_t b = __builtin_convertvector(v, bf16x2_t); return __builtin_bit_cast(unsigned, b); }
#define HG_DPP_ADD(v, ctrl) v += __builtin_bit_cast(float, __builtin_amdgcn_update_dpp(0, __builtin_bit_cast(int, v), ctrl, 0xF, 0xF, true))
__device__ __forceinline__ float row16_sum(float v) { HG_DPP_ADD(v, 0xB1); HG_DPP_ADD(v, 0x4E); HG_DPP_ADD(v, 0x124); HG_DPP_ADD(v, 0x128); return v; }

__device__ __forceinline__ void pass1(int G, int bid, const float* FF, const float* KF, const float* FB, const float* KB, const float* BI, float* P, float* Dg, HG_LAS unsigned char* lds) {
    int tid_l = threadIdx.x; asm volatile("" : "+v"(tid_l));
    const int tid = tid_l, lane = tid & 63, w = __builtin_amdgcn_readfirstlane(tid >> 6), l16 = lane & 15, g = lane >> 4, c = tid & 127, qt = tid >> 7;
    constexpr int VT = 0, KT = 128 * PV, TQ = 3 * 128 * PV;
    for (int u = bid; u < 4 * NSEG; u += G) {
        const int h = u >> 6, seg = u & 63, tok0 = seg * SEG;
        const size_t ub = (size_t)tok0 * HW + h * 128; const int lo = 32 * qt * HW + c;
        {
            const float* vb = BI + ub;
#pragma unroll
            for (int jj = 0; jj < 4; ++jj) { float x[8];
#pragma unroll
                for (int j = 0; j < 8; ++j) x[j] = (vb + (8 * jj + j) * HW)[lo];
                u32x4 o; o.x = pk(x[0], x[1]); o.y = pk(x[2], x[3]); o.z = pk(x[4], x[5]); o.w = pk(x[6], x[7]);
                *(HG_LAS u32x4*)(lds + VT + c * PV + (32 * qt + 8 * jj) * 2) = o; }
        }
        float kw0[32], kw1[32];
        {
            float f[32];
#pragma unroll
            for (int j = 0; j < 32; ++j) { f[j] = (FF + ub + j * HW)[lo]; kw0[j] = (KF + ub + j * HW)[lo]; }
            float run = 1.f;
#pragma unroll
            for (int j = 31; j >= 0; --j) { kw0[j] *= run; run *= f[j]; }
            *(HG_LAS float*)(lds + TQ + (0 * 4 + qt) * 512 + c * 4) = run;
        }
        {
            float f[32];
#pragma unroll
            for (int j = 0; j < 32; ++j) { f[j] = (FB + ub + j * HW)[lo]; kw1[j] = (KB + ub + j * HW)[lo]; }
            float run = 1.f;
#pragma unroll
            for (int j = 0; j < 32; ++j) { kw1[j] *= run; run *= f[j]; }
            *(HG_LAS float*)(lds + TQ + (1 * 4 + qt) * 512 + c * 4) = run;
        }
        __syncthreads();
        {
            float t0[4], t1[4];
#pragma unroll
            for (int q = 0; q < 4; ++q) { t0[q] = *(HG_LAS float*)(lds + TQ + (0 * 4 + q) * 512 + c * 4); t1[q] = *(HG_LAS float*)(lds + TQ + (1 * 4 + q) * 512 + c * 4); }
            float x0 = 1.f, x1 = 1.f;
#pragma unroll
            for (int q = 0; q < 4; ++q) { if (q > qt) x0 *= t0[q]; if (q < qt) x1 *= t1[q]; }
            if (qt == 0) { Dg[((size_t)(h * 2 + 0) * NSEG + seg) * 128 + c] = (t0[0] * t0[1]) * (t0[2] * t0[3]); Dg[((size_t)(h * 2 + 1) * NSEG + seg) * 128 + c] = (t1[0] * t1[1]) * (t1[2] * t1[3]); }
#pragma unroll
            for (int jj = 0; jj < 4; ++jj) { u32x4 o0, o1;
                o0.x = pk(kw0[8 * jj + 0] * x0, kw0[8 * jj + 1] * x0); o0.y = pk(kw0[8 * jj + 2] * x0, kw0[8 * jj + 3] * x0); o0.z = pk(kw0[8 * jj + 4] * x0, kw0[8 * jj + 5] * x0); o0.w = pk(kw0[8 * jj + 6] * x0, kw0[8 * jj + 7] * x0);
                o1.x = pk(kw1[8 * jj + 0] * x1, kw1[8 * jj + 1] * x1); o1.y = pk(kw1[8 * jj + 2] * x1, kw1[8 * jj + 3] * x1); o1.z = pk(kw1[8 * jj + 4] * x1, kw1[8 * jj + 5] * x1); o1.w = pk(kw1[8 * jj + 6] * x1, kw1[8 * jj + 7] * x1);
                *(HG_LAS u32x4*)(lds + KT + c * PV + (32 * qt + 8 * jj) * 2) = o0;
                *(HG_LAS u32x4*)(lds + KT + 128 * PV + c * PV + (32 * qt + 8 * jj) * 2) = o1; }
        }
        __syncthreads();
        {
            s16x8 bfr[4];
#pragma unroll
            for (int kk = 0; kk < 4; ++kk) bfr[kk] = *(const HG_LAS s16x8*)(lds + VT + (16 * w + l16) * PV + (32 * kk + 8 * g) * 2);
#pragma unroll
            for (int dir = 0; dir < 2; ++dir) {
                float* Pp = P + ((size_t)(h * 2 + dir) * NSEG + seg) * 16384 + 16 * w; const int plo = 4 * g * 128 + l16;
#pragma unroll
                for (int i = 0; i < 8; ++i) { f32x4 acc = (f32x4){0.f, 0.f, 0.f, 0.f};
#pragma unroll
                    for (int kk = 0; kk < 4; ++kk) { const s16x8 a = *(const HG_LAS s16x8*)(lds + KT + dir * 128 * PV + (16 * i + l16) * PV + (32 * kk + 8 * g) * 2);
                        acc = __builtin_amdgcn_mfma_f32_16x16x32_bf16(a, bfr[kk], acc, 0, 0, 0); }
#pragma unroll
                    for (int r = 0; r < 4; ++r) (Pp + (16 * i + r) * 128)[plo] = acc[r]; }
            }
        }
        __syncthreads();
    }
}

__device__ __forceinline__ void scan(int G, int vcu, const float* P, const float* Dg, float* SS) {
    int tid_l = threadIdx.x; asm volatile("" : "+v"(tid_l));
    for (int e = vcu * 512 + tid_l; e < 8 * 16384; e += G * 512) {
        const int hd = e >> 14, cv = e & 16383, c = cv >> 7, dir = hd & 1;
        float Sv = 0.f;
        for (int s0 = 0; s0 < NSEG; s0 += 8) { float p[8], d[8];
#pragma unroll
            for (int j = 0; j < 8; ++j) { const int sg = dir ? NSEG - 1 - (s0 + j) : s0 + j; p[j] = P[((size_t)hd * NSEG + sg) * 16384 + cv]; d[j] = Dg[((size_t)hd * NSEG + sg) * 128 + c]; }
#pragma unroll
            for (int j = 0; j < 8; ++j) { const int sg = dir ? NSEG - 1 - (s0 + j) : s0 + j; SS[((size_t)hd * NSEG + sg) * 16384 + cv] = Sv; Sv = d[j] * Sv + p[j]; } }
    }
}

__device__ __forceinline__ void pass2(int G, int bid, const float* BQ, const float* KF, const float* FF, const float* KB, const float* FB, const float* BI, const float* SGt, const float* SS,
                                      const float* gnw, unsigned short* MIX, HG_LAS unsigned char* lds) {
    int tid_l = threadIdx.x; asm volatile("" : "+v"(tid_l));
    const int tid = tid_l, lane = tid & 63, w = __builtin_amdgcn_readfirstlane(tid >> 6), l16 = lane & 15, g = lane >> 4, c = tid & 127, ch_t = tid >> 7;
    constexpr int VT = 0, QT = 128 * PV, KT = QT + 64 * PV, KPT = KT + 64 * PV, KPP = 144, DCH = KPT + 128 * KPP, NRM = DCH + 2048, RSTD = NRM + 4096;
    for (int u = bid; u < 4 * NSEG; u += G) {
        const int h = u >> 6, seg = u & 63, tok0 = seg * SEG;
        {
            const float* vb = BI + (size_t)tok0 * HW + h * 128; const int lo = 32 * ch_t * HW + c;
#pragma unroll
            for (int jj = 0; jj < 4; ++jj) { float x[8];
#pragma unroll
                for (int j = 0; j < 8; ++j) x[j] = (vb + (8 * jj + j) * HW)[lo];
                u32x4 o; o.x = pk(x[0], x[1]); o.y = pk(x[2], x[3]); o.z = pk(x[4], x[5]); o.w = pk(x[6], x[7]);
                *(HG_LAS u32x4*)(lds + VT + c * PV + (32 * ch_t + 8 * jj) * 2) = o; }
        }
        f32x4 O[8];
#pragma unroll
        for (int i = 0; i < 8; ++i) O[i] = (f32x4){0.f, 0.f, 0.f, 0.f};
#pragma unroll
        for (int dir = 0; dir < 2; ++dir) {
            const float* Fp = dir ? FB : FF; const float* Kp = dir ? KB : KF;
            f32x4 St[8];
            { const float* sp = SS + ((size_t)(h * 2 + dir) * NSEG + seg) * 16384 + 16 * w; const int lo = 4 * g * 128 + l16;
              asm volatile("" ::: "memory");
#pragma unroll
              for (int i = 0; i < 8; ++i)
#pragma unroll
                  for (int r = 0; r < 4; ++r) St[i][r] = (sp + (16 * i + r) * 128)[lo]; }
#pragma unroll
            for (int hq = 0; hq < 2; ++hq) {
                const int hh = dir ? 1 - hq : hq;
                {
                    const size_t ub = (size_t)(tok0 + 64 * hh) * HW + h * 128; const int lo = 16 * ch_t * HW + c;
                    float f[16], k[16], q[16];
                    asm volatile("" ::: "memory");
#pragma unroll
                    for (int j = 0; j < 16; ++j) { f[j] = (Fp + ub + j * HW)[lo]; k[j] = (Kp + ub + j * HW)[lo]; q[j] = (BQ + ub + j * HW)[lo]; }
                    float kp[16]; float cum = 1.f, run = 1.f;
                    if (dir == 0) {
#pragma unroll
                        for (int j = 0; j < 16; ++j) { cum *= f[j]; q[j] *= cum; const float kk = k[j]; k[j] = kk * __builtin_amdgcn_rcpf(fmaxf(cum, 1e-30f)); kp[j] = kk; }
#pragma unroll
                        for (int j = 15; j >= 0; --j) { kp[j] *= run; run *= f[j]; }
                    } else {
#pragma unroll
                        for (int j = 15; j >= 0; --j) { cum *= f[j]; q[j] *= cum; const float kk = k[j]; k[j] = kk * __builtin_amdgcn_rcpf(fmaxf(cum, 1e-30f)); kp[j] = kk; }
#pragma unroll
                        for (int j = 0; j < 16; ++j) { kp[j] *= run; run *= f[j]; }
                    }
#pragma unroll
                    for (int j = 0; j < 16; ++j) { *(HG_LAS unsigned short*)(lds + QT + (16 * ch_t + j) * PV + c * 2) = (unsigned short)(pk(q[j], 0.f) & 0xffffu);
                                                   *(HG_LAS unsigned short*)(lds + KT + (16 * ch_t + j) * PV + c * 2) = (unsigned short)(pk(k[j], 0.f) & 0xffffu); }
                    u32x4 o0, o1; o0.x = pk(kp[0], kp[1]); o0.y = pk(kp[2], kp[3]); o0.z = pk(kp[4], kp[5]); o0.w = pk(kp[6], kp[7]); o1.x = pk(kp[8], kp[9]); o1.y = pk(kp[10], kp[11]); o1.z = pk(kp[12], kp[13]); o1.w = pk(kp[14], kp[15]);
                    *(HG_LAS u32x4*)(lds + KPT + c * KPP + (16 * ch_t) * 2) = o0; *(HG_LAS u32x4*)(lds + KPT + c * KPP + (16 * ch_t) * 2 + 16) = o1;
                    *(HG_LAS float*)(lds + DCH + ch_t * 512 + c * 4) = cum;
                }
                __syncthreads();
#pragma unroll
                for (int cq = 0; cq < 4; ++cq) {
                    const int ch = dir ? 3 - cq : cq, tr = 16 * ch, cg = 4 * hh + ch;
                    f32x4 at = (f32x4){0.f, 0.f, 0.f, 0.f};
#pragma unroll
                    for (int m = 0; m < 4; ++m) { const s16x8 a = *(const HG_LAS s16x8*)(lds + KT + (tr + l16) * PV + (32 * m + 8 * g) * 2); const s16x8 b = *(const HG_LAS s16x8*)(lds + QT + (tr + l16) * PV + (32 * m + 8 * g) * 2);
                        at = __builtin_amdgcn_mfma_f32_16x16x32_bf16(a, b, at, 0, 0, 0); }
#pragma unroll
                    for (int r = 0; r < 4; ++r) { const int s = 4 * g + r; const bool keep = dir ? (s >= l16) : (s <= l16); at[r] = keep ? at[r] : 0.f; }
                    u32x4 pa4; pa4.x = pk(at[0], at[1]); pa4.y = pk(at[2], at[3]); pa4.z = 0u; pa4.w = 0u; const s16x8 pa = __builtin_bit_cast(s16x8, pa4);
                    const u32x2 bv2 = *(const HG_LAS u32x2*)(lds + VT + (16 * w + l16) * PV + (64 * hh + tr + 4 * g) * 2);
                    u32x4 bv4; bv4.x = bv2.x; bv4.y = bv2.y; bv4.z = 0u; bv4.w = 0u; const s16x8 bv = __builtin_bit_cast(s16x8, bv4);
                    f32x4 o = O[cg];
                    o = __builtin_amdgcn_mfma_f32_16x16x32_bf16(pa, bv, o, 0, 0, 0);
#pragma unroll
                    for (int m = 0; m < 4; ++m) { u32x4 sb; sb.x = pk(St[2 * m][0], St[2 * m][1]); sb.y = pk(St[2 * m][2], St[2 * m][3]); sb.z = pk(St[2 * m + 1][0], St[2 * m + 1][1]); sb.w = pk(St[2 * m + 1][2], St[2 * m + 1][3]);
                        const u32x2 qa = *(const HG_LAS u32x2*)(lds + QT + (tr + l16) * PV + (32 * m + 4 * g) * 2), qb = *(const HG_LAS u32x2*)(lds + QT + (tr + l16) * PV + (32 * m + 16 + 4 * g) * 2);
                        u32x4 qq; qq.x = qa.x; qq.y = qa.y; qq.z = qb.x; qq.w = qb.y;
                        o = __builtin_amdgcn_mfma_f32_16x16x32_bf16(__builtin_bit_cast(s16x8, qq), __builtin_bit_cast(s16x8, sb), o, 0, 0, 0); }
                    O[cg] = o;
#pragma unroll
                    for (int i = 0; i < 8; ++i) { const f32x4 dv = *(const HG_LAS f32x4*)(lds + DCH + ch * 512 + (16 * i + 4 * g) * 4);
                        const u32x2 a2 = *(const HG_LAS u32x2*)(lds + KPT + (16 * i + l16) * KPP + (tr + 4 * g) * 2);
                        u32x4 a4; a4.x = a2.x; a4.y = a2.y; a4.z = 0u; a4.w = 0u;
                        St[i] = __builtin_amdgcn_mfma_f32_16x16x32_bf16(__builtin_bit_cast(s16x8, a4), bv, St[i] * dv, 0, 0, 0); }
                }
                __syncthreads();
            }
        }
#pragma unroll
        for (int cg = 0; cg < 8; ++cg)
#pragma unroll
            for (int r = 0; r < 4; ++r) { const float s = row16_sum(O[cg][r] * O[cg][r]); if (l16 == 0) *(HG_LAS float*)(lds + NRM + w * 512 + (16 * cg + 4 * g + r) * 4) = s; }
        __syncthreads();
        if (tid < 128) { float s = 0.f;
#pragma unroll
            for (int ww = 0; ww < 8; ++ww) s += *(HG_LAS float*)(lds + NRM + ww * 512 + tid * 4);
            *(HG_LAS float*)(lds + RSTD + tid * 4) = 1.0f / sqrtf(s * (1.0f / 128.0f) + 1e-6f); }
        __syncthreads();
        {
            const float gw = gnw[16 * w + l16];
            const float* sgb = SGt + (size_t)tok0 * HW + h * 128 + 16 * w; const int slo = 4 * g * HW + l16;
            unsigned short* mb = MIX + (size_t)tok0 * 2048 + 768 + h * 128 + 16 * w; const int mlo = 4 * g * 2048 + l16;
            asm volatile("" ::: "memory");
#pragma unroll
            for (int cg = 0; cg < 8; ++cg) { const f32x4 rs = *(const HG_LAS f32x4*)(lds + RSTD + (16 * cg + 4 * g) * 4);
#pragma unroll
                for (int r = 0; r < 4; ++r) {
                    const float y = O[cg][r] * rs[r] * gw * (sgb + (16 * cg + r) * HW)[slo];
                    (mb + (16 * cg + r) * 2048)[mlo] = (unsigned short)(pk(y, 0.f) & 0xffffu); } }
        }
        __syncthreads();
    }
}
#undef HG_DPP_ADD
}

constexpr int NWAVES = 8;
#ifndef MK_SPLIT
#define MK_SPLIT 0
#endif
constexpr int S = 8192, DM = 2048, DFF = 5632, DIN = 5120, NL = 4;
constexpr int NGU = 2 * DFF;
constexpr float EPS = 1e-6f;
constexpr size_t MiB = 1u << 20;
constexpr size_t WS_CTL = 0, CTL_ZERO_BYTES = 1 * MiB;
constexpr size_t WS_TAB = 1 * MiB;
constexpr size_t TAB_RT = 0, TAB_CT = 16384, TAB_TB = 24576, TAB_LB = 40960;
constexpr size_t WS_W = 2 * MiB;
constexpr size_t W_GU1 = 0, W_DN1 = 44 * MiB, W_WIN = 66 * MiB, W_WOUT = 86 * MiB, W_GU2 = 94 * MiB, W_DN2 = 138 * MiB, W_LAYER = 160 * MiB;
constexpr size_t WS_X = WS_W + NL * W_LAYER;
constexpr size_t WS_Y = WS_X + 64 * MiB;
constexpr size_t WS_H = WS_Y + 64 * MiB;
constexpr size_t WS_ACT = WS_H + 32 * MiB;
constexpr size_t WS_MIX = WS_ACT + 88 * MiB;
constexpr size_t WS_AQ = WS_MIX + 32 * MiB, WS_AK = WS_AQ + 12 * MiB, WS_AV = WS_AK + 4 * MiB, WS_CQ = WS_AV + 4 * MiB, WS_CK = WS_CQ + 12 * MiB, WS_CV = WS_CK + 4 * MiB;
constexpr size_t WS_B = WS_CV + 4 * MiB;
constexpr size_t BSZ = 16 * MiB;
constexpr size_t WS_SS = WS_B + 9 * BSZ;
constexpr size_t WS_DG = WS_SS + 32 * MiB;
constexpr size_t WS_PO = WS_DG + 1 * MiB;
constexpr size_t WS_PML = WS_PO + 16 * MiB;
constexpr size_t WS_END = WS_PML + 1 * MiB;
constexpr int CW_BAR = 4096;
constexpr int RING_OFF = 0, RING_BYTES = 131072;
constexpr int LDSCTL_OFF = RING_BYTES, MISC_OFF = LDSCTL_OFF + 320;
constexpr int LDS_BYTES = 147456;

#define GAS __attribute__((address_space(1)))
#define LAS __attribute__((address_space(3)))
typedef unsigned short bf16;
typedef unsigned v4u __attribute__((ext_vector_type(4)));
typedef unsigned v2u __attribute__((ext_vector_type(2)));
typedef float f32x4 __attribute__((ext_vector_type(4)));
typedef GAS unsigned gu32;
#define RLX_AGENT __ATOMIC_RELAXED, __HIP_MEMORY_SCOPE_AGENT
#define LDS_WAIT() asm volatile("s_waitcnt lgkmcnt(0)" ::: "memory")
#define VM_WAIT() asm volatile("s_waitcnt vmcnt(0)" ::: "memory")
__device__ __forceinline__ unsigned f2bf(float f) { unsigned u = __builtin_bit_cast(unsigned, f); return (u + 0x7fffu + ((u >> 16) & 1u)) >> 16; }
__device__ __forceinline__ unsigned pk2(float lo, float hi) { return f2bf(lo) | (f2bf(hi) << 16); }
__device__ __forceinline__ float bf2f(bf16 b) { return __uint_as_float((unsigned)b << 16); }

#define XB_TMO      128
#define XB_XCNT(j)  (256  + 64 * (j))
#define XB_XSUB(j)  (1280 + 64 * (j))
#define XB_XGEN(j)  (2304 + 64 * (j))
#define XB_TOP      3328
#define XB_TOPGEN   3392
#define XCD_BAR_WORDS 3456
#define XB_SPIN_CAP (1u << 18)

__device__ __forceinline__ unsigned xb_ld(unsigned* p)              { return __hip_atomic_load(p, __ATOMIC_RELAXED, __HIP_MEMORY_SCOPE_AGENT); }
__device__ __forceinline__ unsigned xb_add(unsigned* p, unsigned v) { return __hip_atomic_fetch_add(p, v, __ATOMIC_RELAXED, __HIP_MEMORY_SCOPE_AGENT); }
__device__ __forceinline__ unsigned xb_xcc_id() { return (unsigned)__builtin_amdgcn_s_getreg((3 << 11) | 20) & 0xFu; }
#define XB_SPIN(cond, bar) do { unsigned _sp = 0; while (cond) { __builtin_amdgcn_s_sleep(1); \
    if ((++_sp & 255u) == 0u) { if (xb_ld(&(bar)[XB_TMO])) break; if (_sp > XB_SPIN_CAP) { atomicAdd(&(bar)[XB_TMO], 1u); break; } } } } while (0)

struct XcdBarrier {
    unsigned* bar; unsigned x;
    volatile LAS unsigned* st;
};

__device__ __forceinline__ XcdBarrier xcd_barrier_post(unsigned* bar, volatile LAS unsigned* st) {
    XcdBarrier b; b.bar = bar; b.x = xb_xcc_id(); b.st = st;
    if (threadIdx.x == 0) (void)xb_add(&bar[XB_XCNT(b.x)], 1u);
    return b;
}
__device__ __forceinline__ void xcd_barrier_complete(unsigned* bar, unsigned x, unsigned& nloc, unsigned& nx) {
    const unsigned G = gridDim.x * gridDim.y * gridDim.z;
    unsigned sum, cnt, mine, sp = 0u;
    for (;;) {
        sum = 0u; cnt = 0u; mine = 0u;
#pragma unroll
        for (unsigned j = 0; j < 16; ++j) { const unsigned c = xb_ld(&bar[XB_XCNT(j)]); sum += c; cnt += (c > 0u) ? 1u : 0u; mine = (j == x) ? c : mine; }
        if (sum == G) break;
        __builtin_amdgcn_s_sleep(1);
        if ((++sp & 255u) == 0u) { if (xb_ld(&bar[XB_TMO])) break; if (sp > XB_SPIN_CAP) { atomicAdd(&bar[XB_TMO], 1u); break; } }
    }
    nloc = mine > 0u ? mine : 1u; nx = cnt > 0u ? cnt : 1u;
}

__device__ __forceinline__ void xcd_barrier(const XcdBarrier& b) {
    asm volatile("s_waitcnt vmcnt(0)" ::: "memory");
    __syncthreads();
    if (threadIdx.x == 0) {
        unsigned* bar = b.bar;
        __builtin_amdgcn_s_waitcnt(0);
        unsigned nloc = b.st[0], nx = b.st[1];
        if (nloc == 0u) { xcd_barrier_complete(bar, b.x, nloc, nx); b.st[0] = nloc; b.st[1] = nx; }
        const unsigned old = xb_add(&bar[XB_XSUB(b.x)], 1u);
        const unsigned gen = old / nloc;
        if (old + 1u == (gen + 1u) * nloc) {
            __builtin_amdgcn_fence(__ATOMIC_RELEASE, "agent");
            asm volatile("s_waitcnt vmcnt(0)" ::: "memory");
            const unsigned og = xb_add(&bar[XB_TOP], 1u);
            const unsigned tg = og / nx;
            if (og + 1u == (tg + 1u) * nx) xb_add(&bar[XB_TOPGEN], 1u);
            else XB_SPIN(xb_ld(&bar[XB_TOPGEN]) == tg, bar);
            __builtin_amdgcn_fence(__ATOMIC_ACQUIRE, "agent");
            xb_add(&bar[XB_XGEN(b.x)], 1u);
            asm volatile("s_waitcnt vmcnt(0)" ::: "memory");
        } else {
            XB_SPIN(xb_ld(&bar[XB_XGEN(b.x)]) == gen, bar);
            __builtin_amdgcn_fence(__ATOMIC_ACQUIRE, "agent");
            asm volatile("s_waitcnt vmcnt(0)" ::: "memory");
        }
    }
    __syncthreads();
}


struct Frame {
    LAS unsigned char* lds;
    volatile LAS unsigned* MISC;
    gu32* ctl;
    int tid, lane, wave, vcu, G;
};
__device__ __forceinline__ float wave_sum(float v) {
#pragma unroll
    for (int o = 1; o < 64; o <<= 1) v += __shfl_xor(v, o);
    return v;
}
__device__ __forceinline__ float wave_max(float v) {
#pragma unroll
    for (int o = 1; o < 64; o <<= 1) v = fmaxf(v, __shfl_xor(v, o));
    return v;
}
#define DPP_ADD(v, ctrl) v += __builtin_bit_cast(float, __builtin_amdgcn_update_dpp(0, __builtin_bit_cast(int, v), ctrl, 0xF, 0xF, true))
__device__ __forceinline__ float wave_sum_fast(float v) {
    DPP_ADD(v, 0xB1); DPP_ADD(v, 0x4E); DPP_ADD(v, 0x124); DPP_ADD(v, 0x128);
    { auto rr = __builtin_amdgcn_permlane16_swap(__float_as_uint(v), __float_as_uint(v), false, false); v = __uint_as_float(rr[0]) + __uint_as_float(rr[1]); }
    { auto rr = __builtin_amdgcn_permlane32_swap(__float_as_uint(v), __float_as_uint(v), false, false); v = __uint_as_float(rr[0]) + __uint_as_float(rr[1]); }
    return v;
}

__device__ __forceinline__ void p0_transpose_item(const float* W, int K, int N, bf16* WT, int k0, int n0, int drow, LAS float* scr, int lane) {
#pragma unroll 8
    for (int i = 0; i < 32; ++i) { const int kk = 2 * i + (lane >> 5); scr[kk * 33 + (lane & 31)] = W[(size_t)(k0 + kk) * N + n0 + (lane & 31)]; }
    LDS_WAIT(); asm volatile("" ::: "memory");
    const int c = lane & 7;
#pragma unroll
    for (int j = 0; j < 4; ++j) { const int n = (lane >> 3) + 8 * j; const LAS float* s = scr + (8 * c) * 33 + n;
        v4u o; o.x = pk2(s[0 * 33], s[1 * 33]); o.y = pk2(s[2 * 33], s[3 * 33]); o.z = pk2(s[4 * 33], s[5 * 33]); o.w = pk2(s[6 * 33], s[7 * 33]);
        *(GAS v4u*)(WT + (size_t)(drow + n) * K + k0 + 8 * c) = o; }
    LDS_WAIT(); asm volatile("" ::: "memory");
}
__device__ __forceinline__ int t5_bucket(int rel) {
    const int n = rel < 0 ? -rel : rel;
    int b;
    if (n < 8) b = n; else { const int lg = 31 - __builtin_clz((unsigned)(n * n)); b = 8 + (lg - 6); if (b > 15) b = 15; }
    return (rel > 0 ? 16 : 0) + b;
}

struct Args { const float* in[15]; float* out; unsigned char* ws; int ph_lo, ph_hi; };

__device__ __forceinline__ void row_phase(const Frame& F, const float* X, const float* Y, float* Xout, bf16* Hout, const float* wpost, const float* wnext, float coef) {
    const int gw = F.vcu * NWAVES + F.wave, NGW = F.G * NWAVES;
    for (int r = gw; r < S; r += NGW) {
        const GAS f32x4* yr = (const GAS f32x4*)(Y + (size_t)r * DM) + F.lane; const GAS f32x4* xr = (const GAS f32x4*)(X + (size_t)r * DM) + F.lane;
        f32x4 y[8], x[8]; float s = 0.f;
#pragma unroll
        for (int j = 0; j < 8; ++j) { y[j] = yr[64 * j]; x[j] = xr[64 * j]; s += (y[j].x * y[j].x + y[j].y * y[j].y) + (y[j].z * y[j].z + y[j].w * y[j].w); }
        const float r1 = coef / sqrtf(wave_sum(s) * (1.f / DM) + EPS); float s2 = 0.f;
        GAS f32x4* xo = (GAS f32x4*)(Xout + (size_t)r * DM) + F.lane;
#pragma unroll
        for (int j = 0; j < 8; ++j) { const f32x4 w = *((const GAS f32x4*)wpost + F.lane + 64 * j); x[j] = x[j] + y[j] * r1 * w; xo[64 * j] = x[j];
            s2 += (x[j].x * x[j].x + x[j].y * x[j].y) + (x[j].z * x[j].z + x[j].w * x[j].w); }
        if (Hout) { const float r2 = 1.f / sqrtf(wave_sum(s2) * (1.f / DM) + EPS);
            GAS v2u* ho = (GAS v2u*)(Hout + (size_t)r * DM) + F.lane;
#pragma unroll
            for (int j = 0; j < 8; ++j) { const f32x4 w = *((const GAS f32x4*)wnext + F.lane + 64 * j); const f32x4 v = x[j] * r2 * w; v2u o; o.x = pk2(v.x, v.y); o.y = pk2(v.z, v.w); ho[64 * j] = o; } }
    }
}
__device__ __forceinline__ void row_first(const Frame& F, const float* Xin, float* Xout, bf16* Hout, const float* wnext) {
    const int gw = F.vcu * NWAVES + F.wave, NGW = F.G * NWAVES;
    for (int r = gw; r < S; r += NGW) {
        const GAS f32x4* xr = (const GAS f32x4*)(Xin + (size_t)r * DM) + F.lane; GAS f32x4* xo = (GAS f32x4*)(Xout + (size_t)r * DM) + F.lane;
        f32x4 x[8]; float s2 = 0.f;
#pragma unroll
        for (int j = 0; j < 8; ++j) { x[j] = xr[64 * j]; xo[64 * j] = x[j]; s2 += (x[j].x * x[j].x + x[j].y * x[j].y) + (x[j].z * x[j].z + x[j].w * x[j].w); }
        const float r2 = 1.f / sqrtf(wave_sum(s2) * (1.f / DM) + EPS);
        GAS v2u* ho = (GAS v2u*)(Hout + (size_t)r * DM) + F.lane;
#pragma unroll
        for (int j = 0; j < 8; ++j) { const f32x4 w = *((const GAS f32x4*)wnext + F.lane + 64 * j); const f32x4 v = x[j] * r2 * w; v2u o; o.x = pk2(v.x, v.y); o.y = pk2(v.z, v.w); ho[64 * j] = o; }
    }
}

#define WSL() ({ GAS unsigned char* p_ = (GAS unsigned char*)args.ws; asm volatile("" : "+s"(p_)); (unsigned char*)p_; })
#define BID() ({ int b_ = (int)blockIdx.x; asm volatile("" : "+s"(b_)); b_; })
#define GRD() ({ int g_ = (int)gridDim.x; asm volatile("" : "+s"(g_)); g_; })
#define INP(i) ({ int i_ = (i); asm volatile("" : "+s"(i_)); (const float*)(const GAS float*)args.in[i_]; })
#define PHASE_FRAME() Frame F = F0; { asm volatile("" : "+s"(F.vcu), "+s"(F.G)); int t_ = threadIdx.x; asm volatile("" : "+v"(t_)); F.tid = t_; F.lane = t_ & 63; F.wave = __builtin_amdgcn_readfirstlane(t_ >> 6); }
__global__ void __launch_bounds__(NWAVES * 64, 2) fwd(Args args) {
    extern __shared__ __attribute__((aligned(16))) unsigned char lds[];
    Frame F0;
    F0.lds = (LAS unsigned char*)lds;
    F0.MISC = (volatile LAS unsigned*)(F0.lds + MISC_OFF);
    F0.tid = threadIdx.x; F0.lane = F0.tid & 63; F0.wave = __builtin_amdgcn_readfirstlane(F0.tid >> 6);
    F0.G = gridDim.x; { const int bx = blockIdx.x; F0.vcu = (F0.G % 8 == 0) ? (bx % 8) * (F0.G / 8) + bx / 8 : bx; }
    F0.ctl = (gu32*)(args.ws + WS_CTL);
    for (int u = F0.tid; u < (LDS_BYTES - LDSCTL_OFF) / 4; u += NWAVES * 64) ((LAS unsigned*)(F0.lds + LDSCTL_OFF))[u] = 0u;
    __syncthreads();
    const int lo = args.ph_lo, hi = args.ph_hi;
    XcdBarrier bar; bar.bar = (unsigned*)(F0.ctl + CW_BAR); bar.x = 0; bar.st = nullptr;
    if (hi - lo > 1) bar = xcd_barrier_post((unsigned*)(F0.ctl + CW_BAR), F0.MISC + 8);
    int ph = 0;
#define PH_ON (lo <= ph && ph < hi)
#define PH_END do { if (lo <= ph && ph + 1 < hi) { XcdBarrier b2_ = bar; { GAS unsigned* bp_ = (GAS unsigned*)bar.bar; asm volatile("" : "+s"(bp_), "+s"(b2_.x)); b2_.bar = (unsigned*)bp_; } xcd_barrier(b2_); } ++ph; } while (0)

    if (PH_ON) {
        PHASE_FRAME(); unsigned char* ws = WSL();
        const float* w_in = INP(1); const float* w_out = INP(2); const float* f1g = INP(3); const float* f1u = INP(4); const float* f1d = INP(5);
        const float* f2g = INP(6); const float* f2u = INP(7); const float* f2d = INP(8);
        LAS float* scr = (LAS float*)(F.lds + RING_OFF + F.wave * 16384);
        const int gw = F.vcu * NWAVES + F.wave, NGW = F.G * NWAVES;
        constexpr int I_G = (DM / 64) * (DFF / 32), I_D = (DFF / 64) * (DM / 32), I_IN = (DM / 64) * (DIN / 32), I_OUT = (DM / 64) * (DM / 32);
        constexpr int I_LAYER = 6 * I_G + I_IN + I_OUT;
        static_assert(I_D == I_G, "item counts");
        for (int it = gw; it < NL * I_LAYER; it += NGW) {
            const int l = it / I_LAYER; int r = it - l * I_LAYER;
            unsigned char* wl = ws + WS_W + (size_t)l * W_LAYER;
            if (r < 2 * I_G || (r >= 3 * I_G + I_IN + I_OUT && r < 5 * I_G + I_IN + I_OUT)) {
                const bool second = r >= 2 * I_G; if (second) r -= 3 * I_G + I_IN + I_OUT;
                const bool up = r >= I_G; if (up) r -= I_G;
                const float* W = (second ? (up ? f2u : f2g) : (up ? f1u : f1g)) + (size_t)l * DM * DFF;
                const int nblk = DFF / 32, kb = r / nblk, nb = r - kb * nblk, n0 = 32 * nb;
                const int drow = (n0 >> 7) * 256 + (n0 & 127) + (up ? 128 : 0);
                p0_transpose_item(W, DM, DFF, (bf16*)(wl + (second ? W_GU2 : W_GU1)), 64 * kb, n0, drow, scr, F.lane);
            } else if (r < 3 * I_G) {
                r -= 2 * I_G; const int nblk = DM / 32, kb = r / nblk, nb = r - kb * nblk;
                p0_transpose_item(f1d + (size_t)l * DFF * DM, DFF, DM, (bf16*)(wl + W_DN1), 64 * kb, 32 * nb, 32 * nb, scr, F.lane);
            } else if (r < 3 * I_G + I_IN) {
                r -= 3 * I_G; const int nblk = DIN / 32, kb = r / nblk, nb = r - kb * nblk, n0 = 32 * nb, tile = n0 >> 8, q = n0 & 255;
                const int qq = (tile >= 15 && tile <= 18) ? (((q & 63) >> 5) * 128 + (q >> 6) * 32) : q;
                p0_transpose_item(w_in + (size_t)l * DM * DIN, DM, DIN, (bf16*)(wl + W_WIN), 64 * kb, n0, tile * 256 + qq, scr, F.lane);
            } else if (r < 3 * I_G + I_IN + I_OUT) {
                r -= 3 * I_G + I_IN; const int nblk = DM / 32, kb = r / nblk, nb = r - kb * nblk;
                p0_transpose_item(w_out + (size_t)l * DM * DM, DM, DM, (bf16*)(wl + W_WOUT), 64 * kb, 32 * nb, 32 * nb, scr, F.lane);
            } else {
                r -= 5 * I_G + I_IN + I_OUT; const int nblk = DM / 32, kb = r / nblk, nb = r - kb * nblk;
                p0_transpose_item(f2d + (size_t)l * DFF * DM, DFF, DM, (bf16*)(wl + W_DN2), 64 * kb, 32 * nb, 32 * nb, scr, F.lane);
            }
        }
        {
            float* rtab = (float*)(ws + WS_TAB + TAB_RT); float* ctab = (float*)(ws + WS_TAB + TAB_CT); float* tbt = (float*)(ws + WS_TAB + TAB_TB); float* lbs = (float*)(ws + WS_TAB + TAB_LB);
            const float* hg_lb = INP(12); const float* rel_b = INP(14);
            const int gid = F.vcu * (NWAVES * 64) + F.tid;
            if (gid < 3072) {
                const int pos = gid >> 4, j = gid & 15; const int p = pos < 128 ? pos : pos - 128;
                const float inv = 1.0f / exp2f((float)j * (1.0f / 16.0f) * 13.287712379549449f);
                const float ang = (float)p * inv;
                double rev = (double)ang * 0.15915494309189535; rev -= rint(rev); const float rv = (float)rev;
                float* dst = (pos < 128 ? rtab + pos * 32 : ctab + p * 32) + 2 * j;
                dst[0] = __builtin_amdgcn_cosf(rv); dst[1] = __builtin_amdgcn_sinf(rv);
            }
            if (gid < 12 * 257) { const int h = gid / 257, r = gid - h * 257; tbt[h * 260 + r] = rel_b[t5_bucket(r - 128) * 12 + h] * pg8::LOG2E; }
            if (gid < 1024) {
                float v[NL], mx = -INFINITY;
#pragma unroll
                for (int l = 0; l < NL; ++l) { v[l] = hg_lb[l * 1024 + gid]; mx = fmaxf(mx, v[l]); }
                float sum = 0.f;
#pragma unroll
                for (int l = 0; l < NL; ++l) { v[l] = __expf(v[l] - mx); sum += v[l]; }
                float c = 0.f; lbs[gid] = 0.f;
#pragma unroll
                for (int l = 1; l < NL; ++l) { c += v[l] / sum; lbs[l * 1024 + gid] = c; }
            }
        }
        row_first(F, INP(0), (float*)(ws + WS_X), (bf16*)(ws + WS_H), INP(9));
    }
    PH_END;

    for (int l = 0; l < NL; ++l) {
        if (PH_ON) { unsigned char* ws = WSL(); const unsigned char* wl = ws + WS_W + (size_t)l * W_LAYER;
            pg8::Gemm g{(const bf16*)(ws + WS_H), (const bf16*)(wl + W_GU1), S, NGU, DM}; pg8::StaticOrder so; so.init(S, NGU, GRD(), BID());
            pg8::EpiSwiGLU E{(bf16*)(ws + WS_ACT), DFF}; pg8::gemm_phase<pg8::EpiSwiGLU, pg8::StaticOrder, true, true>(F0.lds + RING_OFF, g, so, E); }
        PH_END;
        if (PH_ON) { unsigned char* ws = WSL(); const unsigned char* wl = ws + WS_W + (size_t)l * W_LAYER;
            pg8::Gemm g{(const bf16*)(ws + WS_ACT), (const bf16*)(wl + W_DN1), S, DM, DFF}; pg8::StaticOrder so; so.init(S, DM, GRD(), BID());
            pg8::EpiF32 E{(float*)(ws + WS_Y), DM}; pg8::gemm_phase<pg8::EpiF32, pg8::StaticOrder, true, true>(F0.lds + RING_OFF, g, so, E); }
        PH_END;
        if (PH_ON) { PHASE_FRAME(); unsigned char* ws = WSL(); const float* nw = INP(9) + (size_t)l * 6 * DM;
            row_phase(F, (float*)(ws + WS_X), (float*)(ws + WS_Y), (float*)(ws + WS_X), (bf16*)(ws + WS_H), nw + 1 * DM, nw + 2 * DM, 0.5f); }
        PH_END;
        if (PH_ON) { unsigned char* ws = WSL(); const unsigned char* wl = ws + WS_W + (size_t)l * W_LAYER;
            pg8::Gemm g{(const bf16*)(ws + WS_H), (const bf16*)(wl + W_WIN), S, DIN, DM}; pg8::StaticOrder so; so.init(S, DIN, GRD(), BID());
            float* Bb = (float*)(ws + WS_B); constexpr size_t BE = BSZ / 4;
            pg8::EpiWin E{(bf16*)(ws + WS_AQ), (bf16*)(ws + WS_AK), (bf16*)(ws + WS_AV), (bf16*)(ws + WS_CQ), (bf16*)(ws + WS_CK), (bf16*)(ws + WS_CV),
                          Bb, Bb + BE, Bb + 2 * BE, Bb + 3 * BE, Bb + 4 * BE, Bb + 5 * BE, Bb + 6 * BE,
                          (const float*)(ws + WS_TAB + TAB_LB) + l * 1024, INP(11) + l * 128, (const float*)(ws + WS_TAB + TAB_RT), (const float*)(ws + WS_TAB + TAB_CT)};
            pg8::gemm_phase<pg8::EpiWin, pg8::StaticOrder, true, true>(F0.lds + RING_OFF, g, so, E); }
        PH_END;
        if (PH_ON) {
            { unsigned char* ws = WSL(); float* Bb = (float*)(ws + WS_B); constexpr size_t BE = BSZ / 4;
              hg::pass1(GRD(), BID(), Bb + 2 * BE, Bb + BE, Bb + 4 * BE, Bb + 3 * BE, Bb + 5 * BE, Bb + 7 * BE, (float*)(ws + WS_DG), F0.lds + RING_OFF); }
            { unsigned char* ws = WSL();
              const attn_body::bf16* CQ = (const attn_body::bf16*)(ws + WS_CQ); const attn_body::bf16* CK = (const attn_body::bf16*)(ws + WS_CK); const attn_body::bf16* CV = (const attn_body::bf16*)(ws + WS_CV);
              attn_body::bf16* MIXo = (attn_body::bf16*)(ws + WS_MIX);
              const int gA = GRD(), bA = BID();
              if (gA == 256) {
                { const int u = bA, h = u >> 5, qb = u & 31, kvh = h / 3;
                  attn_body::attn_unit<8, 768, 256, 2048, 0>(qb * 256, S / 64, CQ + h * 64, CK + kvh * 64, CV + kvh * 64, MIXo + 1280 + h * 64, (char*)lds + RING_OFF); }
                { const int su = bA >> 1, half = bA & 1, u = 256 + su, h = u >> 5, qb = u & 31, kvh = h / 3;
                  float* po = (float*)(ws + WS_PO) + ((size_t)su * 2 + half) * 16384; float* pml = (float*)(ws + WS_PML) + ((size_t)su * 2 + half) * 512;
                  attn_body::attn_unit<8, 768, 256, 2048, 0, true>(qb * 256, S / 128, CQ + h * 64, CK + kvh * 64 + (size_t)half * 4096 * 256, CV + kvh * 64 + (size_t)half * 4096 * 256, MIXo, (char*)lds + RING_OFF,
                                                                  nullptr, 0.f, 0, po, pml); }
              } else {
                for (int u = bA; u < 384; u += gA) { const int h = u >> 5, qb = u & 31, kvh = h / 3;
                  attn_body::attn_unit<8, 768, 256, 2048, 0>(qb * 256, S / 64, CQ + h * 64, CK + kvh * 64, CV + kvh * 64, MIXo + 1280 + h * 64, (char*)lds + RING_OFF); }
              } }
            { unsigned char* ws = WSL();
              const attn_body::bf16* AQp = (const attn_body::bf16*)(ws + WS_AQ); const attn_body::bf16* AKp = (const attn_body::bf16*)(ws + WS_AK); const attn_body::bf16* AVp = (const attn_body::bf16*)(ws + WS_AV);
              attn_body::bf16* MIXo = (attn_body::bf16*)(ws + WS_MIX); const float* tbp = (const float*)(ws + WS_TAB + TAB_TB); const float* skp = INP(10) + l * 12;
              const int gB = GRD(); for (int u = BID(); u < 384; u += gB) { const int h = u >> 5, qb = u & 31, kvh = h / 3;
                const int t_lo = qb * 4 - 2 < 0 ? 0 : qb * 4 - 2, t_hi = qb * 4 + 6 > S / 64 ? S / 64 : qb * 4 + 6;
                attn_body::attn_unit<8, 768, 256, 2048, 1>(qb * 256, t_hi - t_lo, AQp + h * 64, AKp + kvh * 64 + (size_t)t_lo * 64 * 256, AVp + kvh * 64 + (size_t)t_lo * 64 * 256, MIXo + h * 64, (char*)lds + RING_OFF,
                                                           tbp + h * 260, skp[h] * pg8::LOG2E, t_lo * 64); } }
        }
        PH_END;
        if (PH_ON) { unsigned char* ws = WSL(); hg::scan(GRD(), ({ int v_ = F0.vcu; asm volatile("" : "+s"(v_)); v_; }), (const float*)(ws + WS_B + 7 * BSZ), (const float*)(ws + WS_DG), (float*)(ws + WS_SS)); }
        PH_END;
        if (PH_ON) { unsigned char* ws = WSL(); float* Bb = (float*)(ws + WS_B); constexpr size_t BE = BSZ / 4;
            if (GRD() == 256) {
                int t_ = threadIdx.x; asm volatile("" : "+v"(t_)); const int bM = BID(), su = bM >> 1, u = 256 + su, h = u >> 5, qb = u & 31;
                const int row = 128 * (bM & 1) + (t_ >> 2), c0 = (t_ & 3) * 16;
                const float* p0 = (const float*)(ws + WS_PO) + ((size_t)su * 2) * 16384 + row * 64 + c0; const float* p1 = p0 + 16384;
                const float* ml0 = (const float*)(ws + WS_PML) + ((size_t)su * 2) * 512 + row * 2; const float* ml1 = ml0 + 512;
                const float m0 = ml0[0], l0 = ml0[1], m1 = ml1[0], l1 = ml1[1], mm = fmaxf(m0, m1), w0 = __builtin_amdgcn_exp2f(m0 - mm), w1 = __builtin_amdgcn_exp2f(m1 - mm);
                const float inv = 1.0f / (l0 * w0 + l1 * w1), a0 = w0 * inv, a1 = w1 * inv;
                bf16* op = (bf16*)(ws + WS_MIX) + (size_t)(qb * 256 + row) * 2048 + 1280 + h * 64 + c0;
#pragma unroll
                for (int j = 0; j < 2; ++j) { const f32x4 x0 = *(const f32x4*)(p0 + 8 * j), x1 = *(const f32x4*)(p0 + 8 * j + 4), y0 = *(const f32x4*)(p1 + 8 * j), y1 = *(const f32x4*)(p1 + 8 * j + 4);
                    const f32x4 r0 = x0 * a0 + y0 * a1, r1 = x1 * a0 + y1 * a1; v4u o; o.x = pk2(r0.x, r0.y); o.y = pk2(r0.z, r0.w); o.z = pk2(r1.x, r1.y); o.w = pk2(r1.z, r1.w);
                    *(v4u*)(op + 8 * j) = o; }
            }
            hg::pass2(GRD(), BID(), Bb, Bb + BE, Bb + 2 * BE, Bb + 3 * BE, Bb + 4 * BE, Bb + 5 * BE, Bb + 6 * BE, (const float*)(ws + WS_SS), INP(13) + l * 128, (bf16*)(ws + WS_MIX), F0.lds + RING_OFF); }
        PH_END;
        if (PH_ON) { unsigned char* ws = WSL(); const unsigned char* wl = ws + WS_W + (size_t)l * W_LAYER;
            pg8::Gemm g{(const bf16*)(ws + WS_MIX), (const bf16*)(wl + W_WOUT), S, DM, DM}; pg8::StaticOrder so; so.init(S, DM, GRD(), BID());
            pg8::EpiF32 E{(float*)(ws + WS_Y), DM}; pg8::gemm_phase<pg8::EpiF32, pg8::StaticOrder, true, true>(F0.lds + RING_OFF, g, so, E); }
        PH_END;
        if (PH_ON) { PHASE_FRAME(); unsigned char* ws = WSL(); const float* nw = INP(9) + (size_t)l * 6 * DM;
            row_phase(F, (float*)(ws + WS_X), (float*)(ws + WS_Y), (float*)(ws + WS_X), (bf16*)(ws + WS_H), nw + 3 * DM, nw + 4 * DM, 1.0f); }
        PH_END;
        if (PH_ON) { unsigned char* ws = WSL(); const unsigned char* wl = ws + WS_W + (size_t)l * W_LAYER;
            pg8::Gemm g{(const bf16*)(ws + WS_H), (const bf16*)(wl + W_GU2), S, NGU, DM}; pg8::StaticOrder so; so.init(S, NGU, GRD(), BID());
            pg8::EpiSwiGLU E{(bf16*)(ws + WS_ACT), DFF}; pg8::gemm_phase<pg8::EpiSwiGLU, pg8::StaticOrder, true, true>(F0.lds + RING_OFF, g, so, E); }
        PH_END;
        if (PH_ON) { unsigned char* ws = WSL(); const unsigned char* wl = ws + WS_W + (size_t)l * W_LAYER;
            pg8::Gemm g{(const bf16*)(ws + WS_ACT), (const bf16*)(wl + W_DN2), S, DM, DFF}; pg8::StaticOrder so; so.init(S, DM, GRD(), BID());
            pg8::EpiF32 E{(float*)(ws + WS_Y), DM}; pg8::gemm_phase<pg8::EpiF32, pg8::StaticOrder, true, true>(F0.lds + RING_OFF, g, so, E); }
        PH_END;
        if (PH_ON) { PHASE_FRAME(); unsigned char* ws = WSL(); const float* nw = INP(9) + (size_t)l * 6 * DM; const bool lastl = (l == NL - 1);
            row_phase(F, (float*)(ws + WS_X), (float*)(ws + WS_Y), lastl ? (float*)(GAS float*)args.out : (float*)(ws + WS_X), lastl ? (bf16*)nullptr : (bf16*)(ws + WS_H), nw + 5 * DM, nw + 6 * DM, 0.5f); }
        PH_END;
    }
#undef PH_ON
#undef PH_END
}
constexpr int N_PHASES = 1 + NL * 12;

extern "C" void kernel_launch(void* const* d_in, const int* in_sizes, int n_in, void* d_out, int out_size, void* d_ws, size_t ws_size, hipStream_t stream) {
    static int grid = 0;
    if (grid == 0) {
        if (n_in != 15 || in_sizes[0] != S * DM || out_size != S * DM || ws_size < WS_END) { fprintf(stderr, "kernel_launch: unexpected shapes / workspace (n_in %d, in0 %d, out %d, ws %zu < %zu); nothing launched\n", n_in, n_in > 0 ? in_sizes[0] : -1, out_size, ws_size, (size_t)WS_END); grid = -1; return; }
        int dev = 0, cus = 0, per_cu = 0;
        if (hipGetDevice(&dev) != hipSuccess || hipDeviceGetAttribute(&cus, hipDeviceAttributeMultiprocessorCount, dev) != hipSuccess) { grid = -1; return; }
        if (hipFuncSetAttribute((const void*)fwd, hipFuncAttributeMaxDynamicSharedMemorySize, LDS_BYTES) != hipSuccess) { fprintf(stderr, "kernel_launch: hipFuncSetAttribute failed\n"); grid = -1; return; }
        if (hipOccupancyMaxActiveBlocksPerMultiprocessor(&per_cu, (const void*)fwd, NWAVES * 64, LDS_BYTES) != hipSuccess || per_cu < 1)
            fprintf(stderr, "kernel_launch: note: occupancy query reports %d workgroups per CU\n", per_cu);
        (void)hipGetLastError();
        grid = cus;
    }
    if (grid < 0) return;
    if (hipMemsetAsync((char*)d_ws + WS_CTL, 0, CTL_ZERO_BYTES, stream) != hipSuccess) { fprintf(stderr, "kernel_launch: memset failed\n"); return; }
    Args a{};
    for (int i = 0; i < 15; ++i) a.in[i] = (const float*)d_in[i];
    a.out = (float*)d_out; a.ws = (unsigned char*)d_ws;
#if MK_SPLIT
    for (int p = 0; p < N_PHASES; ++p) { a.ph_lo = p; a.ph_hi = p + 1; hipLaunchKernelGGL(fwd, dim3(grid), dim3(NWAVES * 64), LDS_BYTES, stream, a); }
#else
    a.ph_lo = 0; a.ph_hi = N_PHASES;
    hipLaunchKernelGGL(fwd, dim3(grid), dim3(NWAVES * 64), LDS_BYTES, stream, a);
#endif
    const hipError_t le = hipPeekAtLastError();
    if (le != hipSuccess) fprintf(stderr, "kernel_launch: launch failed: %s\n", hipGetErrorName(le));
}
```

```cpp
#include <hip/hip_runtime.h>
#include <hip/hip_bf16.h>
#include <cstdio>
#include <cstdint>
#include <cmath>
namespace pg8 {
#define PG8_LAS __attribute__((address_space(3)))
typedef unsigned short bf16_t;
typedef short bf16x8 __attribute__((ext_vector_type(8)));
typedef float f32x4 __attribute__((ext_vector_type(4)));
typedef unsigned u32x4 __attribute__((ext_vector_type(4)));
constexpr int BM = 256, BK = 64, HALF = 128, HTB = HALF * BK * 2  , STAGE_BYTES = 8 * HTB, NXCD = 8, WGM = 8;

__host__ __device__ __forceinline__ int lds_byte(int r, int c) { const int st = (r >> 4) * 2 + (c >> 5), rr = r & 15, cc = c & 31, ob = rr * 64 + cc * 2; return st * 1024 + (ob ^ (((ob >> 9) & 1) << 5)); }
__host__ __device__ __forceinline__ void stage_rc(int b, int& R, int& C) { const int st = b / 1024, sb = b % 1024, swz = sb ^ (((sb >> 9) & 1) << 5); R = (st >> 1) * 16 + swz / 64; C = (st & 1) * 32 + (swz % 64) / 2; }
__host__ __device__ __forceinline__ int perm32(int rho) { const int n = rho >> 4, i = rho & 15; return 8 * (i >> 2) + 4 * n + (i & 3); }

struct Unit { int pm, pn; };
struct Gemm { const bf16_t* A; const bf16_t* Bt; int M, N, K; };

struct StaticOrder {
    int nM, nN, nwg, G, c;
    __host__ __device__ void init(int M, int N, int G_, int c_) { nM = M / BM; nN = N / BM; nwg = nM * nN; G = G_; c = c_; }
    __host__ __device__ bool next(int i, Unit& u) const {
        const long L = (long)i * G + c; if (L >= nwg) return false;
        int wgid = (int)L; { const int q = nwg / NXCD, r = nwg % NXCD, xcd = wgid % NXCD, off = wgid / NXCD; wgid = (xcd < r ? xcd * (q + 1) : r * (q + 1) + (xcd - r) * q) + off; }
        const int nig = WGM * nN, gid = wgid / nig, fm = gid * WGM, gsz = (nM - fm) < WGM ? (nM - fm) : WGM;
        u.pm = fm + ((wgid % nig) % gsz); u.pn = (wgid % nig) / gsz; return true;
    }
    __device__ __forceinline__ void a_ready(const Unit&) const {}
    __device__ __forceinline__ void done(const Unit&) const {}
};

__device__ __forceinline__ unsigned cvt_pk_bf16(float lo, float hi) { unsigned r; asm volatile("v_cvt_pk_bf16_f32 %0, %1, %2" : "=v"(r) : "v"(lo), "v"(hi)); return r; }
typedef float f32x2 __attribute__((ext_vector_type(2)));
constexpr float LOG2E = 1.4426950408889634f;
constexpr float QSCALE = 0.125f * 1.4426950408889634f;
__device__ __forceinline__ float sigmoid_f(float x) { return __builtin_amdgcn_rcpf(1.0f + __builtin_amdgcn_exp2f(-LOG2E * x)); }

struct EpiF32 {
    static constexpr bool PERM = false, AFTER_DRAIN = false;
    float* C; int ldc;
    __device__ __forceinline__ void operator()(const f32x4 (&acc)[2][2][4][2], const Unit& u, int wr, int wc, int fr, int fq) const {
        const int row0 = u.pm * BM + wr * 64 + fr, col0 = u.pn * BM + wc * 32 + 4 * fq;
#pragma unroll
        for (int ai = 0; ai < 2; ++ai)
#pragma unroll
            for (int m = 0; m < 4; ++m) { float* rowp = C + (size_t)(row0 + ai * HALF + m * 16) * ldc + col0;
#pragma unroll
                for (int bj = 0; bj < 2; ++bj)
#pragma unroll
                    for (int n = 0; n < 2; ++n) *(f32x4*)(rowp + bj * HALF + n * 16) = acc[ai][bj][m][n]; }
    }
};


struct EpiBf16Y {
    static constexpr bool PERM = true, AFTER_DRAIN = false;
    bf16_t* O; int ldc;
    __device__ __forceinline__ void operator()(const f32x4 (&acc)[2][2][4][2], const Unit& u, int wr, int wc, int fr, int fq) const {
        const int row0 = u.pm * BM + wr * 64 + fr, col0 = u.pn * BM + wc * 32 + 8 * fq;
#pragma unroll
        for (int ai = 0; ai < 2; ++ai)
#pragma unroll
            for (int m = 0; m < 4; ++m) { bf16_t* rowp = O + (size_t)(row0 + ai * HALF + m * 16) * ldc + col0;
#pragma unroll
                for (int bj = 0; bj < 2; ++bj) { const f32x4 v0 = acc[ai][bj][m][0], v1 = acc[ai][bj][m][1];
                    u32x4 w; w.x = cvt_pk_bf16(v0[0], v0[1]); w.y = cvt_pk_bf16(v0[2], v0[3]); w.z = cvt_pk_bf16(v1[0], v1[1]); w.w = cvt_pk_bf16(v1[2], v1[3]);
                    *(u32x4*)(rowp + bj * HALF) = w; } }
    }
};

struct EpiSwiGLU {
    static constexpr bool PERM = true, AFTER_DRAIN = false;
    bf16_t* O; int ldc;
    __device__ __forceinline__ void operator()(const f32x4 (&acc)[2][2][4][2], const Unit& u, int wr, int wc, int fr, int fq) const {
        const int row0 = u.pm * BM + wr * 64 + fr, col0 = u.pn * HALF + wc * 32 + 8 * fq;
#pragma unroll
        for (int ai = 0; ai < 2; ++ai)
#pragma unroll
            for (int m = 0; m < 4; ++m) { bf16_t* rowp = O + (size_t)(row0 + ai * HALF + m * 16) * ldc + col0;
                float o[8];
#pragma unroll
                for (int n = 0; n < 2; ++n)
#pragma unroll
                    for (int i = 0; i < 4; ++i) { const float g = acc[ai][0][m][n][i], up = acc[ai][1][m][n][i]; o[4 * n + i] = g * sigmoid_f(g) * up; }
                u32x4 w; w.x = cvt_pk_bf16(o[0], o[1]); w.y = cvt_pk_bf16(o[2], o[3]); w.z = cvt_pk_bf16(o[4], o[5]); w.w = cvt_pk_bf16(o[6], o[7]);
                *(u32x4*)rowp = w; }
    }
};

struct EpiWin {
    static constexpr bool PERM = true, AFTER_DRAIN = false;
    bf16_t *AQ, *AK, *AV, *CQ, *CK, *CV;
    unsigned char* Bb;
    const float* lb;
    const float* qkw;
    const float* rtab; const float* ctab;
    __device__ __forceinline__ void operator()(const f32x4 (&acc)[2][2][4][2], const Unit& u, int wr, int wc, int fr, int fq) const {
        const int pn = u.pn, row0 = u.pm * BM + wr * 64 + fr, cl = wc * 32 + 8 * fq;
        if (pn < 5 || pn == 19) {
            bf16_t* base; int ldc, colt; float sc = 1.f;
            if (pn < 3) { base = AQ; ldc = 768; colt = pn * 256; sc = QSCALE; } else if (pn == 3) { base = AK; ldc = 256; colt = 0; } else if (pn == 4) { base = AV; ldc = 256; colt = 0; } else { base = CV; ldc = 256; colt = 0; }
#pragma unroll
            for (int ai = 0; ai < 2; ++ai)
#pragma unroll
                for (int m = 0; m < 4; ++m) { bf16_t* rowp = base + (size_t)(row0 + ai * HALF + m * 16) * ldc + colt + cl;
#pragma unroll
                    for (int bj = 0; bj < 2; ++bj) { const f32x4 v0 = acc[ai][bj][m][0] * sc, v1 = acc[ai][bj][m][1] * sc;
                        u32x4 w; w.x = cvt_pk_bf16(v0[0], v0[1]); w.y = cvt_pk_bf16(v0[2], v0[3]); w.z = cvt_pk_bf16(v1[0], v1[1]); w.w = cvt_pk_bf16(v1[2], v1[3]);
                        *(u32x4*)(rowp + bj * HALF) = w; } }
        } else if (pn < 15) {
            const int sec = (pn - 5) >> 1, colt = ((pn - 5) & 1) * 256;
            if (sec == 1 || sec == 2) {
                float* o2 = (float*)(Bb + ((size_t)(sec + 1) << 24)); const float* lbp = lb + (sec == 2 ? 512 : 0);
#pragma unroll
                for (int bj = 0; bj < 2; ++bj) { const int col = colt + bj * HALF + cl;
                    const f32x4 lv0 = *(const f32x4*)(lbp + col), lv1 = *(const f32x4*)(lbp + col + 4);
#pragma unroll
                    for (int ai = 0; ai < 2; ++ai)
#pragma unroll
                        for (int m = 0; m < 4; ++m) { const size_t off = (size_t)(row0 + ai * HALF + m * 16) * 512 + col;
                            const f32x4 a0 = acc[ai][bj][m][0], a1 = acc[ai][bj][m][1]; f32x4 f0, f1;
#pragma unroll
                            for (int i = 0; i < 4; ++i) { f0[i] = lv0[i] + (1.f - lv0[i]) * sigmoid_f(a0[i]); f1[i] = lv1[i] + (1.f - lv1[i]) * sigmoid_f(a1[i]); }
                            *(f32x4*)(o2 + off) = f0; *(f32x4*)(o2 + off + 4) = f1; } }
            } else {
                bf16_t* o1 = (bf16_t*)(Bb + ((size_t)(sec == 0 ? 0 : sec - 2) << 23));
#pragma unroll
                for (int bj = 0; bj < 2; ++bj) { const int col = colt + bj * HALF + cl;
#pragma unroll
                    for (int ai = 0; ai < 2; ++ai)
#pragma unroll
                        for (int m = 0; m < 4; ++m) { const size_t off = (size_t)(row0 + ai * HALF + m * 16) * 512 + col;
                            f32x4 a0 = acc[ai][bj][m][0], a1 = acc[ai][bj][m][1];
                            if (sec != 3) {
#pragma unroll
                                for (int i = 0; i < 4; ++i) { a0[i] = a0[i] * sigmoid_f(a0[i]); a1[i] = a1[i] * sigmoid_f(a1[i]); } }
                            u32x4 w; w.x = cvt_pk_bf16(a0[0], a0[1]); w.y = cvt_pk_bf16(a0[2], a0[3]); w.z = cvt_pk_bf16(a1[0], a1[1]); w.w = cvt_pk_bf16(a1[2], a1[3]);
                            *(u32x4*)(o1 + off) = w; } }
            }
        } else {
            const bool isq = pn < 18; bf16_t* base = isq ? CQ : CK; const int ldc = isq ? 768 : 256, head = (isq ? (pn - 15) * 4 : 0) + wc;
            const float* w = qkw + (isq ? 0 : 64); const float sc = isq ? QSCALE : 1.f;
            f32x4 wv[2][2];
#pragma unroll
            for (int bj = 0; bj < 2; ++bj)
#pragma unroll
                for (int n = 0; n < 2; ++n) wv[bj][n] = *(const f32x4*)(w + 32 * bj + 8 * fq + 4 * n) * sc;
#pragma unroll
            for (int ai = 0; ai < 2; ++ai)
#pragma unroll
                for (int m = 0; m < 4; ++m) { const int row = row0 + ai * HALF + m * 16;
                    float ss = 0.f;
#pragma unroll
                    for (int bj = 0; bj < 2; ++bj)
#pragma unroll
                        for (int n = 0; n < 2; ++n) { const f32x4 x = acc[ai][bj][m][n]; ss += (x[0] * x[0] + x[1] * x[1]) + (x[2] * x[2] + x[3] * x[3]); }
                    ss += __shfl_xor(ss, 16); ss += __shfl_xor(ss, 32);
                    const float r = 1.0f / sqrtf(ss * (1.0f / 64.0f) + 1e-6f);
                    bf16_t* rowp = base + (size_t)row * ldc + head * 64 + 8 * fq;
#pragma unroll
                    for (int bj = 0; bj < 2; ++bj) { const float* tab = bj == 0 ? rtab + (size_t)(row >> 6) * 32 : ctab + (size_t)(row & 63) * 32;
                        float o[8];
#pragma unroll
                        for (int n = 0; n < 2; ++n) { const f32x4 x = acc[ai][bj][m][n] * r * wv[bj][n]; const f32x4 cs = *(const f32x4*)(tab + (4 * fq + 2 * n) * 2);
                            o[4 * n + 0] = x[0] * cs[0] - x[1] * cs[1]; o[4 * n + 1] = x[0] * cs[1] + x[1] * cs[0];
                            o[4 * n + 2] = x[2] * cs[2] - x[3] * cs[3]; o[4 * n + 3] = x[2] * cs[3] + x[3] * cs[2]; }
                        u32x4 wd; wd.x = cvt_pk_bf16(o[0], o[1]); wd.y = cvt_pk_bf16(o[2], o[3]); wd.z = cvt_pk_bf16(o[4], o[5]); wd.w = cvt_pk_bf16(o[6], o[7]);
                        *(u32x4*)(rowp + 32 * bj) = wd; } }
        }
    }
};
template <class Epi, class Sched, bool ALIGN_EPI = false, bool SP2 = false>
__device__ __forceinline__ void gemm_phase(PG8_LAS unsigned char* lds, const Gemm g, const Sched& S, const Epi& E) {
    int tid_l = threadIdx.x; asm volatile("" : "+v"(tid_l)); const int tid = tid_l, wid = __builtin_amdgcn_readfirstlane(tid >> 6), lane = tid & 63, wr = wid >> 2, wc = wid & 3, fr = lane & 15, fq = lane >> 4;
    const int K = g.K, nt = K / BK;
    unsigned voffA[2], voffB[2];
#pragma unroll
    for (int i = 0; i < 2; ++i) { int R, C; stage_rc(tid * 16 + i * 8192, R, C); const int Rb = Epi::PERM ? ((R & ~31) + perm32(R & 31)) : R;
        voffA[i] = (unsigned)(R * K + C) * 2u; voffB[i] = (unsigned)(Rb * K + C) * 2u; }
    const size_t kstep = (size_t)(BK * 2);
    const size_t hstep = (size_t)HALF * K * 2;
    const size_t tstep = 2 * hstep;
    const unsigned ldsw = (unsigned)wid * 1024u;
    const int aoff = lds_byte(wr * 64 + fr, fq * 8), boff = lds_byte(wc * 32 + fr, fq * 8);
#define PG8_SA(b, h) (((b) * 2 + (h)) * HTB)
#define PG8_SB(b, h) ((4 + (b) * 2 + (h)) * HTB)
#define PG8_STAGE(bufoff, gbase, voff) do { _Pragma("unroll") for (int _i = 0; _i < 2; ++_i) \
        __builtin_amdgcn_global_load_lds((const unsigned*)((const char*)(gbase) + (voff)[_i]), (PG8_LAS unsigned*)(lds + (bufoff) + ldsw + _i * 8192), 16, 0, 0); } while (0)
#define PG8_LDA(dst, b, h) do { _Pragma("unroll") for (int m = 0; m < 4; ++m) _Pragma("unroll") for (int k = 0; k < 2; ++k) dst[m][k] = *(const PG8_LAS bf16x8*)(lds + PG8_SA(b, h) + aoff + m * 2048 + k * 1024); } while (0)
#define PG8_LDB(dst, b, h) do { _Pragma("unroll") for (int n = 0; n < 2; ++n) _Pragma("unroll") for (int k = 0; k < 2; ++k) dst[n][k] = *(const PG8_LAS bf16x8*)(lds + PG8_SB(b, h) + boff + n * 2048 + k * 1024); } while (0)
#define PG8_MMA(ai, bj, At, Bt) do { __builtin_amdgcn_s_setprio(1); _Pragma("unroll") for (int m = 0; m < 4; ++m) _Pragma("unroll") for (int n = 0; n < 2; ++n) _Pragma("unroll") for (int k = 0; k < 2; ++k) \
        acc[ai][bj][m][n] = __builtin_amdgcn_mfma_f32_16x16x32_bf16(Bt[n][k], At[m][k], acc[ai][bj][m][n], 0, 0, 0); __builtin_amdgcn_s_setprio(0); } while (0)
#define PG8_WAIT_V(n) asm volatile("s_waitcnt vmcnt(" #n ")" ::: "memory")
#define PG8_WAIT_L(n) asm volatile("s_waitcnt lgkmcnt(" #n ")" ::: "memory")
#define PG8_BAR __builtin_amdgcn_s_barrier()
#define PG8_SCHED __builtin_amdgcn_sched_barrier(0)
    Unit cur, nxt; int ui = 0;
    if (!S.next(0, cur)) return;
    f32x4 acc[2][2][4][2];
#pragma unroll
    for (int a = 0; a < 2; ++a)
#pragma unroll
        for (int b = 0; b < 2; ++b)
#pragma unroll
            for (int m = 0; m < 4; ++m)
#pragma unroll
                for (int n = 0; n < 2; ++n) acc[a][b][m][n] = (f32x4){0.f, 0.f, 0.f, 0.f};
    bf16x8 At[4][2], B0[2][2], B1[2][2];
    const char* cA = (const char*)g.A + (size_t)cur.pm * tstep; const char* cB = (const char*)g.Bt + (size_t)cur.pn * tstep;
    S.a_ready(cur);
    if constexpr (SP2) {
        PG8_STAGE(PG8_SB(0, 0), cB, voffB); PG8_STAGE(PG8_SB(0, 1), cB + hstep, voffB); PG8_STAGE(PG8_SA(0, 0), cA, voffA); PG8_STAGE(PG8_SA(0, 1), cA + hstep, voffA);
        if (wr == 1) PG8_BAR;
        PG8_WAIT_V(2); PG8_BAR;
        PG8_STAGE(PG8_SB(1, 0), cB + kstep, voffB); PG8_STAGE(PG8_SA(1, 0), cA + kstep, voffA); PG8_STAGE(PG8_SB(1, 1), cB + hstep + kstep, voffB);
        PG8_WAIT_V(6); PG8_BAR;
    } else {
        PG8_STAGE(PG8_SB(0, 0), cB, voffB); PG8_STAGE(PG8_SA(0, 0), cA, voffA); PG8_STAGE(PG8_SB(0, 1), cB + hstep, voffB); PG8_STAGE(PG8_SA(0, 1), cA + hstep, voffA);
        if (wr == 1) PG8_BAR;
        PG8_WAIT_V(4); PG8_BAR;
        PG8_STAGE(PG8_SB(1, 0), cB + kstep, voffB); PG8_STAGE(PG8_SA(1, 0), cA + kstep, voffA); PG8_STAGE(PG8_SB(1, 1), cB + hstep + kstep, voffB);
        PG8_WAIT_V(6); PG8_BAR;
    }
    for (;;) {
        const bool has_next = S.next(ui + 1, nxt);
        const char* nA = has_next ? (const char*)g.A + (size_t)nxt.pm * tstep : cA; const char* nB = has_next ? (const char*)g.Bt + (size_t)nxt.pn * tstep : cB;
        for (int t = 0; t < nt; t += 2) {
            const bool last = (t == nt - 2);
            const char* a1 = cA + (size_t)(t + 1) * kstep;
            const char* a2 = last ? nA : cA + (size_t)(t + 2) * kstep; const char* b2 = last ? nB : cB + (size_t)(t + 2) * kstep;
            const char* a3 = a2 + kstep; const char* b3 = b2 + kstep;
            if (last && has_next) S.a_ready(nxt);
            if constexpr (SP2) {
            PG8_LDB(B0, 0, 0); PG8_LDB(B1, 0, 1); PG8_SCHED; PG8_LDA(At, 0, 0); PG8_STAGE(PG8_SA(1, 1), a1 + hstep, voffA);
            PG8_WAIT_V(8); PG8_WAIT_L(0); PG8_BAR; PG8_MMA(0, 0, At, B0); PG8_MMA(0, 1, At, B1); PG8_BAR; PG8_SCHED;
            PG8_LDA(At, 0, 1); PG8_STAGE(PG8_SB(0, 0), b2, voffB); PG8_STAGE(PG8_SB(0, 1), b2 + hstep, voffB); PG8_STAGE(PG8_SA(0, 0), a2, voffA);
            PG8_WAIT_V(8); PG8_WAIT_L(0); PG8_BAR; PG8_MMA(1, 0, At, B0); PG8_MMA(1, 1, At, B1); PG8_BAR; PG8_SCHED;
            PG8_LDB(B0, 1, 0); PG8_LDB(B1, 1, 1); PG8_SCHED; PG8_LDA(At, 1, 0); PG8_STAGE(PG8_SA(0, 1), a2 + hstep, voffA);
            PG8_WAIT_V(8); PG8_WAIT_L(0); PG8_BAR; PG8_MMA(0, 0, At, B0); PG8_MMA(0, 1, At, B1); PG8_BAR; PG8_SCHED;
            PG8_LDA(At, 1, 1); PG8_STAGE(PG8_SB(1, 0), b3, voffB); PG8_STAGE(PG8_SB(1, 1), b3 + hstep, voffB); PG8_STAGE(PG8_SA(1, 0), a3, voffA);
            PG8_WAIT_V(8); PG8_WAIT_L(0); PG8_BAR; PG8_MMA(1, 0, At, B0); PG8_MMA(1, 1, At, B1); PG8_BAR; PG8_SCHED;
            } else {
            PG8_LDB(B0, 0, 0); PG8_SCHED; PG8_LDA(At, 0, 0); PG8_STAGE(PG8_SA(1, 1), a1 + hstep, voffA);
            PG8_WAIT_L(8); PG8_BAR; PG8_WAIT_L(0); PG8_MMA(0, 0, At, B0); PG8_BAR; PG8_SCHED;
            PG8_LDB(B1, 0, 1); PG8_STAGE(PG8_SB(0, 0), b2, voffB);
            PG8_BAR; PG8_WAIT_L(0); PG8_MMA(0, 1, At, B1); PG8_BAR;
            PG8_LDA(At, 0, 1); PG8_STAGE(PG8_SA(0, 0), a2, voffA);
            PG8_BAR; PG8_WAIT_L(0); PG8_MMA(1, 0, At, B0); PG8_BAR; PG8_SCHED;
            PG8_STAGE(PG8_SB(0, 1), b2 + hstep, voffB);
            PG8_WAIT_V(6); PG8_BAR; PG8_MMA(1, 1, At, B1); PG8_BAR;
            PG8_LDB(B0, 1, 0); PG8_SCHED; PG8_LDA(At, 1, 0); PG8_STAGE(PG8_SA(0, 1), a2 + hstep, voffA);
            PG8_WAIT_L(8); PG8_BAR; PG8_WAIT_L(0); PG8_MMA(0, 0, At, B0); PG8_BAR; PG8_SCHED;
            PG8_LDB(B1, 1, 1); PG8_STAGE(PG8_SB(1, 0), b3, voffB);
            PG8_BAR; PG8_WAIT_L(0); PG8_MMA(0, 1, At, B1); PG8_BAR;
            PG8_LDA(At, 1, 1); PG8_STAGE(PG8_SA(1, 0), a3, voffA);
            PG8_BAR; PG8_WAIT_L(0); PG8_MMA(1, 0, At, B0); PG8_BAR; PG8_SCHED;
            PG8_STAGE(PG8_SB(1, 1), b3 + hstep, voffB);
            PG8_WAIT_V(6); PG8_BAR; PG8_MMA(1, 1, At, B1); PG8_BAR;
            }
        }
        if constexpr (ALIGN_EPI) { if (wr == 0) PG8_BAR; }
        if constexpr (!Epi::AFTER_DRAIN) { E(acc, cur, wr, wc, fr, fq); S.done(cur); }
        if (!has_next) break;
#pragma unroll
        for (int a = 0; a < 2; ++a)
#pragma unroll
            for (int b = 0; b < 2; ++b)
#pragma unroll
                for (int m = 0; m < 4; ++m)
#pragma unroll
                    for (int n = 0; n < 2; ++n) acc[a][b][m][n] = (f32x4){0.f, 0.f, 0.f, 0.f};
        cur = nxt; cA = nA; cB = nB; ++ui;
        if constexpr (ALIGN_EPI) { if (wr == 1) PG8_BAR; }
    }
    PG8_WAIT_V(0);
    if constexpr (!ALIGN_EPI) { if (wr == 0) PG8_BAR; }
    PG8_BAR;
    if constexpr (Epi::AFTER_DRAIN) { E.fused(acc, cur, wr, wc, fr, fq, lds, wid, lane); S.done(cur); }
#undef PG8_SA
#undef PG8_SB
#undef PG8_STAGE
#undef PG8_LDA
#undef PG8_LDB
#undef PG8_MMA
#undef PG8_WAIT_V
#undef PG8_WAIT_L
#undef PG8_BAR
#undef PG8_SCHED
}
}

#include <hip/hip_bf16.h>
#include <cmath>
namespace attn_body {
using bf16=__hip_bfloat16;
using bf16x8=__attribute__((ext_vector_type(8)))short;
using s16x4=__attribute__((ext_vector_type(4)))short;
using f32x16=__attribute__((ext_vector_type(16)))float;
using u32x4=__attribute__((ext_vector_type(4)))unsigned;
constexpr int SEQ=8192,D=64;
constexpr int NW=8,QBLK=32,QB=QBLK*NW,KVBLK=64;
constexpr int ATTN_UNIT_ROWS=QB;
__device__ __forceinline__ int crow(int r,int hi){return (r&3)+8*(r>>2)+4*hi;}
#define SBAR() __builtin_amdgcn_sched_barrier(0)
__device__ __forceinline__ void cmask(f32x16&p0,f32x16&p1,int jb,int qrel,int hi){
  const float NEG=-INFINITY; int kb=64*jb+4*hi;
  #pragma unroll
  for(int r=0;r<16;++r){int kv=kb+(r&3)+8*(r>>2); if(kv>qrel)p0[r]=NEG; if(kv+32>qrel)p1[r]=NEG;}
}

constexpr int NSLOT=3, SLOTB=8192;
constexpr int LDS_K=0, LDS_V=NSLOT*SLOTB, LDS_WS=2*NSLOT*SLOTB, LDS_OST=LDS_WS+NW*64*4, LDS_BYTES=LDS_OST+NW*4096;
constexpr int LDS_TB=LDS_BYTES;
template<int MODE> __device__ __forceinline__ void wmask(f32x16&p0,f32x16&p1,int kb,int qabs,int hi,const __attribute__((address_space(3))) float*tbl){
  if constexpr(MODE==1){ const int base=kb+4*hi-qabs+128;
    #pragma unroll
    for(int r=0;r<16;++r){ const int i0=base+(r&3)+8*(r>>2),i1=i0+32; const bool v0=(unsigned)i0<=256u,v1=(unsigned)i1<=256u;
      const float b0=tbl[v0?i0:0],b1=tbl[v1?i1:0]; p0[r]=v0?p0[r]+b0:-INFINITY; p1[r]=v1?p1[r]+b1:-INFINITY; } }
}
constexpr float C2=0.125f*1.4426950408889634f;
__device__ __forceinline__ void glds16(const void*gsrc,unsigned lds_dst){unsigned keep;
  asm volatile("s_mov_b32 %0, m0\n\ts_mov_b32 m0, %2\n\ts_nop 0\n\tglobal_load_lds_dwordx4 %1, off\n\ts_mov_b32 m0, %0":"=&s"(keep):"v"(gsrc),"s"(lds_dst):"memory");}
__device__ __forceinline__ float max3f(float a,float b,float c){float r;asm("v_max3_f32 %0, %1, %2, %3":"=v"(r):"v"(a),"v"(b),"v"(c));return r;}
__device__ __forceinline__ float max2f(float a,float b){float r;asm("v_max_f32_e32 %0, %1, %2":"=v"(r):"v"(a),"v"(b));return r;}
__device__ __forceinline__ float fadd_s(float a,float b){float r;asm("v_add_f32_e32 %0, %1, %2":"=v"(r):"v"(a),"v"(b));return r;}
__device__ __forceinline__ float fsub_s(float a,float b){float r;asm("v_sub_f32_e32 %0, %1, %2":"=v"(r):"v"(a),"v"(b));return r;}
typedef float f32x2_t __attribute__((ext_vector_type(2))); typedef __bf16 bf16x2_t __attribute__((ext_vector_type(2)));
__device__ __forceinline__ unsigned cvtpk_s(float lo,float hi){f32x2_t v={lo,hi};bf16x2_t b=__builtin_convertvector(v,bf16x2_t);return __builtin_bit_cast(unsigned,b);}
#define WAIT_BAR(N) asm volatile("s_waitcnt vmcnt(" #N ") lgkmcnt(0)\n\ts_barrier":::"memory")

__device__ __forceinline__ void qkt(f32x16&p0,f32x16&p1,const char*Kslot,const bf16x8*qr,const f32x16&negm,int r32,int hi){
  const char*kb=Kslot+hi*1024+r32*16;
  #pragma unroll
  for(int d0=0;d0<4;++d0){
    const bf16x8 b0=*reinterpret_cast<const bf16x8*>(kb+d0*2048);
    const bf16x8 b1=*reinterpret_cast<const bf16x8*>(kb+d0*2048+512);
    if(d0==0){p0=__builtin_amdgcn_mfma_f32_32x32x16_bf16(b0,qr[0],negm,0,0,0);p1=__builtin_amdgcn_mfma_f32_32x32x16_bf16(b1,qr[0],negm,0,0,0);}
    else{p0=__builtin_amdgcn_mfma_f32_32x32x16_bf16(b0,qr[d0],p0,0,0,0);p1=__builtin_amdgcn_mfma_f32_32x32x16_bf16(b1,qr[d0],p1,0,0,0);}}
}
typedef __attribute__((address_space(3))) const char* lds_cptr;
typedef short v4i16_t __attribute__((ext_vector_type(4)));
__device__ __forceinline__ void kload8(bf16x8*kf,lds_cptr kp){
  kf[0]=*(const __attribute__((address_space(3))) bf16x8*)(kp);      kf[1]=*(const __attribute__((address_space(3))) bf16x8*)(kp+512);
  kf[2]=*(const __attribute__((address_space(3))) bf16x8*)(kp+2048); kf[3]=*(const __attribute__((address_space(3))) bf16x8*)(kp+2560);
  kf[4]=*(const __attribute__((address_space(3))) bf16x8*)(kp+4096); kf[5]=*(const __attribute__((address_space(3))) bf16x8*)(kp+4608);
  kf[6]=*(const __attribute__((address_space(3))) bf16x8*)(kp+6144); kf[7]=*(const __attribute__((address_space(3))) bf16x8*)(kp+6656);
}
__device__ __forceinline__ void kload2(bf16x8*kf,lds_cptr kp,int j){ kf[2*j]=*(const __attribute__((address_space(3))) bf16x8*)(kp+j*2048); kf[2*j+1]=*(const __attribute__((address_space(3))) bf16x8*)(kp+j*2048+512); }
__device__ __forceinline__ s16x4 vtr(lds_cptr p){ return __builtin_bit_cast(s16x4,__builtin_amdgcn_ds_read_tr16_b64_v4i16((__attribute__((address_space(3))) v4i16_t*)p)); }
__device__ __forceinline__ float rowmax(const f32x16&p0,const f32x16&p1){
  float a=max3f(p0[0],p0[1],p1[0]),b=max3f(p0[2],p0[3],p1[1]);a=max3f(a,p1[2],p1[3]);
  #pragma unroll
  for(int r=4;r<16;r+=4){a=max3f(a,p0[r],p0[r+1]);b=max3f(b,p0[r+2],p0[r+3]);a=max3f(a,p1[r],p1[r+1]);b=max3f(b,p1[r+2],p1[r+3]);}
  const float m=max2f(a,b);
  auto rr=__builtin_amdgcn_permlane32_swap(__float_as_uint(m),__float_as_uint(m),false,false);
  return max2f(__uint_as_float(rr[0]),__uint_as_float(rr[1]));
}
__device__ __forceinline__ void pv(f32x16*o,int vb,bf16x8 pa0,bf16x8 pa1,bf16x8 pa2,bf16x8 pa3){
  #pragma unroll
  for(int d0=0;d0<2;++d0){s16x4 lo[4],hi[4];
    #pragma unroll
    for(int ks=0;ks<4;++ks){
      asm volatile("ds_read_b64_tr_b16 %0,%1 offset:%c2":"=&v"(lo[ks]):"v"(vb),"i"(d0*4096+ks*1024):"memory");
      asm volatile("ds_read_b64_tr_b16 %0,%1 offset:%c2":"=&v"(hi[ks]):"v"(vb),"i"(d0*4096+ks*1024+512):"memory");}
    asm volatile("s_waitcnt lgkmcnt(0)":::"memory");SBAR();
    #define PK(k) (bf16x8){lo[k][0],lo[k][1],lo[k][2],lo[k][3],hi[k][0],hi[k][1],hi[k][2],hi[k][3]}
    o[d0]=__builtin_amdgcn_mfma_f32_32x32x16_bf16(pa0,PK(0),o[d0],0,0,0);
    o[d0]=__builtin_amdgcn_mfma_f32_32x32x16_bf16(pa1,PK(1),o[d0],0,0,0);
    o[d0]=__builtin_amdgcn_mfma_f32_32x32x16_bf16(pa2,PK(2),o[d0],0,0,0);
    o[d0]=__builtin_amdgcn_mfma_f32_32x32x16_bf16(pa3,PK(3),o[d0],0,0,0);
    #undef PK
  }
}

#ifndef ATTN_STORE16
#define ATTN_STORE16(p,v) (*(u32x4*)(p)=(v))
#endif
template<int THRL,int QP,int KP,int OP,int MODE,bool PART=false> __device__ __forceinline__ void attn_unit(int q0,int NT,const bf16*Qh,const bf16*__restrict__ Kh,const bf16*__restrict__ Vh,bf16*Oh,char*shm,const float*tbg=nullptr,float sink2=0.f,int kb0=0,float*Po=nullptr,float*Pml=nullptr){
  int tid_l=threadIdx.x; asm volatile("":"+v"(tid_l)); const int tid=tid_l,lane=tid&63,r32=lane&31,hi=lane>>5; const int wid=__builtin_amdgcn_readfirstlane(tid>>6);
  __attribute__((address_space(3))) float* tblL=(__attribute__((address_space(3))) float*)((__attribute__((address_space(3))) char*)shm+LDS_TB);
  if constexpr(MODE==1){ if(tid<257)tblL[tid]=tbg[tid]; }

  const bf16*Qw=Qh+(long)(q0+wid*QBLK)*QP;

  const unsigned lds0=(unsigned)(uintptr_t)shm;
  float*wsf=(float*)(shm+LDS_WS)+wid*64;
  const bf16*ksrc=Kh+(long)lane*KP+wid*8;
  const bf16*vsrc=Vh+(long)(16*(wid&3)+(lane>>2))*KP+(wid>>2)*32+(lane&3)*8;
  const unsigned kdst=lds0+LDS_K+wid*1024, vdst=lds0+LDS_V+wid*1024;
  #define DMA_K(t,slot) glds16(ksrc+(long)(t)*KVBLK*KP,(unsigned)__builtin_amdgcn_readfirstlane(kdst+(slot)))
  #define DMA_V(t,slot) glds16(vsrc+(long)(t)*KVBLK*KP,(unsigned)__builtin_amdgcn_readfirstlane(vdst+(slot)))
  const int vb0=(int)(lds0+LDS_V)+((lane>>4)&1)*32+(lane&3)*8+(4*hi+((lane&15)>>2))*64;
  const char*Kbase=shm+LDS_K; bf16x8 kf[8];
  const lds_cptr shm3=(lds_cptr)shm; const lds_cptr kp0=shm3+LDS_K+hi*1024+r32*16; const lds_cptr vp0=shm3+LDS_V+((lane>>4)&1)*32+(lane&3)*8+(4*hi+((lane&15)>>2))*64;

  DMA_K(0,0);DMA_V(0,0);DMA_K(1,SLOTB);
  bf16x8 qr[4];
  #pragma unroll
  for(int d0=0;d0<4;++d0)qr[d0]=*reinterpret_cast<const bf16x8*>(&Qw[(long)r32*QP+d0*16+hi*8]);
  float mhat=0.f,l_reg=0.f;f32x16 o[2];o[0]=f32x16{};o[1]=f32x16{};f32x16 negm=f32x16{};asm volatile("":"+v"(negm));
  const int qrel=wid*QBLK+r32; const int qabs=q0+qrel;
  #define CMASK(P0,P1,t) wmask<MODE>(P0,P1,kb0+(t)*64,qabs,hi,tblL)
  bool resc=false;
  #define START(P0,P1) do{ float rm=rowmax(P0,P1); if constexpr(MODE==1) rm=__builtin_fmaxf(rm,sink2); resc=false; \
    { const float dl=rm; mhat=fadd_s(mhat,dl); \
      _Pragma("unroll") for(int r=0;r<16;++r){P0[r]=fsub_s(P0[r],dl);P1[r]=fsub_s(P1[r],dl);} \
      _Pragma("unroll") for(int r=0;r<16;++r)negm[r]=-mhat; asm volatile("":"+v"(negm)); } \
    _Pragma("unroll") for(int r=0;r<16;++r)P0[r]=__builtin_amdgcn_exp2f(P0[r]); }while(0)
  #define RESC() do{ if(resc){ asm volatile("s_waitcnt lgkmcnt(0)":::"memory"); \
      _Pragma("unroll") for(int d_=0;d_<2;++d_) _Pragma("unroll") for(int r=0;r<16;++r)o[d_][r]*=wsf[crow(r,hi)]; } }while(0)
  f32x16 pA0,pA1,pB0,pB1;
  int sl_prev=0,sl_cur=0,sl_next=SLOTB;
  #define ROT() do{sl_prev=sl_cur;sl_cur=sl_next;sl_next=(sl_next==(NSLOT-1)*SLOTB)?0:sl_next+SLOTB;}while(0)
  DMA_K(2,2*SLOTB);
  WAIT_BAR(3);
  qkt(pA0,pA1,Kbase,qr,negm,r32,hi);asm volatile("s_nop 15\n\ts_nop 7":"+v"(pA0),"+v"(pA1));CMASK(pA0,pA1,0);
  START(pA0,pA1);
  _Pragma("unroll") for(int r=0;r<16;++r)pA1[r]=__builtin_amdgcn_exp2f(pA1[r]);
  WAIT_BAR(0);
  DMA_K(3,0);DMA_V(1,SLOTB);
  ROT();
  kload8(kf,kp0+sl_cur);
  WAIT_BAR(2);
  s16x4 vlo[8],vhi[8]; u32x4 pw0,pw1,pw2,pw3;
  #define PKW(P,B) cvtpk_s(P[B],P[B+1])
  #define PAF(k) __builtin_bit_cast(bf16x8,pw##k)
  #define VFR(i) (bf16x8){vlo[i][0],vlo[i][1],vlo[i][2],vlo[i][3],vhi[i][0],vhi[i][1],vhi[i][2],vhi[i][3]}
  #define PIN(x) asm volatile("":"+v"(x))
  #define MX3(a,b,c) __builtin_fmaxf(__builtin_fmaxf((a),(b)),(c))
  #define GAPA(MF,A0,A1,A2,A3,W0,W1,PW) do{ MF; sacc+=A0; sacc+=A1; sacc+=A2; sacc+=A3; PIN(sacc); W0; W1; PIN(PW); SBAR(); }while(0)
  #define EX(v) __builtin_amdgcn_exp2f(v)
  #define GAPB(MF,X,B) do{ MF; X[B]=EX(X[B]); X[B+1]=EX(X[B+1]); X[B+2]=EX(X[B+2]); X[B+3]=EX(X[B+3]); PIN(X); SBAR(); }while(0)
  #define VRD(i) do{ vlo[i]=vtr(vp_+(((i)>>2)*4096+((i)&3)*1024)); vhi[i]=vtr(vp_+(((i)>>2)*4096+((i)&3)*1024+512)); }while(0)
  #define KRD(G,j) do{ if(G){ kload2(kf,kp0+sl_next,j); SBAR(); } }while(0)
  #define STEP(C0,C1,P0,P1,t,GK,GV,GL) do{ SBAR(); \
    const lds_cptr vp_=vp0+sl_prev; \
    VRD(0); SBAR(); float sacc=(P0[0]+P0[1]); \
    GAPA(C0=__builtin_amdgcn_mfma_f32_32x32x16_bf16(kf[0],qr[0],negm,0,0,0), P0[2],P0[3],P0[4],P0[5],     pw0[0]=PKW(P0,0), pw0[1]=PKW(P0,2), pw0); \
    VRD(4); SBAR(); GAPA(C1=__builtin_amdgcn_mfma_f32_32x32x16_bf16(kf[1],qr[0],negm,0,0,0), P0[6],P0[7],P0[8],P0[9],     pw0[2]=PKW(P0,4), pw0[3]=PKW(P0,6), pw0); \
    VRD(1); SBAR(); GAPA(C0=__builtin_amdgcn_mfma_f32_32x32x16_bf16(kf[2],qr[1],C0,0,0,0),   P0[10],P0[11],P0[12],P0[13], pw1[0]=PKW(P0,8), pw1[1]=PKW(P0,10), pw1); \
    VRD(5); SBAR(); GAPA(C1=__builtin_amdgcn_mfma_f32_32x32x16_bf16(kf[3],qr[1],C1,0,0,0),   P0[14],P0[15],P1[0],P1[1],   pw1[2]=PKW(P0,12),pw1[3]=PKW(P0,14), pw1); \
    VRD(2); SBAR(); GAPA(C0=__builtin_amdgcn_mfma_f32_32x32x16_bf16(kf[4],qr[2],C0,0,0,0),   P1[2],P1[3],P1[4],P1[5],     pw2[0]=PKW(P1,0), pw2[1]=PKW(P1,2), pw2); \
    VRD(6); SBAR(); GAPA(C1=__builtin_amdgcn_mfma_f32_32x32x16_bf16(kf[5],qr[2],C1,0,0,0),   P1[6],P1[7],P1[8],P1[9],     pw2[2]=PKW(P1,4), pw2[3]=PKW(P1,6), pw2); \
    VRD(3); SBAR(); GAPA(C0=__builtin_amdgcn_mfma_f32_32x32x16_bf16(kf[6],qr[3],C0,0,0,0),   P1[10],P1[11],P1[12],P1[13], pw3[0]=PKW(P1,8), pw3[1]=PKW(P1,10), pw3); \
    VRD(7); SBAR(); GAPA(C1=__builtin_amdgcn_mfma_f32_32x32x16_bf16(kf[7],qr[3],C1,0,0,0),   P1[14],P1[15],0.f,0.f,       pw3[2]=PKW(P1,12),pw3[3]=PKW(P1,14), pw3); \
    l_reg+=sacc; \
    if(GK){DMA_K((t)+3,sl_cur);} if(GV){DMA_V((t)+1,sl_next);} \
    CMASK(C0,C1,t); \
    { float a=MX3(C0[0],C0[1],C1[0]),b=MX3(C0[2],C0[3],C1[1]); a=MX3(a,C1[2],C1[3]); \
      _Pragma("unroll") for(int r=4;r<16;r+=4){a=MX3(a,C0[r],C0[r+1]);b=MX3(b,C0[r+2],C0[r+3]);a=MX3(a,C1[r],C1[r+1]);b=MX3(b,C1[r+2],C1[r+3]);} \
      float rm=__builtin_fmaxf(a,b); { auto rr=__builtin_amdgcn_permlane32_swap(__float_as_uint(rm),__float_as_uint(rm),false,false); rm=__builtin_fmaxf(__uint_as_float(rr[0]),__uint_as_float(rr[1])); } \
      resc=false; \
      if(__builtin_expect(__any(rm>(float)THRL),0)){ const float dl=__builtin_fmaxf(rm,0.f); mhat+=dl; \
        _Pragma("unroll") for(int r=0;r<16;++r){C0[r]-=dl;C1[r]-=dl;} \
        _Pragma("unroll") for(int r=0;r<16;++r)negm[r]=-mhat; asm volatile("":"+v"(negm)); \
        const float f=__builtin_amdgcn_exp2f(-dl); l_reg*=f; if(hi==0)wsf[r32]=f; resc=true; } } \
    SBAR(); \
    GAPB(o[0]=__builtin_amdgcn_mfma_f32_32x32x16_bf16(PAF(0),VFR(0),o[0],0,0,0), C0,0); \
    GAPB(o[1]=__builtin_amdgcn_mfma_f32_32x32x16_bf16(PAF(0),VFR(4),o[1],0,0,0), C0,4); \
    KRD(GL,0); GAPB(o[0]=__builtin_amdgcn_mfma_f32_32x32x16_bf16(PAF(1),VFR(1),o[0],0,0,0), C0,8); \
    KRD(GL,1); GAPB(o[1]=__builtin_amdgcn_mfma_f32_32x32x16_bf16(PAF(1),VFR(5),o[1],0,0,0), C0,12); \
    KRD(GL,2); GAPB(o[0]=__builtin_amdgcn_mfma_f32_32x32x16_bf16(PAF(2),VFR(2),o[0],0,0,0), C1,0); \
    KRD(GL,3); GAPB(o[1]=__builtin_amdgcn_mfma_f32_32x32x16_bf16(PAF(2),VFR(6),o[1],0,0,0), C1,4); \
    GAPB(o[0]=__builtin_amdgcn_mfma_f32_32x32x16_bf16(PAF(3),VFR(3),o[0],0,0,0), C1,8); \
    GAPB(o[1]=__builtin_amdgcn_mfma_f32_32x32x16_bf16(PAF(3),VFR(7),o[1],0,0,0), C1,12); \
    }while(0)
  int t=1;
  #undef CMASK
  #define CMASK(P0,P1,t) wmask<MODE>(P0,P1,kb0+(t)*64,qabs,hi,tblL)
  for(;t+5<NT;t+=2){
    STEP(pB0,pB1,pA0,pA1,t,true,true,true);     WAIT_BAR(2); RESC(); ROT();
    STEP(pA0,pA1,pB0,pB1,t+1,true,true,true);   WAIT_BAR(2); RESC(); ROT();
  }
  #undef CMASK
  #define CMASK(P0,P1,t) wmask<MODE>(P0,P1,kb0+(t)*64,qabs,hi,tblL)
  #define ENDW(tt) do{ if((tt)+3<NT){WAIT_BAR(2);} else if((tt)+2<NT){WAIT_BAR(1);} else {WAIT_BAR(0);} }while(0)
  for(;t+1<NT;t+=2){
    STEP(pB0,pB1,pA0,pA1,t,(t+3<NT),(t+1<NT),(t+1<NT));       ENDW(t);   RESC(); ROT();
    STEP(pA0,pA1,pB0,pB1,t+1,(t+4<NT),(t+2<NT),(t+2<NT));     ENDW(t+1); RESC(); ROT();
  }
  STEP(pB0,pB1,pA0,pA1,NT-1,false,false,false); RESC();
  { float sacc=pB0[0]+pB0[1]; _Pragma("unroll") for(int r=2;r<16;++r)sacc+=pB0[r]; _Pragma("unroll") for(int r=0;r<16;++r)sacc+=pB1[r]; l_reg+=sacc;
    pw0=(u32x4){PKW(pB0,0),PKW(pB0,2),PKW(pB0,4),PKW(pB0,6)};pw1=(u32x4){PKW(pB0,8),PKW(pB0,10),PKW(pB0,12),PKW(pB0,14)};pw2=(u32x4){PKW(pB1,0),PKW(pB1,2),PKW(pB1,4),PKW(pB1,6)};pw3=(u32x4){PKW(pB1,8),PKW(pB1,10),PKW(pB1,12),PKW(pB1,14)};
    SBAR(); pv(o,vb0+sl_cur,PAF(0),PAF(1),PAF(2),PAF(3)); }
  #undef PKW
  #undef PAF
  #undef VFR
  #undef PIN
  #undef MX3
  #undef GAPA
  #undef GAPB
  #undef EX
  #undef VRD
  #undef KRD
  #undef STEP
  #undef ENDW
  {auto rr=__builtin_amdgcn_permlane32_swap(__float_as_uint(l_reg),__float_as_uint(l_reg),false,false);l_reg=__uint_as_float(rr[0])+__uint_as_float(rr[1]);}
  if constexpr(MODE==1) l_reg+=__builtin_amdgcn_exp2f(sink2-mhat);
  if constexpr(PART){
    if(hi==0){ Pml[(wid*QBLK+r32)*2]=mhat; Pml[(wid*QBLK+r32)*2+1]=l_reg; }
    float*Pw=Po+(long)(wid*QBLK)*64+r32;
    #pragma unroll
    for(int r=0;r<16;++r){ Pw[crow(r,hi)*64]=o[0][r]; Pw[crow(r,hi)*64+32]=o[1][r]; }
  } else {
  if(hi==0)wsf[32+r32]=l_reg;asm volatile("s_waitcnt lgkmcnt(0)":::"memory");
  float rli[16];
  #pragma unroll
  for(int r=0;r<16;++r)rli[r]=__builtin_amdgcn_rcpf(wsf[32+crow(r,hi)]);
  bf16*Ow=Oh+(long)(q0+wid*QBLK)*OP;
  { bf16*stg=(bf16*)(shm+LDS_OST)+wid*2048;
    #pragma unroll
    for(int r=0;r<16;++r){const int orow=crow(r,hi);
      #pragma unroll
      for(int d0=0;d0<2;++d0)stg[orow*64+d0*32+r32]=__float2bfloat16(o[d0][r]*rli[r]);}
    asm volatile("s_waitcnt lgkmcnt(0)":::"memory");
    #pragma unroll
    for(int i=0;i<4;++i){const int row=i*8+(lane>>3),ch=lane&7; const u32x4 v=*(const u32x4*)(stg+row*64+ch*8); ATTN_STORE16(Ow+(long)row*OP+ch*8,v);} }
  }
  asm volatile("s_waitcnt lgkmcnt(0)\n\ts_barrier":::"memory");
  #undef DMA_K
  #undef DMA_V
  #undef CMASK
  #undef START
  #undef RESC
  #undef ROT
}
constexpr int ATTN_LDS_BYTES=LDS_BYTES+1056;
#undef SBAR
#undef WAIT_BAR
}

namespace hg {
typedef short s16x4 __attribute__((ext_vector_type(4)));
typedef short s16x8 __attribute__((ext_vector_type(8)));
typedef float f32x4 __attribute__((ext_vector_type(4)));
typedef unsigned u32x4 __attribute__((ext_vector_type(4)));
typedef unsigned u32x2 __attribute__((ext_vector_type(2)));
#define HG_LAS __attribute__((address_space(3)))
constexpr int T = 8192, SEG = 128, NSEG = 64, HW = 512;
constexpr int PV = 272;
typedef float f32x2_t __attribute__((ext_vector_type(2))); typedef __bf16 bf16x2_t __attribute__((ext_vector_type(2)));
__device__ __forceinline__ unsigned pk(float lo, float hi) { f32x2_t v = {lo, hi}; bf16x2_t b = __builtin_convertvector(v, bf16x2_t); return __builtin_bit_cast(unsigned, b); }
#define HG_DPP_ADD(v, ctrl) v += __builtin_bit_cast(float, __builtin_amdgcn_update_dpp(0, __builtin_bit_cast(int, v), ctrl, 0xF, 0xF, true))
__device__ __forceinline__ float row16_sum(float v) { HG_DPP_ADD(v, 0xB1); HG_DPP_ADD(v, 0x4E); HG_DPP_ADD(v, 0x124); HG_DPP_ADD(v, 0x128); return v; }

__device__ __forceinline__ void pass1(int G, int bid, const float* FF, const float* FB, const unsigned short* BI, unsigned short* P, float* Dg, HG_LAS unsigned char* lds) {
    int tid_l = threadIdx.x; asm volatile("" : "+v"(tid_l));
    const int tid = tid_l, lane = tid & 63, w = __builtin_amdgcn_readfirstlane(tid >> 6), l16 = lane & 15, g = lane >> 4, c = tid & 127, qt = tid >> 7;
    constexpr int VT = 0, KT = 128 * PV, TQ = 3 * 128 * PV;
    for (int u = bid; u < 4 * NSEG; u += G) {
        const int h = u >> 6, seg = u & 63, tok0 = seg * SEG;
        const size_t ub = (size_t)tok0 * HW + h * 128; const int lo = 32 * qt * HW + c;
        {
            const unsigned short* vb = BI + ub;
#pragma unroll
            for (int jj = 0; jj < 4; ++jj) { unsigned x[8];
#pragma unroll
                for (int j = 0; j < 8; ++j) x[j] = (vb + (8 * jj + j) * HW)[lo];
                u32x4 o; o.x = x[0] | (x[1] << 16); o.y = x[2] | (x[3] << 16); o.z = x[4] | (x[5] << 16); o.w = x[6] | (x[7] << 16);
                *(HG_LAS u32x4*)(lds + VT + c * PV + (32 * qt + 8 * jj) * 2) = o; }
        }
        float kw0[32], kw1[32];
        {
            float f[32];
#pragma unroll
            for (int j = 0; j < 32; ++j) { f[j] = (FF + ub + j * HW)[lo]; kw0[j] = 1.0f - f[j]; }
            float run = 1.f;
#pragma unroll
            for (int j = 31; j >= 0; --j) { kw0[j] *= run; run *= f[j]; }
            *(HG_LAS float*)(lds + TQ + (0 * 4 + qt) * 512 + c * 4) = run;
        }
        {
            float f[32];
#pragma unroll
            for (int j = 0; j < 32; ++j) { f[j] = (FB + ub + j * HW)[lo]; kw1[j] = 1.0f - f[j]; }
            float run = 1.f;
#pragma unroll
            for (int j = 0; j < 32; ++j) { kw1[j] *= run; run *= f[j]; }
            *(HG_LAS float*)(lds + TQ + (1 * 4 + qt) * 512 + c * 4) = run;
        }
        __syncthreads();
        {
            float t0[4], t1[4];
#pragma unroll
            for (int q = 0; q < 4; ++q) { t0[q] = *(HG_LAS float*)(lds + TQ + (0 * 4 + q) * 512 + c * 4); t1[q] = *(HG_LAS float*)(lds + TQ + (1 * 4 + q) * 512 + c * 4); }
            float x0 = 1.f, x1 = 1.f;
#pragma unroll
            for (int q = 0; q < 4; ++q) { if (q > qt) x0 *= t0[q]; if (q < qt) x1 *= t1[q]; }
            if (qt == 0) { Dg[((size_t)(h * 2 + 0) * NSEG + seg) * 128 + c] = (t0[0] * t0[1]) * (t0[2] * t0[3]); Dg[((size_t)(h * 2 + 1) * NSEG + seg) * 128 + c] = (t1[0] * t1[1]) * (t1[2] * t1[3]); }
#pragma unroll
            for (int jj = 0; jj < 4; ++jj) { u32x4 o0, o1;
                o0.x = pk(kw0[8 * jj + 0] * x0, kw0[8 * jj + 1] * x0); o0.y = pk(kw0[8 * jj + 2] * x0, kw0[8 * jj + 3] * x0); o0.z = pk(kw0[8 * jj + 4] * x0, kw0[8 * jj + 5] * x0); o0.w = pk(kw0[8 * jj + 6] * x0, kw0[8 * jj + 7] * x0);
                o1.x = pk(kw1[8 * jj + 0] * x1, kw1[8 * jj + 1] * x1); o1.y = pk(kw1[8 * jj + 2] * x1, kw1[8 * jj + 3] * x1); o1.z = pk(kw1[8 * jj + 4] * x1, kw1[8 * jj + 5] * x1); o1.w = pk(kw1[8 * jj + 6] * x1, kw1[8 * jj + 7] * x1);
                *(HG_LAS u32x4*)(lds + KT + c * PV + (32 * qt + 8 * jj) * 2) = o0;
                *(HG_LAS u32x4*)(lds + KT + 128 * PV + c * PV + (32 * qt + 8 * jj) * 2) = o1; }
        }
        __syncthreads();
        {
            s16x8 bfr[4];
#pragma unroll
            for (int kk = 0; kk < 4; ++kk) bfr[kk] = *(const HG_LAS s16x8*)(lds + VT + (16 * w + l16) * PV + (32 * kk + 8 * g) * 2);
#pragma unroll
            for (int dir = 0; dir < 2; ++dir) {
                unsigned short* Pp = P + ((size_t)(h * 2 + dir) * NSEG + seg) * 16384 + (size_t)(16 * w) * 128; const int plo = l16 * 128 + 4 * g;
#pragma unroll
                for (int i = 0; i < 8; ++i) { f32x4 acc = (f32x4){0.f, 0.f, 0.f, 0.f};
#pragma unroll
                    for (int kk = 0; kk < 4; ++kk) { const s16x8 a = *(const HG_LAS s16x8*)(lds + KT + dir * 128 * PV + (16 * i + l16) * PV + (32 * kk + 8 * g) * 2);
                        acc = __builtin_amdgcn_mfma_f32_16x16x32_bf16(a, bfr[kk], acc, 0, 0, 0); }
                    { u32x2 o; o.x = pk(acc[0], acc[1]); o.y = pk(acc[2], acc[3]); *(u32x2*)(Pp + 16 * i + plo) = o; } }
            }
        }
        __syncthreads();
    }
}

__device__ __forceinline__ void scan(int G, int vcu, const unsigned short* P, const float* Dg, unsigned short* SS) {
    int tid_l = threadIdx.x; asm volatile("" : "+v"(tid_l));
    for (int e = vcu * 512 + tid_l; e < 8 * 16384; e += G * 512) {
        const int hd = e >> 14, vc = e & 16383, c = vc & 127, dir = hd & 1;
        float Sv = 0.f;
        for (int s0 = 0; s0 < NSEG; s0 += 8) { float p[8], d[8];
#pragma unroll
            for (int j = 0; j < 8; ++j) { const int sg = dir ? NSEG - 1 - (s0 + j) : s0 + j; p[j] = __uint_as_float((unsigned)P[((size_t)hd * NSEG + sg) * 16384 + vc] << 16); d[j] = Dg[((size_t)hd * NSEG + sg) * 128 + c]; }
#pragma unroll
            for (int j = 0; j < 8; ++j) { const int sg = dir ? NSEG - 1 - (s0 + j) : s0 + j; SS[((size_t)hd * NSEG + sg) * 16384 + vc] = (unsigned short)(pk(Sv, 0.f) & 0xffffu); Sv = d[j] * Sv + p[j]; } }
    }
}

__device__ __forceinline__ void pass2(int G, int bid, const unsigned short* BQ, const float* FF, const float* FB, const unsigned short* BI, const unsigned short* SGt, const unsigned short* SS,
                                      const float* gnw, unsigned short* MIX, HG_LAS unsigned char* lds) {
    int tid_l = threadIdx.x; asm volatile("" : "+v"(tid_l));
    const int tid = tid_l, lane = tid & 63, w = __builtin_amdgcn_readfirstlane(tid >> 6), l16 = lane & 15, g = lane >> 4, c = tid & 127, ch_t = tid >> 7;
    constexpr int VT = 0, QT = 128 * PV, KT = QT + 64 * PV, KPT = KT + 64 * PV, KPP = 144, DCH = KPT + 128 * KPP, NRM = DCH + 2048, RSTD = NRM + 4096;
    for (int u = bid; u < 4 * NSEG; u += G) {
        const int h = u >> 6, seg = u & 63, tok0 = seg * SEG;
        {
            const unsigned short* vb = BI + (size_t)tok0 * HW + h * 128; const int lo = 32 * ch_t * HW + c;
#pragma unroll
            for (int jj = 0; jj < 4; ++jj) { unsigned x[8];
#pragma unroll
                for (int j = 0; j < 8; ++j) x[j] = (vb + (8 * jj + j) * HW)[lo];
                u32x4 o; o.x = x[0] | (x[1] << 16); o.y = x[2] | (x[3] << 16); o.z = x[4] | (x[5] << 16); o.w = x[6] | (x[7] << 16);
                *(HG_LAS u32x4*)(lds + VT + c * PV + (32 * ch_t + 8 * jj) * 2) = o; }
        }
        f32x4 O[8];
#pragma unroll
        for (int i = 0; i < 8; ++i) O[i] = (f32x4){0.f, 0.f, 0.f, 0.f};
#pragma unroll
        for (int dir = 0; dir < 2; ++dir) {
            const float* Fp = dir ? FB : FF;
            f32x4 St[8];
            { const unsigned short* sp = SS + ((size_t)(h * 2 + dir) * NSEG + seg) * 16384 + (size_t)(16 * w) * 128; const int lo = l16 * 128 + 4 * g;
              asm volatile("" ::: "memory");
#pragma unroll
              for (int i = 0; i < 8; ++i) { const u32x2 sv = *(const u32x2*)(sp + 16 * i + lo);
                  St[i][0] = __uint_as_float(sv.x << 16); St[i][1] = __uint_as_float(sv.x & 0xffff0000u); St[i][2] = __uint_as_float(sv.y << 16); St[i][3] = __uint_as_float(sv.y & 0xffff0000u); } }
#pragma unroll
            for (int hq = 0; hq < 2; ++hq) {
                const int hh = dir ? 1 - hq : hq;
                {
                    const size_t ub = (size_t)(tok0 + 64 * hh) * HW + h * 128; const int lo = 16 * ch_t * HW + c;
                    float f[16], k[16], q[16];
                    asm volatile("" ::: "memory");
#pragma unroll
                    for (int j = 0; j < 16; ++j) { f[j] = (Fp + ub + j * HW)[lo]; q[j] = __uint_as_float((unsigned)(BQ + ub + j * HW)[lo] << 16); }
#pragma unroll
                    for (int j = 0; j < 16; ++j) k[j] = 1.0f - f[j];
                    float kp[16]; float cum = 1.f, run = 1.f;
                    if (dir == 0) {
#pragma unroll
                        for (int j = 0; j < 16; ++j) { cum *= f[j]; q[j] *= cum; const float kk = k[j]; k[j] = kk * __builtin_amdgcn_rcpf(fmaxf(cum, 1e-30f)); kp[j] = kk; }
#pragma unroll
                        for (int j = 15; j >= 0; --j) { kp[j] *= run; run *= f[j]; }
                    } else {
#pragma unroll
                        for (int j = 15; j >= 0; --j) { cum *= f[j]; q[j] *= cum; const float kk = k[j]; k[j] = kk * __builtin_amdgcn_rcpf(fmaxf(cum, 1e-30f)); kp[j] = kk; }
#pragma unroll
                        for (int j = 0; j < 16; ++j) { kp[j] *= run; run *= f[j]; }
                    }
#pragma unroll
                    for (int j = 0; j < 16; ++j) { *(HG_LAS unsigned short*)(lds + QT + (16 * ch_t + j) * PV + c * 2) = (unsigned short)(pk(q[j], 0.f) & 0xffffu);
                                                   *(HG_LAS unsigned short*)(lds + KT + (16 * ch_t + j) * PV + c * 2) = (unsigned short)(pk(k[j], 0.f) & 0xffffu); }
                    u32x4 o0, o1; o0.x = pk(kp[0], kp[1]); o0.y = pk(kp[2], kp[3]); o0.z = pk(kp[4], kp[5]); o0.w = pk(kp[6], kp[7]); o1.x = pk(kp[8], kp[9]); o1.y = pk(kp[10], kp[11]); o1.z = pk(kp[12], kp[13]); o1.w = pk(kp[14], kp[15]);
                    *(HG_LAS u32x4*)(lds + KPT + c * KPP + (16 * ch_t) * 2) = o0; *(HG_LAS u32x4*)(lds + KPT + c * KPP + (16 * ch_t) * 2 + 16) = o1;
                    *(HG_LAS float*)(lds + DCH + ch_t * 512 + c * 4) = cum;
                }
                __syncthreads();
#pragma unroll
                for (int cq = 0; cq < 4; ++cq) {
                    const int ch = dir ? 3 - cq : cq, tr = 16 * ch, cg = 4 * hh + ch;
                    f32x4 at = (f32x4){0.f, 0.f, 0.f, 0.f};
#pragma unroll
                    for (int m = 0; m < 4; ++m) { const s16x8 a = *(const HG_LAS s16x8*)(lds + KT + (tr + l16) * PV + (32 * m + 8 * g) * 2); const s16x8 b = *(const HG_LAS s16x8*)(lds + QT + (tr + l16) * PV + (32 * m + 8 * g) * 2);
                        at = __builtin_amdgcn_mfma_f32_16x16x32_bf16(a, b, at, 0, 0, 0); }
#pragma unroll
                    for (int r = 0; r < 4; ++r) { const int s = 4 * g + r; const bool keep = dir ? (s >= l16) : (s <= l16); at[r] = keep ? at[r] : 0.f; }
                    u32x4 pa4; pa4.x = pk(at[0], at[1]); pa4.y = pk(at[2], at[3]); pa4.z = 0u; pa4.w = 0u; const s16x8 pa = __builtin_bit_cast(s16x8, pa4);
                    const u32x2 bv2 = *(const HG_LAS u32x2*)(lds + VT + (16 * w + l16) * PV + (64 * hh + tr + 4 * g) * 2);
                    u32x4 bv4; bv4.x = bv2.x; bv4.y = bv2.y; bv4.z = 0u; bv4.w = 0u; const s16x8 bv = __builtin_bit_cast(s16x8, bv4);
                    f32x4 o = O[cg];
                    o = __builtin_amdgcn_mfma_f32_16x16x32_bf16(pa, bv, o, 0, 0, 0);
#pragma unroll
                    for (int m = 0; m < 4; ++m) { u32x4 sb; sb.x = pk(St[2 * m][0], St[2 * m][1]); sb.y = pk(St[2 * m][2], St[2 * m][3]); sb.z = pk(St[2 * m + 1][0], St[2 * m + 1][1]); sb.w = pk(St[2 * m + 1][2], St[2 * m + 1][3]);
                        const u32x2 qa = *(const HG_LAS u32x2*)(lds + QT + (tr + l16) * PV + (32 * m + 4 * g) * 2), qb = *(const HG_LAS u32x2*)(lds + QT + (tr + l16) * PV + (32 * m + 16 + 4 * g) * 2);
                        u32x4 qq; qq.x = qa.x; qq.y = qa.y; qq.z = qb.x; qq.w = qb.y;
                        o = __builtin_amdgcn_mfma_f32_16x16x32_bf16(__builtin_bit_cast(s16x8, qq), __builtin_bit_cast(s16x8, sb), o, 0, 0, 0); }
                    O[cg] = o;
#pragma unroll
                    for (int i = 0; i < 8; ++i) { const f32x4 dv = *(const HG_LAS f32x4*)(lds + DCH + ch * 512 + (16 * i + 4 * g) * 4);
                        const u32x2 a2 = *(const HG_LAS u32x2*)(lds + KPT + (16 * i + l16) * KPP + (tr + 4 * g) * 2);
                        u32x4 a4; a4.x = a2.x; a4.y = a2.y; a4.z = 0u; a4.w = 0u;
                        St[i] = __builtin_amdgcn_mfma_f32_16x16x32_bf16(__builtin_bit_cast(s16x8, a4), bv, St[i] * dv, 0, 0, 0); }
                }
                __syncthreads();
            }
        }
#pragma unroll
        for (int cg = 0; cg < 8; ++cg)
#pragma unroll
            for (int r = 0; r < 4; ++r) { const float s = row16_sum(O[cg][r] * O[cg][r]); if (l16 == 0) *(HG_LAS float*)(lds + NRM + w * 512 + (16 * cg + 4 * g + r) * 4) = s; }
        __syncthreads();
        if (tid < 128) { float s = 0.f;
#pragma unroll
            for (int ww = 0; ww < 8; ++ww) s += *(HG_LAS float*)(lds + NRM + ww * 512 + tid * 4);
            *(HG_LAS float*)(lds + RSTD + tid * 4) = 1.0f / sqrtf(s * (1.0f / 128.0f) + 1e-6f); }
        __syncthreads();
        {
            const float gw = gnw[16 * w + l16];
            const unsigned short* sgb = SGt + (size_t)tok0 * HW + h * 128 + 16 * w; const int slo = 4 * g * HW + l16;
            unsigned short* mb = MIX + (size_t)tok0 * 2048 + 768 + h * 128 + 16 * w; const int mlo = 4 * g * 2048 + l16;
            asm volatile("" ::: "memory");
#pragma unroll
            for (int cg = 0; cg < 8; ++cg) { const f32x4 rs = *(const HG_LAS f32x4*)(lds + RSTD + (16 * cg + 4 * g) * 4);
#pragma unroll
                for (int r = 0; r < 4; ++r) {
                    const float y = O[cg][r] * rs[r] * gw * __uint_as_float((unsigned)(sgb + (16 * cg + r) * HW)[slo] << 16);
                    (mb + (16 * cg + r) * 2048)[mlo] = (unsigned short)(pk(y, 0.f) & 0xffffu); } }
        }
        __syncthreads();
    }
}
#undef HG_DPP_ADD
}

constexpr int NWAVES = 8;
#ifndef MK_SPLIT
#define MK_SPLIT 0
#endif
constexpr int S = 8192, DM = 2048, DFF = 5632, DIN = 5120, NL = 4;
constexpr int NGU = 2 * DFF;
constexpr float EPS = 1e-6f;
constexpr size_t MiB = 1u << 20;
constexpr size_t WS_CTL = 0, CTL_ZERO_BYTES = 1 * MiB;
constexpr size_t WS_TAB = 1 * MiB;
constexpr size_t TAB_RT = 0, TAB_CT = 16384, TAB_TB = 24576, TAB_LB = 40960;
constexpr size_t WS_W = 2 * MiB;
constexpr size_t W_GU1 = 0, W_DN1 = 44 * MiB, W_WIN = 66 * MiB, W_WOUT = 86 * MiB, W_GU2 = 94 * MiB, W_DN2 = 138 * MiB, W_LAYER = 160 * MiB;
constexpr size_t WS_X = WS_W + NL * W_LAYER;
constexpr size_t WS_Y = WS_X + 64 * MiB;
constexpr size_t WS_H = WS_Y + 64 * MiB;
constexpr size_t WS_ACT = WS_H + 32 * MiB;
constexpr size_t WS_MIX = WS_ACT + 88 * MiB;
constexpr size_t WS_AQ = WS_MIX + 32 * MiB, WS_AK = WS_AQ + 12 * MiB, WS_AV = WS_AK + 4 * MiB, WS_CQ = WS_AV + 4 * MiB, WS_CK = WS_CQ + 12 * MiB, WS_CV = WS_CK + 4 * MiB;
constexpr size_t WS_B = WS_CV + 4 * MiB;
constexpr size_t WB_BQ = 0, WB_BI = 8 * MiB, WB_SG = 16 * MiB, WB_FF = 32 * MiB, WB_FB = 48 * MiB, WB_P = 64 * MiB;
constexpr size_t BSZ = 16 * MiB;
constexpr size_t WS_SS = WS_B + 9 * BSZ;
constexpr size_t WS_DG = WS_SS + 32 * MiB;
constexpr size_t WS_PO = WS_DG + 1 * MiB;
constexpr size_t WS_PML = WS_PO + 16 * MiB;
constexpr size_t WS_END = WS_PML + 1 * MiB;
constexpr int CW_BAR = 4096;
constexpr int RING_OFF = 0, RING_BYTES = 131072;
constexpr int LDSCTL_OFF = RING_BYTES, MISC_OFF = LDSCTL_OFF + 320;
constexpr int LDS_BYTES = 147456;

#define GAS __attribute__((address_space(1)))
#define LAS __attribute__((address_space(3)))
typedef unsigned short bf16;
typedef unsigned v4u __attribute__((ext_vector_type(4)));
typedef unsigned v2u __attribute__((ext_vector_type(2)));
typedef float f32x4 __attribute__((ext_vector_type(4)));
typedef GAS unsigned gu32;
#define RLX_AGENT __ATOMIC_RELAXED, __HIP_MEMORY_SCOPE_AGENT
#define LDS_WAIT() asm volatile("s_waitcnt lgkmcnt(0)" ::: "memory")
#define VM_WAIT() asm volatile("s_waitcnt vmcnt(0)" ::: "memory")
__device__ __forceinline__ unsigned f2bf(float f) { unsigned u = __builtin_bit_cast(unsigned, f); return (u + 0x7fffu + ((u >> 16) & 1u)) >> 16; }
__device__ __forceinline__ unsigned pk2(float lo, float hi) { return f2bf(lo) | (f2bf(hi) << 16); }
__device__ __forceinline__ float bf2f(bf16 b) { return __uint_as_float((unsigned)b << 16); }

#define XB_TMO      128
#define XB_XCNT(j)  (256  + 64 * (j))
#define XB_XSUB(j)  (1280 + 64 * (j))
#define XB_XGEN(j)  (2304 + 64 * (j))
#define XB_TOP      3328
#define XB_TOPGEN   3392
#define XCD_BAR_WORDS 3456
#define XB_SPIN_CAP (1u << 18)

__device__ __forceinline__ unsigned xb_ld(unsigned* p)              { return __hip_atomic_load(p, __ATOMIC_RELAXED, __HIP_MEMORY_SCOPE_AGENT); }
__device__ __forceinline__ unsigned xb_add(unsigned* p, unsigned v) { return __hip_atomic_fetch_add(p, v, __ATOMIC_RELAXED, __HIP_MEMORY_SCOPE_AGENT); }
__device__ __forceinline__ unsigned xb_xcc_id() { return (unsigned)__builtin_amdgcn_s_getreg((3 << 11) | 20) & 0xFu; }
#define XB_SPIN(cond, bar) do { unsigned _sp = 0; while (cond) { __builtin_amdgcn_s_sleep(1); \
    if ((++_sp & 255u) == 0u) { if (xb_ld(&(bar)[XB_TMO])) break; if (_sp > XB_SPIN_CAP) { atomicAdd(&(bar)[XB_TMO], 1u); break; } } } } while (0)

struct XcdBarrier {
    unsigned* bar; unsigned x;
    volatile LAS unsigned* st;
};

__device__ __forceinline__ XcdBarrier xcd_barrier_post(unsigned* bar, volatile LAS unsigned* st) {
    XcdBarrier b; b.bar = bar; b.x = xb_xcc_id(); b.st = st;
    if (threadIdx.x == 0) (void)xb_add(&bar[XB_XCNT(b.x)], 1u);
    return b;
}
__device__ __forceinline__ void xcd_barrier_complete(unsigned* bar, unsigned x, unsigned& nloc, unsigned& nx) {
    const unsigned G = gridDim.x * gridDim.y * gridDim.z;
    unsigned sum, cnt, mine, sp = 0u;
    for (;;) {
        sum = 0u; cnt = 0u; mine = 0u;
#pragma unroll
        for (unsigned j = 0; j < 16; ++j) { const unsigned c = xb_ld(&bar[XB_XCNT(j)]); sum += c; cnt += (c > 0u) ? 1u : 0u; mine = (j == x) ? c : mine; }
        if (sum == G) break;
        __builtin_amdgcn_s_sleep(1);
        if ((++sp & 255u) == 0u) { if (xb_ld(&bar[XB_TMO])) break; if (sp > XB_SPIN_CAP) { atomicAdd(&bar[XB_TMO], 1u); break; } }
    }
    nloc = mine > 0u ? mine : 1u; nx = cnt > 0u ? cnt : 1u;
}

__device__ __forceinline__ void xcd_barrier(const XcdBarrier& b) {
    asm volatile("s_waitcnt vmcnt(0)" ::: "memory");
    __syncthreads();
    if (threadIdx.x == 0) {
        unsigned* bar = b.bar;
        __builtin_amdgcn_s_waitcnt(0);
        unsigned nloc = b.st[0], nx = b.st[1];
        if (nloc == 0u) { xcd_barrier_complete(bar, b.x, nloc, nx); b.st[0] = nloc; b.st[1] = nx; }
        const unsigned old = xb_add(&bar[XB_XSUB(b.x)], 1u);
        const unsigned gen = old / nloc;
        if (old + 1u == (gen + 1u) * nloc) {
            __builtin_amdgcn_fence(__ATOMIC_RELEASE, "agent");
            asm volatile("s_waitcnt vmcnt(0)" ::: "memory");
            const unsigned og = xb_add(&bar[XB_TOP], 1u);
            const unsigned tg = og / nx;
            if (og + 1u == (tg + 1u) * nx) xb_add(&bar[XB_TOPGEN], 1u);
            else XB_SPIN(xb_ld(&bar[XB_TOPGEN]) == tg, bar);
            __builtin_amdgcn_fence(__ATOMIC_ACQUIRE, "agent");
            xb_add(&bar[XB_XGEN(b.x)], 1u);
            asm volatile("s_waitcnt vmcnt(0)" ::: "memory");
        } else {
            XB_SPIN(xb_ld(&bar[XB_XGEN(b.x)]) == gen, bar);
            __builtin_amdgcn_fence(__ATOMIC_ACQUIRE, "agent");
            asm volatile("s_waitcnt vmcnt(0)" ::: "memory");
        }
    }
    __syncthreads();
}


struct Frame {
    LAS unsigned char* lds;
    volatile LAS unsigned* MISC;
    gu32* ctl;
    int tid, lane, wave, vcu, G;
};
__device__ __forceinline__ float wave_sum(float v) {
#pragma unroll
    for (int o = 1; o < 64; o <<= 1) v += __shfl_xor(v, o);
    return v;
}
__device__ __forceinline__ float wave_max(float v) {
#pragma unroll
    for (int o = 1; o < 64; o <<= 1) v = fmaxf(v, __shfl_xor(v, o));
    return v;
}
#define DPP_ADD(v, ctrl) v += __builtin_bit_cast(float, __builtin_amdgcn_update_dpp(0, __builtin_bit_cast(int, v), ctrl, 0xF, 0xF, true))
__device__ __forceinline__ float wave_sum_fast(float v) {
    DPP_ADD(v, 0xB1); DPP_ADD(v, 0x4E); DPP_ADD(v, 0x124); DPP_ADD(v, 0x128);
    { auto rr = __builtin_amdgcn_permlane16_swap(__float_as_uint(v), __float_as_uint(v), false, false); v = __uint_as_float(rr[0]) + __uint_as_float(rr[1]); }
    { auto rr = __builtin_amdgcn_permlane32_swap(__float_as_uint(v), __float_as_uint(v), false, false); v = __uint_as_float(rr[0]) + __uint_as_float(rr[1]); }
    return v;
}

__device__ __forceinline__ void p0_transpose_item(const float* W, int K, int N, bf16* WT, int k0, int n0, int drow, LAS float* scr, int lane) {
#pragma unroll 8
    for (int i = 0; i < 32; ++i) { const int kk = 2 * i + (lane >> 5); scr[kk * 33 + (lane & 31)] = W[(size_t)(k0 + kk) * N + n0 + (lane & 31)]; }
    LDS_WAIT(); asm volatile("" ::: "memory");
    const int c = lane & 7;
#pragma unroll
    for (int j = 0; j < 4; ++j) { const int n = (lane >> 3) + 8 * j; const LAS float* s = scr + (8 * c) * 33 + n;
        v4u o; o.x = pk2(s[0 * 33], s[1 * 33]); o.y = pk2(s[2 * 33], s[3 * 33]); o.z = pk2(s[4 * 33], s[5 * 33]); o.w = pk2(s[6 * 33], s[7 * 33]);
        *(GAS v4u*)(WT + (size_t)(drow + n) * K + k0 + 8 * c) = o; }
    LDS_WAIT(); asm volatile("" ::: "memory");
}
__device__ __forceinline__ int t5_bucket(int rel) {
    const int n = rel < 0 ? -rel : rel;
    int b;
    if (n < 8) b = n; else { const int lg = 31 - __builtin_clz((unsigned)(n * n)); b = 8 + (lg - 6); if (b > 15) b = 15; }
    return (rel > 0 ? 16 : 0) + b;
}

struct Args { const float* in[15]; float* out; unsigned char* ws; int ph_lo, ph_hi; };

__device__ __forceinline__ void row_phase(const Frame& F, const float* X, const bf16* Y, float* Xout, bf16* Hout, const float* wpost, const float* wnext, float coef) {
    const int gw = F.vcu * NWAVES + F.wave, NGW = F.G * NWAVES;
    for (int r = gw; r < S; r += NGW) {
        const GAS v2u* yr = (const GAS v2u*)(Y + (size_t)r * DM) + F.lane; const GAS f32x4* xr = (const GAS f32x4*)(X + (size_t)r * DM) + F.lane;
        f32x4 y[8], x[8]; float s = 0.f;
#pragma unroll
        for (int j = 0; j < 8; ++j) { const v2u yb = yr[64 * j]; y[j] = (f32x4){__uint_as_float(yb.x << 16), __uint_as_float(yb.x & 0xffff0000u), __uint_as_float(yb.y << 16), __uint_as_float(yb.y & 0xffff0000u)};
            x[j] = xr[64 * j]; s += (y[j].x * y[j].x + y[j].y * y[j].y) + (y[j].z * y[j].z + y[j].w * y[j].w); }
        const float r1 = coef / sqrtf(wave_sum(s) * (1.f / DM) + EPS); float s2 = 0.f;
        GAS f32x4* xo = (GAS f32x4*)(Xout + (size_t)r * DM) + F.lane;
#pragma unroll
        for (int j = 0; j < 8; ++j) { const f32x4 w = *((const GAS f32x4*)wpost + F.lane + 64 * j); x[j] = x[j] + y[j] * r1 * w; xo[64 * j] = x[j];
            s2 += (x[j].x * x[j].x + x[j].y * x[j].y) + (x[j].z * x[j].z + x[j].w * x[j].w); }
        if (Hout) { const float r2 = 1.f / sqrtf(wave_sum(s2) * (1.f / DM) + EPS);
            GAS v2u* ho = (GAS v2u*)(Hout + (size_t)r * DM) + F.lane;
#pragma unroll
            for (int j = 0; j < 8; ++j) { const f32x4 w = *((const GAS f32x4*)wnext + F.lane + 64 * j); const f32x4 v = x[j] * r2 * w; v2u o; o.x = pk2(v.x, v.y); o.y = pk2(v.z, v.w); ho[64 * j] = o; } }
    }
}
__device__ __forceinline__ void row_first(const Frame& F, const float* Xin, float* Xout, bf16* Hout, const float* wnext) {
    const int gw = F.vcu * NWAVES + F.wave, NGW = F.G * NWAVES;
    for (int r = gw; r < S; r += NGW) {
        const GAS f32x4* xr = (const GAS f32x4*)(Xin + (size_t)r * DM) + F.lane; GAS f32x4* xo = (GAS f32x4*)(Xout + (size_t)r * DM) + F.lane;
        f32x4 x[8]; float s2 = 0.f;
#pragma unroll
        for (int j = 0; j < 8; ++j) { x[j] = xr[64 * j]; xo[64 * j] = x[j]; s2 += (x[j].x * x[j].x + x[j].y * x[j].y) + (x[j].z * x[j].z + x[j].w * x[j].w); }
        const float r2 = 1.f / sqrtf(wave_sum(s2) * (1.f / DM) + EPS);
        GAS v2u* ho = (GAS v2u*)(Hout + (size_t)r * DM) + F.lane;
#pragma unroll
        for (int j = 0; j < 8; ++j) { const f32x4 w = *((const GAS f32x4*)wnext + F.lane + 64 * j); const f32x4 v = x[j] * r2 * w; v2u o; o.x = pk2(v.x, v.y); o.y = pk2(v.z, v.w); ho[64 * j] = o; }
    }
}

#define WSL() ({ GAS unsigned char* p_ = (GAS unsigned char*)args.ws; asm volatile("" : "+s"(p_)); (unsigned char*)p_; })
#define BID() ({ int b_ = (int)blockIdx.x; asm volatile("" : "+s"(b_)); b_; })
#define GRD() ({ int g_ = (int)gridDim.x; asm volatile("" : "+s"(g_)); g_; })
#define INP(i) ({ int i_ = (i); asm volatile("" : "+s"(i_)); (const float*)(const GAS float*)args.in[i_]; })
#define PHASE_FRAME() Frame F = F0; { asm volatile("" : "+s"(F.vcu), "+s"(F.G)); int t_ = threadIdx.x; asm volatile("" : "+v"(t_)); F.tid = t_; F.lane = t_ & 63; F.wave = __builtin_amdgcn_readfirstlane(t_ >> 6); }
__global__ void __launch_bounds__(NWAVES * 64, 2) fwd(Args args) {
    extern __shared__ __attribute__((aligned(16))) unsigned char lds[];
    Frame F0;
    F0.lds = (LAS unsigned char*)lds;
    F0.MISC = (volatile LAS unsigned*)(F0.lds + MISC_OFF);
    F0.tid = threadIdx.x; F0.lane = F0.tid & 63; F0.wave = __builtin_amdgcn_readfirstlane(F0.tid >> 6);
    F0.G = gridDim.x; { const int bx = blockIdx.x; F0.vcu = (F0.G % 8 == 0) ? (bx % 8) * (F0.G / 8) + bx / 8 : bx; }
    F0.ctl = (gu32*)(args.ws + WS_CTL);
    for (int u = F0.tid; u < (LDS_BYTES - LDSCTL_OFF) / 4; u += NWAVES * 64) ((LAS unsigned*)(F0.lds + LDSCTL_OFF))[u] = 0u;
    __syncthreads();
    const int lo = args.ph_lo, hi = args.ph_hi;
    XcdBarrier bar; bar.bar = (unsigned*)(F0.ctl + CW_BAR); bar.x = 0; bar.st = nullptr;
    if (hi - lo > 1) bar = xcd_barrier_post((unsigned*)(F0.ctl + CW_BAR), F0.MISC + 8);
    int ph = 0;
#define PH_ON (lo <= ph && ph < hi)
#define PH_END do { if (lo <= ph && ph + 1 < hi) { XcdBarrier b2_ = bar; { GAS unsigned* bp_ = (GAS unsigned*)bar.bar; asm volatile("" : "+s"(bp_), "+s"(b2_.x)); b2_.bar = (unsigned*)bp_; } xcd_barrier(b2_); } ++ph; } while (0)

    if (PH_ON) {
        PHASE_FRAME(); unsigned char* ws = WSL();
        const float* w_in = INP(1); const float* w_out = INP(2); const float* f1g = INP(3); const float* f1u = INP(4); const float* f1d = INP(5);
        const float* f2g = INP(6); const float* f2u = INP(7); const float* f2d = INP(8);
        LAS float* scr = (LAS float*)(F.lds + RING_OFF + F.wave * 16384);
        const int gw = F.vcu * NWAVES + F.wave, NGW = F.G * NWAVES;
        constexpr int I_G = (DM / 64) * (DFF / 32), I_D = (DFF / 64) * (DM / 32), I_IN = (DM / 64) * (DIN / 32), I_OUT = (DM / 64) * (DM / 32);
        constexpr int I_LAYER = 6 * I_G + I_IN + I_OUT;
        static_assert(I_D == I_G, "item counts");
        for (int it = gw; it < NL * I_LAYER; it += NGW) {
            const int l = it / I_LAYER; int r = it - l * I_LAYER;
            unsigned char* wl = ws + WS_W + (size_t)l * W_LAYER;
            if (r < 2 * I_G || (r >= 3 * I_G + I_IN + I_OUT && r < 5 * I_G + I_IN + I_OUT)) {
                const bool second = r >= 2 * I_G; if (second) r -= 3 * I_G + I_IN + I_OUT;
                const bool up = r >= I_G; if (up) r -= I_G;
                const float* W = (second ? (up ? f2u : f2g) : (up ? f1u : f1g)) + (size_t)l * DM * DFF;
                const int nblk = DFF / 32, kb = r / nblk, nb = r - kb * nblk, n0 = 32 * nb;
                const int drow = (n0 >> 7) * 256 + (n0 & 127) + (up ? 128 : 0);
                p0_transpose_item(W, DM, DFF, (bf16*)(wl + (second ? W_GU2 : W_GU1)), 64 * kb, n0, drow, scr, F.lane);
            } else if (r < 3 * I_G) {
                r -= 2 * I_G; const int nblk = DM / 32, kb = r / nblk, nb = r - kb * nblk;
                p0_transpose_item(f1d + (size_t)l * DFF * DM, DFF, DM, (bf16*)(wl + W_DN1), 64 * kb, 32 * nb, 32 * nb, scr, F.lane);
            } else if (r < 3 * I_G + I_IN) {
                r -= 3 * I_G; const int nblk = DIN / 32, kb = r / nblk, nb = r - kb * nblk, n0 = 32 * nb, tile = n0 >> 8, q = n0 & 255;
                const int qq = (tile >= 15 && tile <= 18) ? (((q & 63) >> 5) * 128 + (q >> 6) * 32) : q;
                p0_transpose_item(w_in + (size_t)l * DM * DIN, DM, DIN, (bf16*)(wl + W_WIN), 64 * kb, n0, tile * 256 + qq, scr, F.lane);
            } else if (r < 3 * I_G + I_IN + I_OUT) {
                r -= 3 * I_G + I_IN; const int nblk = DM / 32, kb = r / nblk, nb = r - kb * nblk;
                p0_transpose_item(w_out + (size_t)l * DM * DM, DM, DM, (bf16*)(wl + W_WOUT), 64 * kb, 32 * nb, 32 * nb, scr, F.lane);
            } else {
                r -= 5 * I_G + I_IN + I_OUT; const int nblk = DM / 32, kb = r / nblk, nb = r - kb * nblk;
                p0_transpose_item(f2d + (size_t)l * DFF * DM, DFF, DM, (bf16*)(wl + W_DN2), 64 * kb, 32 * nb, 32 * nb, scr, F.lane);
            }
        }
        {
            float* rtab = (float*)(ws + WS_TAB + TAB_RT); float* ctab = (float*)(ws + WS_TAB + TAB_CT); float* tbt = (float*)(ws + WS_TAB + TAB_TB); float* lbs = (float*)(ws + WS_TAB + TAB_LB);
            const float* hg_lb = INP(12); const float* rel_b = INP(14);
            const int gid = F.vcu * (NWAVES * 64) + F.tid;
            if (gid < 3072) {
                const int pos = gid >> 4, j = gid & 15; const int p = pos < 128 ? pos : pos - 128;
                const float inv = 1.0f / exp2f((float)j * (1.0f / 16.0f) * 13.287712379549449f);
                const float ang = (float)p * inv;
                double rev = (double)ang * 0.15915494309189535; rev -= rint(rev); const float rv = (float)rev;
                float* dst = (pos < 128 ? rtab + pos * 32 : ctab + p * 32) + 2 * j;
                dst[0] = __builtin_amdgcn_cosf(rv); dst[1] = __builtin_amdgcn_sinf(rv);
            }
            if (gid < 12 * 257) { const int h = gid / 257, r = gid - h * 257; tbt[h * 260 + r] = rel_b[t5_bucket(r - 128) * 12 + h] * pg8::LOG2E; }
            if (gid < 1024) {
                float v[NL], mx = -INFINITY;
#pragma unroll
                for (int l = 0; l < NL; ++l) { v[l] = hg_lb[l * 1024 + gid]; mx = fmaxf(mx, v[l]); }
                float sum = 0.f;
#pragma unroll
                for (int l = 0; l < NL; ++l) { v[l] = __expf(v[l] - mx); sum += v[l]; }
                float c = 0.f; lbs[gid] = 0.f;
#pragma unroll
                for (int l = 1; l < NL; ++l) { c += v[l] / sum; lbs[l * 1024 + gid] = c; }
            }
        }
        row_first(F, INP(0), (float*)(ws + WS_X), (bf16*)(ws + WS_H), INP(9));
    }
    PH_END;

    for (int l = 0; l < NL; ++l) {
        if (PH_ON) { unsigned char* ws = WSL(); const unsigned char* wl = ws + WS_W + (size_t)l * W_LAYER;
            pg8::Gemm g{(const bf16*)(ws + WS_H), (const bf16*)(wl + W_GU1), S, NGU, DM}; pg8::StaticOrder so; so.init(S, NGU, GRD(), BID());
            pg8::EpiSwiGLU E{(bf16*)(ws + WS_ACT), DFF}; pg8::gemm_phase<pg8::EpiSwiGLU, pg8::StaticOrder, true, true>(F0.lds + RING_OFF, g, so, E); }
        PH_END;
        if (PH_ON) { unsigned char* ws = WSL(); const unsigned char* wl = ws + WS_W + (size_t)l * W_LAYER;
            pg8::Gemm g{(const bf16*)(ws + WS_ACT), (const bf16*)(wl + W_DN1), S, DM, DFF}; pg8::StaticOrder so; so.init(S, DM, GRD(), BID());
            pg8::EpiBf16Y E{(bf16*)(ws + WS_Y), DM}; pg8::gemm_phase<pg8::EpiBf16Y, pg8::StaticOrder, true, true>(F0.lds + RING_OFF, g, so, E); }
        PH_END;
        if (PH_ON) { PHASE_FRAME(); unsigned char* ws = WSL(); const float* nw = INP(9) + (size_t)l * 6 * DM;
            row_phase(F, (float*)(ws + WS_X), (const bf16*)(ws + WS_Y), (float*)(ws + WS_X), (bf16*)(ws + WS_H), nw + 1 * DM, nw + 2 * DM, 0.5f); }
        PH_END;
        if (PH_ON) { unsigned char* ws = WSL(); const unsigned char* wl = ws + WS_W + (size_t)l * W_LAYER;
            pg8::Gemm g{(const bf16*)(ws + WS_H), (const bf16*)(wl + W_WIN), S, DIN, DM}; pg8::StaticOrder so; so.init(S, DIN, GRD(), BID());
            unsigned char* Bb = ws + WS_B;
            pg8::EpiWin E{(bf16*)(ws + WS_AQ), (bf16*)(ws + WS_AK), (bf16*)(ws + WS_AV), (bf16*)(ws + WS_CQ), (bf16*)(ws + WS_CK), (bf16*)(ws + WS_CV),
                          Bb,
                          (const float*)(ws + WS_TAB + TAB_LB) + l * 1024, INP(11) + l * 128, (const float*)(ws + WS_TAB + TAB_RT), (const float*)(ws + WS_TAB + TAB_CT)};
            pg8::gemm_phase<pg8::EpiWin, pg8::StaticOrder, true, true>(F0.lds + RING_OFF, g, so, E); }
        PH_END;
        if (PH_ON) {
            { unsigned char* ws = WSL(); unsigned char* Bb = ws + WS_B;
              hg::pass1(GRD(), BID(), (const float*)(Bb + WB_FF), (const float*)(Bb + WB_FB), (const bf16*)(Bb + WB_BI), (bf16*)(Bb + WB_P), (float*)(ws + WS_DG), F0.lds + RING_OFF); }
            { unsigned char* ws = WSL();
              const attn_body::bf16* CQ = (const attn_body::bf16*)(ws + WS_CQ); const attn_body::bf16* CK = (const attn_body::bf16*)(ws + WS_CK); const attn_body::bf16* CV = (const attn_body::bf16*)(ws + WS_CV);
              attn_body::bf16* MIXo = (attn_body::bf16*)(ws + WS_MIX);
              const int gA = GRD(), bA = BID();
              if (gA == 256) {
                { const int u = bA, h = u >> 5, qb = u & 31, kvh = h / 3;
                  attn_body::attn_unit<8, 768, 256, 2048, 0>(qb * 256, S / 64, CQ + h * 64, CK + kvh * 64, CV + kvh * 64, MIXo + 1280 + h * 64, (char*)lds + RING_OFF); }
                { const int su = bA >> 1, half = bA & 1, u = 256 + su, h = u >> 5, qb = u & 31, kvh = h / 3;
                  float* po = (float*)(ws + WS_PO) + ((size_t)su * 2 + half) * 16384; float* pml = (float*)(ws + WS_PML) + ((size_t)su * 2 + half) * 512;
                  attn_body::attn_unit<8, 768, 256, 2048, 0, true>(qb * 256, S / 128, CQ + h * 64, CK + kvh * 64 + (size_t)half * 4096 * 256, CV + kvh * 64 + (size_t)half * 4096 * 256, MIXo, (char*)lds + RING_OFF,
                                                                  nullptr, 0.f, 0, po, pml); }
              } else {
                for (int u = bA; u < 384; u += gA) { const int h = u >> 5, qb = u & 31, kvh = h / 3;
                  attn_body::attn_unit<8, 768, 256, 2048, 0>(qb * 256, S / 64, CQ + h * 64, CK + kvh * 64, CV + kvh * 64, MIXo + 1280 + h * 64, (char*)lds + RING_OFF); }
              } }
            { unsigned char* ws = WSL();
              const attn_body::bf16* AQp = (const attn_body::bf16*)(ws + WS_AQ); const attn_body::bf16* AKp = (const attn_body::bf16*)(ws + WS_AK); const attn_body::bf16* AVp = (const attn_body::bf16*)(ws + WS_AV);
              attn_body::bf16* MIXo = (attn_body::bf16*)(ws + WS_MIX); const float* tbp = (const float*)(ws + WS_TAB + TAB_TB); const float* skp = INP(10) + l * 12;
              const int gB = GRD(); for (int u = BID(); u < 384; u += gB) { const int h = u >> 5, qb = u & 31, kvh = h / 3;
                const int t_lo = qb * 4 - 2 < 0 ? 0 : qb * 4 - 2, t_hi = qb * 4 + 6 > S / 64 ? S / 64 : qb * 4 + 6;
                attn_body::attn_unit<8, 768, 256, 2048, 1>(qb * 256, t_hi - t_lo, AQp + h * 64, AKp + kvh * 64 + (size_t)t_lo * 64 * 256, AVp + kvh * 64 + (size_t)t_lo * 64 * 256, MIXo + h * 64, (char*)lds + RING_OFF,
                                                           tbp + h * 260, skp[h] * pg8::LOG2E, t_lo * 64); } }
        }
        PH_END;
        if (PH_ON) { unsigned char* ws = WSL(); hg::scan(GRD(), ({ int v_ = F0.vcu; asm volatile("" : "+s"(v_)); v_; }), (const bf16*)(ws + WS_B + WB_P), (const float*)(ws + WS_DG), (bf16*)(ws + WS_SS)); }
        PH_END;
        if (PH_ON) { unsigned char* ws = WSL(); unsigned char* Bb = ws + WS_B;
            if (GRD() == 256) {
                int t_ = threadIdx.x; asm volatile("" : "+v"(t_)); const int bM = BID(), su = bM >> 1, u = 256 + su, h = u >> 5, qb = u & 31;
                const int row = 128 * (bM & 1) + (t_ >> 2), c0 = (t_ & 3) * 16;
                const float* p0 = (const float*)(ws + WS_PO) + ((size_t)su * 2) * 16384 + row * 64 + c0; const float* p1 = p0 + 16384;
                const float* ml0 = (const float*)(ws + WS_PML) + ((size_t)su * 2) * 512 + row * 2; const float* ml1 = ml0 + 512;
                const float m0 = ml0[0], l0 = ml0[1], m1 = ml1[0], l1 = ml1[1], mm = fmaxf(m0, m1), w0 = __builtin_amdgcn_exp2f(m0 - mm), w1 = __builtin_amdgcn_exp2f(m1 - mm);
                const float inv = 1.0f / (l0 * w0 + l1 * w1), a0 = w0 * inv, a1 = w1 * inv;
                bf16* op = (bf16*)(ws + WS_MIX) + (size_t)(qb * 256 + row) * 2048 + 1280 + h * 64 + c0;
#pragma unroll
                for (int j = 0; j < 2; ++j) { const f32x4 x0 = *(const f32x4*)(p0 + 8 * j), x1 = *(const f32x4*)(p0 + 8 * j + 4), y0 = *(const f32x4*)(p1 + 8 * j), y1 = *(const f32x4*)(p1 + 8 * j + 4);
                    const f32x4 r0 = x0 * a0 + y0 * a1, r1 = x1 * a0 + y1 * a1; v4u o; o.x = pk2(r0.x, r0.y); o.y = pk2(r0.z, r0.w); o.z = pk2(r1.x, r1.y); o.w = pk2(r1.z, r1.w);
                    *(v4u*)(op + 8 * j) = o; }
            }
            hg::pass2(GRD(), BID(), (const bf16*)(Bb + WB_BQ), (const float*)(Bb + WB_FF), (const float*)(Bb + WB_FB), (const bf16*)(Bb + WB_BI), (const bf16*)(Bb + WB_SG), (const bf16*)(ws + WS_SS), INP(13) + l * 128, (bf16*)(ws + WS_MIX), F0.lds + RING_OFF); }
        PH_END;
        if (PH_ON) { unsigned char* ws = WSL(); const unsigned char* wl = ws + WS_W + (size_t)l * W_LAYER;
            pg8::Gemm g{(const bf16*)(ws + WS_MIX), (const bf16*)(wl + W_WOUT), S, DM, DM}; pg8::StaticOrder so; so.init(S, DM, GRD(), BID());
            pg8::EpiBf16Y E{(bf16*)(ws + WS_Y), DM}; pg8::gemm_phase<pg8::EpiBf16Y, pg8::StaticOrder, true, true>(F0.lds + RING_OFF, g, so, E); }
        PH_END;
        if (PH_ON) { PHASE_FRAME(); unsigned char* ws = WSL(); const float* nw = INP(9) + (size_t)l * 6 * DM;
            row_phase(F, (float*)(ws + WS_X), (const bf16*)(ws + WS_Y), (float*)(ws + WS_X), (bf16*)(ws + WS_H), nw + 3 * DM, nw + 4 * DM, 1.0f); }
        PH_END;
        if (PH_ON) { unsigned char* ws = WSL(); const unsigned char* wl = ws + WS_W + (size_t)l * W_LAYER;
            pg8::Gemm g{(const bf16*)(ws + WS_H), (const bf16*)(wl + W_GU2), S, NGU, DM}; pg8::StaticOrder so; so.init(S, NGU, GRD(), BID());
            pg8::EpiSwiGLU E{(bf16*)(ws + WS_ACT), DFF}; pg8::gemm_phase<pg8::EpiSwiGLU, pg8::StaticOrder, true, true>(F0.lds + RING_OFF, g, so, E); }
        PH_END;
        if (PH_ON) { unsigned char* ws = WSL(); const unsigned char* wl = ws + WS_W + (size_t)l * W_LAYER;
            pg8::Gemm g{(const bf16*)(ws + WS_ACT), (const bf16*)(wl + W_DN2), S, DM, DFF}; pg8::StaticOrder so; so.init(S, DM, GRD(), BID());
            pg8::EpiBf16Y E{(bf16*)(ws + WS_Y), DM}; pg8::gemm_phase<pg8::EpiBf16Y, pg8::StaticOrder, true, true>(F0.lds + RING_OFF, g, so, E); }
        PH_END;
        if (PH_ON) { PHASE_FRAME(); unsigned char* ws = WSL(); const float* nw = INP(9) + (size_t)l * 6 * DM; const bool lastl = (l == NL - 1);
            row_phase(F, (float*)(ws + WS_X), (const bf16*)(ws + WS_Y), lastl ? (float*)(GAS float*)args.out : (float*)(ws + WS_X), lastl ? (bf16*)nullptr : (bf16*)(ws + WS_H), nw + 5 * DM, nw + 6 * DM, 0.5f); }
        PH_END;
    }
#undef PH_ON
#undef PH_END
}
constexpr int N_PHASES = 1 + NL * 12;

extern "C" void kernel_launch(void* const* d_in, const int* in_sizes, int n_in, void* d_out, int out_size, void* d_ws, size_t ws_size, hipStream_t stream) {
    static int grid = 0;
    if (grid == 0) {
        if (n_in != 15 || in_sizes[0] != S * DM || out_size != S * DM || ws_size < WS_END) { fprintf(stderr, "kernel_launch: unexpected shapes / workspace (n_in %d, in0 %d, out %d, ws %zu < %zu); nothing launched\n", n_in, n_in > 0 ? in_sizes[0] : -1, out_size, ws_size, (size_t)WS_END); grid = -1; return; }
        int dev = 0, cus = 0, per_cu = 0;
        if (hipGetDevice(&dev) != hipSuccess || hipDeviceGetAttribute(&cus, hipDeviceAttributeMultiprocessorCount, dev) != hipSuccess) { grid = -1; return; }
        if (hipFuncSetAttribute((const void*)fwd, hipFuncAttributeMaxDynamicSharedMemorySize, LDS_BYTES) != hipSuccess) { fprintf(stderr, "kernel_launch: hipFuncSetAttribute failed\n"); grid = -1; return; }
        if (hipOccupancyMaxActiveBlocksPerMultiprocessor(&per_cu, (const void*)fwd, NWAVES * 64, LDS_BYTES) != hipSuccess || per_cu < 1)
            fprintf(stderr, "kernel_launch: note: occupancy query reports %d workgroups per CU\n", per_cu);
        (void)hipGetLastError();
        grid = cus;
    }
    if (grid < 0) return;
    if (hipMemsetAsync((char*)d_ws + WS_CTL, 0, CTL_ZERO_BYTES, stream) != hipSuccess) { fprintf(stderr, "kernel_launch: memset failed\n"); return; }
    Args a{};
    for (int i = 0; i < 15; ++i) a.in[i] = (const float*)d_in[i];
    a.out = (float*)d_out; a.ws = (unsigned char*)d_ws;
#if MK_SPLIT
    for (int p = 0; p < N_PHASES; ++p) { a.ph_lo = p; a.ph_hi = p + 1; hipLaunchKernelGGL(fwd, dim3(grid), dim3(NWAVES * 64), LDS_BYTES, stream, a); }
#else
    a.ph_lo = 0; a.ph_hi = N_PHASES;
    hipLaunchKernelGGL(fwd, dim3(grid), dim3(NWAVES * 64), LDS_BYTES, stream, a);
#endif
    const hipError_t le = hipPeekAtLastError();
    if (le != hipSuccess) fprintf(stderr, "kernel_launch: launch failed: %s\n", hipGetErrorName(le));
}
```

```cpp
#include <hip/hip_runtime.h>
#include <hip/hip_bf16.h>
#include <cstdio>
#include <cstdint>
#include <cmath>
namespace pg8 {
#define PG8_LAS __attribute__((address_space(3)))
typedef unsigned short bf16_t;
typedef short bf16x8 __attribute__((ext_vector_type(8)));
typedef float f32x4 __attribute__((ext_vector_type(4)));
typedef unsigned u32x4 __attribute__((ext_vector_type(4)));
constexpr int BM = 256, BK = 64, HALF = 128, HTB = HALF * BK * 2  , STAGE_BYTES = 8 * HTB, NXCD = 8, WGM = 4;

__host__ __device__ __forceinline__ int lds_byte(int r, int c) { const int st = (r >> 4) * 2 + (c >> 5), rr = r & 15, cc = c & 31, ob = rr * 64 + cc * 2; return st * 1024 + (ob ^ (((ob >> 9) & 1) << 5)); }
__host__ __device__ __forceinline__ void stage_rc(int b, int& R, int& C) { const int st = b / 1024, sb = b % 1024, swz = sb ^ (((sb >> 9) & 1) << 5); R = (st >> 1) * 16 + swz / 64; C = (st & 1) * 32 + (swz % 64) / 2; }
__host__ __device__ __forceinline__ int perm32(int rho) { const int n = rho >> 4, i = rho & 15; return 8 * (i >> 2) + 4 * n + (i & 3); }

struct Unit { int pm, pn; };
struct Gemm { const bf16_t* A; const bf16_t* Bt; int M, N, K; };

struct StaticOrder {
    int nM, nN, nwg, G, c;
    __host__ __device__ void init(int M, int N, int G_, int c_) { nM = M / BM; nN = N / BM; nwg = nM * nN; G = G_; c = c_; }
    __host__ __device__ bool next(int i, Unit& u) const {
        const long L = (long)i * G + c; if (L >= nwg) return false;
        int wgid = (int)L; { const int q = nwg / NXCD, r = nwg % NXCD, xcd = wgid % NXCD, off = wgid / NXCD; wgid = (xcd < r ? xcd * (q + 1) : r * (q + 1) + (xcd - r) * q) + off; }
        const int nig = WGM * nN, gid = wgid / nig, fm = gid * WGM, gsz = (nM - fm) < WGM ? (nM - fm) : WGM;
        u.pm = fm + ((wgid % nig) % gsz); u.pn = (wgid % nig) / gsz; return true;
    }
    __device__ __forceinline__ void a_ready(const Unit&) const {}
    __device__ __forceinline__ void done(const Unit&) const {}
};

__device__ __forceinline__ unsigned cvt_pk_bf16(float lo, float hi) { unsigned r; asm volatile("v_cvt_pk_bf16_f32 %0, %1, %2" : "=v"(r) : "v"(lo), "v"(hi)); return r; }
typedef float f32x2 __attribute__((ext_vector_type(2)));
constexpr float LOG2E = 1.4426950408889634f;
constexpr float QSCALE = 0.125f * 1.4426950408889634f;
__device__ __forceinline__ float sigmoid_f(float x) { return __builtin_amdgcn_rcpf(1.0f + __builtin_amdgcn_exp2f(-LOG2E * x)); }

struct EpiF32 {
    static constexpr bool PERM = false, AFTER_DRAIN = false;
    float* C; int ldc;
    __device__ __forceinline__ void operator()(const f32x4 (&acc)[2][2][4][2], const Unit& u, int wr, int wc, int fr, int fq) const {
        const int row0 = u.pm * BM + wr * 64 + fr, col0 = u.pn * BM + wc * 32 + 4 * fq;
#pragma unroll
        for (int ai = 0; ai < 2; ++ai)
#pragma unroll
            for (int m = 0; m < 4; ++m) { float* rowp = C + (size_t)(row0 + ai * HALF + m * 16) * ldc + col0;
#pragma unroll
                for (int bj = 0; bj < 2; ++bj)
#pragma unroll
                    for (int n = 0; n < 2; ++n) *(f32x4*)(rowp + bj * HALF + n * 16) = acc[ai][bj][m][n]; }
    }
};


__device__ __forceinline__ unsigned pk4_e4m3(float a, float b, float c, float d) {
    a = __builtin_amdgcn_fmed3f(a, -448.f, 448.f); b = __builtin_amdgcn_fmed3f(b, -448.f, 448.f); c = __builtin_amdgcn_fmed3f(c, -448.f, 448.f); d = __builtin_amdgcn_fmed3f(d, -448.f, 448.f);
    int w = 0; w = __builtin_amdgcn_cvt_pk_fp8_f32(a, b, w, false); w = __builtin_amdgcn_cvt_pk_fp8_f32(c, d, w, true); return (unsigned)w;
}
template <int SCL2> struct EpiBf16YT {
    static constexpr bool PERM = true, AFTER_DRAIN = false;
    static constexpr float GS = 1.0f / (float)(1u << SCL2);
    bf16_t* O; int ldc;
    __device__ __forceinline__ void operator()(const f32x4 (&acc)[2][2][4][2], const Unit& u, int wr, int wc, int fr, int fq) const {
        const int row0 = u.pm * BM + wr * 64 + fr, col0 = u.pn * BM + wc * 32 + 8 * fq;
#pragma unroll
        for (int ai = 0; ai < 2; ++ai)
#pragma unroll
            for (int m = 0; m < 4; ++m) { bf16_t* rowp = O + (size_t)(row0 + ai * HALF + m * 16) * ldc + col0;
#pragma unroll
                for (int bj = 0; bj < 2; ++bj) { f32x4 v0 = acc[ai][bj][m][0], v1 = acc[ai][bj][m][1]; if constexpr (SCL2 != 0) { v0 = v0 * GS; v1 = v1 * GS; }
                    u32x4 w; w.x = cvt_pk_bf16(v0[0], v0[1]); w.y = cvt_pk_bf16(v0[2], v0[3]); w.z = cvt_pk_bf16(v1[0], v1[1]); w.w = cvt_pk_bf16(v1[2], v1[3]);
                    *(u32x4*)(rowp + bj * HALF) = w; } }
    }
};
typedef EpiBf16YT<0> EpiBf16Y;

template <int SCL2, int O8 = -1> struct EpiSwiGLUT {
    static constexpr bool PERM = true, AFTER_DRAIN = false;
    static constexpr float GS = 1.0f / (float)(1u << SCL2), PC = (float)(1u << SCL2) * (float)(1u << SCL2) / (float)(1u << (O8 < 0 ? 0 : O8));
    bf16_t* O; int ldc;
    __device__ __forceinline__ void operator()(const f32x4 (&acc)[2][2][4][2], const Unit& u, int wr, int wc, int fr, int fq) const {
        const int row0 = u.pm * BM + wr * 64 + fr, col0 = u.pn * HALF + wc * 32 + 8 * fq;
#pragma unroll
        for (int ai = 0; ai < 2; ++ai)
#pragma unroll
            for (int m = 0; m < 4; ++m) { bf16_t* rowp = O + (size_t)(row0 + ai * HALF + m * 16) * ldc + col0;
                float o[8];
                { float g[8], t[8];
#pragma unroll
                  for (int n = 0; n < 2; ++n)
#pragma unroll
                      for (int i = 0; i < 4; ++i) { g[4 * n + i] = acc[ai][0][m][n][i]; o[4 * n + i] = g[4 * n + i] * acc[ai][1][m][n][i]; }
#pragma unroll
                  for (int i = 0; i < 8; ++i) t[i] = (-LOG2E * GS) * g[i];
#pragma unroll
                  for (int i = 0; i < 8; ++i) t[i] = __builtin_amdgcn_exp2f(t[i]);
#pragma unroll
                  for (int i = 0; i < 8; ++i) { if constexpr (SCL2 == 0 && O8 < 0) t[i] = 1.0f + t[i]; else t[i] = __builtin_fmaf(t[i], PC, PC); }
#pragma unroll
                  for (int i = 0; i < 8; ++i) t[i] = __builtin_amdgcn_rcpf(t[i]);
#pragma unroll
                  for (int i = 0; i < 8; ++i) o[i] *= t[i]; }
                if constexpr (O8 >= 0) { typedef unsigned u32x2_t __attribute__((ext_vector_type(2))); u32x2_t w; w.x = pk4_e4m3(o[0], o[1], o[2], o[3]); w.y = pk4_e4m3(o[4], o[5], o[6], o[7]);
                    *(u32x2_t*)((unsigned char*)O + (size_t)(row0 + ai * HALF + m * 16) * ldc + col0) = w; }
                else { u32x4 w; w.x = cvt_pk_bf16(o[0], o[1]); w.y = cvt_pk_bf16(o[2], o[3]); w.z = cvt_pk_bf16(o[4], o[5]); w.w = cvt_pk_bf16(o[6], o[7]);
                    *(u32x4*)rowp = w; } }
    }
};
typedef EpiSwiGLUT<0> EpiSwiGLU;
template <int O8> struct EpiSwiGLUI8 {
    static constexpr bool PERM = true, AFTER_DRAIN = false;
    static constexpr float OS = (float)(1u << (O8 < 0 ? 0 : O8));
    bf16_t* O; int ldc; const float* hs; float wg, wu;
    __device__ __forceinline__ void operator()(const f32x4 (&acc)[2][2][4][2], const Unit& u, int wr, int wc, int fr, int fq) const {
        const int row0 = u.pm * BM + wr * 64 + fr, col0 = u.pn * HALF + wc * 32 + 8 * fq;
        float hv[8];
#pragma unroll
        for (int q = 0; q < 8; ++q) hv[q] = hs[row0 + (q >> 2) * HALF + (q & 3) * 16];
#pragma unroll
        for (int ai = 0; ai < 2; ++ai)
#pragma unroll
            for (int m = 0; m < 4; ++m) { const int row = row0 + ai * HALF + m * 16; const float h = hv[ai * 4 + m];
                const float c1 = -LOG2E * h * wg, pc = __builtin_amdgcn_rcpf(h * h * wg * wu * OS);
                float o[8];
                { float g[8], t[8];
#pragma unroll
                  for (int n = 0; n < 2; ++n)
#pragma unroll
                      for (int i = 0; i < 4; ++i) { const float fg = acc[ai][0][m][n][i], fu = acc[ai][1][m][n][i];
                          g[4 * n + i] = (float)__float_as_int(fg); o[4 * n + i] = g[4 * n + i] * (float)__float_as_int(fu); }
#pragma unroll
                  for (int i = 0; i < 8; ++i) t[i] = c1 * g[i];
#pragma unroll
                  for (int i = 0; i < 8; ++i) t[i] = __builtin_amdgcn_exp2f(t[i]);
#pragma unroll
                  for (int i = 0; i < 8; ++i) t[i] = __builtin_fmaf(t[i], pc, pc);
#pragma unroll
                  for (int i = 0; i < 8; ++i) t[i] = __builtin_amdgcn_rcpf(t[i]);
#pragma unroll
                  for (int i = 0; i < 8; ++i) o[i] *= t[i]; }
                if constexpr (O8 >= 0) { typedef unsigned u32x2_t __attribute__((ext_vector_type(2))); u32x2_t w; w.x = pk4_e4m3(o[0], o[1], o[2], o[3]); w.y = pk4_e4m3(o[4], o[5], o[6], o[7]);
                    *(u32x2_t*)((unsigned char*)O + (size_t)row * ldc + col0) = w; }
                else { u32x4 w; w.x = cvt_pk_bf16(o[0], o[1]); w.y = cvt_pk_bf16(o[2], o[3]); w.z = cvt_pk_bf16(o[4], o[5]); w.w = cvt_pk_bf16(o[6], o[7]);
                    *(u32x4*)(O + (size_t)row * ldc + col0) = w; } }
    }
};

struct EpiWin {
    static constexpr bool PERM = true, AFTER_DRAIN = false;
    bf16_t *AQ, *AK, *AV, *CQ, *CK, *CV;
    unsigned char* Bb;
    const float* lb;
    const float* qkw;
    const float* rtab; const float* ctab;
    __device__ __forceinline__ void operator()(const f32x4 (&acc)[2][2][4][2], const Unit& u, int wr, int wc, int fr, int fq) const {
        const int pn = u.pn, row0 = u.pm * BM + wr * 64 + fr, cl = wc * 32 + 8 * fq;
        if (pn < 5 || pn == 19) {
            bf16_t* base; int ldc, colt; float sc = 1.f;
            if (pn < 3) { base = AQ; ldc = 768; colt = pn * 256; sc = QSCALE; } else if (pn == 3) { base = AK; ldc = 256; colt = 0; } else if (pn == 4) { base = AV; ldc = 256; colt = 0; } else { base = CV; ldc = 256; colt = 0; }
#pragma unroll
            for (int ai = 0; ai < 2; ++ai)
#pragma unroll
                for (int m = 0; m < 4; ++m) { bf16_t* rowp = base + (size_t)(row0 + ai * HALF + m * 16) * ldc + colt + cl;
#pragma unroll
                    for (int bj = 0; bj < 2; ++bj) { const f32x4 v0 = acc[ai][bj][m][0] * sc, v1 = acc[ai][bj][m][1] * sc;
                        u32x4 w; w.x = cvt_pk_bf16(v0[0], v0[1]); w.y = cvt_pk_bf16(v0[2], v0[3]); w.z = cvt_pk_bf16(v1[0], v1[1]); w.w = cvt_pk_bf16(v1[2], v1[3]);
                        *(u32x4*)(rowp + bj * HALF) = w; } }
        } else if (pn < 15) {
            const int sec = (pn - 5) >> 1, colt = ((pn - 5) & 1) * 256;
            if (sec == 1 || sec == 2) {
                float* o2 = (float*)(Bb + ((size_t)(sec + 1) << 24)); const float* lbp = lb + (sec == 2 ? 512 : 0);
#pragma unroll
                for (int bj = 0; bj < 2; ++bj) { const int col = colt + bj * HALF + cl;
                    const f32x4 lv0 = *(const f32x4*)(lbp + col), lv1 = *(const f32x4*)(lbp + col + 4);
#pragma unroll
                    for (int ai = 0; ai < 2; ++ai)
#pragma unroll
                        for (int m = 0; m < 4; ++m) { const size_t off = (size_t)(row0 + ai * HALF + m * 16) * 512 + col;
                            const f32x4 a0 = acc[ai][bj][m][0], a1 = acc[ai][bj][m][1]; f32x4 f0, f1;
#pragma unroll
                            for (int i = 0; i < 4; ++i) { f0[i] = lv0[i] + (1.f - lv0[i]) * sigmoid_f(a0[i]); f1[i] = lv1[i] + (1.f - lv1[i]) * sigmoid_f(a1[i]); }
                            typedef _Float16 h16x8_t __attribute__((ext_vector_type(8))); typedef float f32x8_t __attribute__((ext_vector_type(8)));
                            const f32x8_t f8 = {f0[0], f0[1], f0[2], f0[3], f1[0], f1[1], f1[2], f1[3]};
                            *(h16x8_t*)((_Float16*)o2 + off) = __builtin_convertvector(f8, h16x8_t); } }
            } else {
                bf16_t* o1 = (bf16_t*)(Bb + ((size_t)(sec == 0 ? 0 : sec - 2) << 23));
#pragma unroll
                for (int bj = 0; bj < 2; ++bj) { const int col = colt + bj * HALF + cl;
#pragma unroll
                    for (int ai = 0; ai < 2; ++ai)
#pragma unroll
                        for (int m = 0; m < 4; ++m) { const size_t off = (size_t)(row0 + ai * HALF + m * 16) * 512 + col;
                            f32x4 a0 = acc[ai][bj][m][0], a1 = acc[ai][bj][m][1];
                            if (sec != 3) {
#pragma unroll
                                for (int i = 0; i < 4; ++i) { a0[i] = a0[i] * sigmoid_f(a0[i]); a1[i] = a1[i] * sigmoid_f(a1[i]); } }
                            u32x4 w; w.x = cvt_pk_bf16(a0[0], a0[1]); w.y = cvt_pk_bf16(a0[2], a0[3]); w.z = cvt_pk_bf16(a1[0], a1[1]); w.w = cvt_pk_bf16(a1[2], a1[3]);
                            *(u32x4*)(o1 + off) = w; } }
            }
        } else {
            const bool isq = pn < 18; bf16_t* base = isq ? CQ : CK; const int ldc = isq ? 768 : 256, head = (isq ? (pn - 15) * 4 : 0) + wc;
            const float* w = qkw + (isq ? 0 : 64); const float sc = isq ? QSCALE : 1.f;
            f32x4 wv[2][2];
#pragma unroll
            for (int bj = 0; bj < 2; ++bj)
#pragma unroll
                for (int n = 0; n < 2; ++n) wv[bj][n] = *(const f32x4*)(w + 32 * bj + 8 * fq + 4 * n) * sc;
#pragma unroll
            for (int ai = 0; ai < 2; ++ai)
#pragma unroll
                for (int m = 0; m < 4; ++m) { const int row = row0 + ai * HALF + m * 16;
                    float ss = 0.f;
#pragma unroll
                    for (int bj = 0; bj < 2; ++bj)
#pragma unroll
                        for (int n = 0; n < 2; ++n) { const f32x4 x = acc[ai][bj][m][n]; ss += (x[0] * x[0] + x[1] * x[1]) + (x[2] * x[2] + x[3] * x[3]); }
                    ss += __shfl_xor(ss, 16); ss += __shfl_xor(ss, 32);
                    const float r = __builtin_amdgcn_rsqf(ss * (1.0f / 64.0f) + 1e-6f);
                    bf16_t* rowp = base + (size_t)row * ldc + head * 64 + 8 * fq;
                    f32x4 csv[2][2];
#pragma unroll
                    for (int bj = 0; bj < 2; ++bj) { const float* tab = bj == 0 ? rtab + (size_t)(row >> 6) * 32 : ctab + (size_t)(row & 63) * 32;
#pragma unroll
                        for (int n = 0; n < 2; ++n) csv[bj][n] = *(const f32x4*)(tab + (4 * fq + 2 * n) * 2); }
#pragma unroll
                    for (int bj = 0; bj < 2; ++bj) {
                        float o[8];
#pragma unroll
                        for (int n = 0; n < 2; ++n) { const f32x4 x = acc[ai][bj][m][n] * r * wv[bj][n]; const f32x4 cs = csv[bj][n];
                            o[4 * n + 0] = x[0] * cs[0] - x[1] * cs[1]; o[4 * n + 1] = x[0] * cs[1] + x[1] * cs[0];
                            o[4 * n + 2] = x[2] * cs[2] - x[3] * cs[3]; o[4 * n + 3] = x[2] * cs[3] + x[3] * cs[2]; }
                        u32x4 wd; wd.x = cvt_pk_bf16(o[0], o[1]); wd.y = cvt_pk_bf16(o[2], o[3]); wd.z = cvt_pk_bf16(o[4], o[5]); wd.w = cvt_pk_bf16(o[6], o[7]);
                        *(u32x4*)(rowp + 32 * bj) = wd; } }
        }
    }
};
typedef int i32x8 __attribute__((ext_vector_type(8))); typedef int i32x4 __attribute__((ext_vector_type(4)));
template <class Epi, class Sched, bool ALIGN_EPI = false, bool SP2 = false, int F8 = 0>
__device__ __forceinline__ void gemm_phase(PG8_LAS unsigned char* lds, const Gemm g, const Sched& S, const Epi& E) {
    int tid_l = threadIdx.x; asm volatile("" : "+v"(tid_l)); const int tid = tid_l, wid = __builtin_amdgcn_readfirstlane(tid >> 6), lane = tid & 63, wr = wid >> 2, wc = wid & 3, fr = lane & 15, fq = lane >> 4;
    const int K = g.K, nt = K / BK;
    unsigned voffA[2], voffB[2];
#pragma unroll
    for (int i = 0; i < 2; ++i) { int R, C; stage_rc(tid * 16 + i * 8192, R, C); const int Rb = Epi::PERM ? ((R & ~31) + perm32(R & 31)) : R;
        voffA[i] = (unsigned)(R * K + C) * 2u; voffB[i] = (unsigned)(Rb * K + C) * 2u; }
    const size_t kstep = (size_t)(BK * 2);
    const size_t hstep = (size_t)HALF * K * 2;
    const size_t tstep = 2 * hstep;
    const unsigned ldsw = (unsigned)wid * 1024u;
    const int aoff = lds_byte(wr * 64 + fr, fq * 8), boff = lds_byte(wc * 32 + fr, fq * 8);
#define PG8_SA(b, h) (((b) * 2 + (h)) * HTB)
#define PG8_SB(b, h) ((4 + (b) * 2 + (h)) * HTB)
#define PG8_STAGE(bufoff, gbase, voff) do { _Pragma("unroll") for (int _i = 0; _i < 2; ++_i) \
        __builtin_amdgcn_global_load_lds((const unsigned*)((const char*)(gbase) + (voff)[_i]), (PG8_LAS unsigned*)(lds + (bufoff) + ldsw + _i * 8192), 16, 0, 0); } while (0)
#define PG8_J8(x, y) __builtin_shufflevector(__builtin_bit_cast(i32x4, x), __builtin_bit_cast(i32x4, y), 0, 1, 2, 3, 4, 5, 6, 7)
#define PG8_LDA(dst, b, h) do { _Pragma("unroll") for (int m = 0; m < 4; ++m) _Pragma("unroll") for (int k = 0; k < 2; ++k) dst[m][k] = *(const PG8_LAS bf16x8*)(lds + PG8_SA(b, h) + aoff + m * 2048 + k * 1024); \
        if constexpr (F8 == 1) { _Pragma("unroll") for (int m = 0; m < 4; ++m) dst##8[m] = PG8_J8(dst[m][0], dst[m][1]); } } while (0)
#define PG8_LDB(dst, b, h) do { _Pragma("unroll") for (int n = 0; n < 2; ++n) _Pragma("unroll") for (int k = 0; k < 2; ++k) dst[n][k] = *(const PG8_LAS bf16x8*)(lds + PG8_SB(b, h) + boff + n * 2048 + k * 1024); \
        if constexpr (F8 == 1) { _Pragma("unroll") for (int n = 0; n < 2; ++n) dst##8[n] = PG8_J8(dst[n][0], dst[n][1]); } } while (0)
#define PG8_MMA(ai, bj, At, Bt) do { __builtin_amdgcn_s_setprio(1); \
        if constexpr (F8 == 2) { _Pragma("unroll") for (int m = 0; m < 4; ++m) _Pragma("unroll") for (int n = 0; n < 2; ++n) _Pragma("unroll") for (int k = 0; k < 2; ++k) asm volatile("v_mfma_i32_16x16x64_i8 %0, %1, %2, %0" : "+v"(acc[ai][bj][m][n]) : "v"(Bt[n][k]), "v"(At[m][k])); } \
        else if constexpr (F8 == 1) { _Pragma("unroll") for (int m = 0; m < 4; ++m) _Pragma("unroll") for (int n = 0; n < 2; ++n) asm volatile("v_mfma_f32_16x16x128_f8f6f4 %0, %1, %2, %0" : "+v"(acc[ai][bj][m][n]) : "v"(Bt##8[n]), "v"(At##8[m])); } \
        else { _Pragma("unroll") for (int m = 0; m < 4; ++m) _Pragma("unroll") for (int n = 0; n < 2; ++n) _Pragma("unroll") for (int k = 0; k < 2; ++k) \
        acc[ai][bj][m][n] = __builtin_amdgcn_mfma_f32_16x16x32_bf16(Bt[n][k], At[m][k], acc[ai][bj][m][n], 0, 0, 0); } __builtin_amdgcn_s_setprio(0); } while (0)
#define PG8_WAIT_V(n) asm volatile("s_waitcnt vmcnt(" #n ")" ::: "memory")
#define PG8_WAIT_L(n) asm volatile("s_waitcnt lgkmcnt(" #n ")" ::: "memory")
#define PG8_BAR __builtin_amdgcn_s_barrier()
#define PG8_SCHED __builtin_amdgcn_sched_barrier(0)
    Unit cur, nxt; int ui = 0;
    if (!S.next(0, cur)) return;
    f32x4 acc[2][2][4][2];
#pragma unroll
    for (int a = 0; a < 2; ++a)
#pragma unroll
        for (int b = 0; b < 2; ++b)
#pragma unroll
            for (int m = 0; m < 4; ++m)
#pragma unroll
                for (int n = 0; n < 2; ++n) acc[a][b][m][n] = (f32x4){0.f, 0.f, 0.f, 0.f};
    bf16x8 At[4][2], B0[2][2], B1[2][2]; i32x8 At8[4], B08[2], B18[2];
    const char* cA = (const char*)g.A + (size_t)cur.pm * tstep; const char* cB = (const char*)g.Bt + (size_t)cur.pn * tstep;
    S.a_ready(cur);
    if constexpr (SP2) {
        PG8_STAGE(PG8_SB(0, 0), cB, voffB); PG8_STAGE(PG8_SB(0, 1), cB + hstep, voffB); PG8_STAGE(PG8_SA(0, 0), cA, voffA); PG8_STAGE(PG8_SA(0, 1), cA + hstep, voffA);
        PG8_STAGE(PG8_SB(1, 0), cB + kstep, voffB); PG8_STAGE(PG8_SA(1, 0), cA + kstep, voffA); PG8_STAGE(PG8_SB(1, 1), cB + hstep + kstep, voffB);
        if (wr == 1) PG8_BAR;
        PG8_WAIT_V(8); PG8_BAR;
        PG8_WAIT_V(6); PG8_BAR;
    } else {
        PG8_STAGE(PG8_SB(0, 0), cB, voffB); PG8_STAGE(PG8_SA(0, 0), cA, voffA); PG8_STAGE(PG8_SB(0, 1), cB + hstep, voffB); PG8_STAGE(PG8_SA(0, 1), cA + hstep, voffA);
        if (wr == 1) PG8_BAR;
        PG8_WAIT_V(4); PG8_BAR;
        PG8_STAGE(PG8_SB(1, 0), cB + kstep, voffB); PG8_STAGE(PG8_SA(1, 0), cA + kstep, voffA); PG8_STAGE(PG8_SB(1, 1), cB + hstep + kstep, voffB);
        PG8_WAIT_V(6); PG8_BAR;
    }
    for (;;) {
        const bool has_next = S.next(ui + 1, nxt);
        const char* nA = has_next ? (const char*)g.A + (size_t)nxt.pm * tstep : cA; const char* nB = has_next ? (const char*)g.Bt + (size_t)nxt.pn * tstep : cB;
        for (int t = 0; t < nt; t += 2) {
            const bool last = (t == nt - 2);
            const char* a1 = cA + (size_t)(t + 1) * kstep;
            const char* a2 = last ? nA : cA + (size_t)(t + 2) * kstep; const char* b2 = last ? nB : cB + (size_t)(t + 2) * kstep;
            const char* a3 = a2 + kstep; const char* b3 = b2 + kstep;
            if (last && has_next) S.a_ready(nxt);
            if constexpr (SP2) {
            PG8_LDB(B0, 0, 0); PG8_LDB(B1, 0, 1); PG8_SCHED; PG8_LDA(At, 0, 0); PG8_STAGE(PG8_SA(1, 1), a1 + hstep, voffA);
            PG8_WAIT_V(8); PG8_WAIT_L(0); PG8_BAR; PG8_MMA(0, 0, At, B0); PG8_MMA(0, 1, At, B1); PG8_BAR; PG8_SCHED;
            PG8_LDA(At, 0, 1); PG8_STAGE(PG8_SB(0, 0), b2, voffB); PG8_STAGE(PG8_SB(0, 1), b2 + hstep, voffB); PG8_STAGE(PG8_SA(0, 0), a2, voffA);
            PG8_WAIT_V(8); PG8_WAIT_L(0); PG8_BAR; PG8_MMA(1, 0, At, B0); PG8_MMA(1, 1, At, B1); PG8_BAR; PG8_SCHED;
            PG8_LDB(B0, 1, 0); PG8_LDB(B1, 1, 1); PG8_SCHED; PG8_LDA(At, 1, 0); PG8_STAGE(PG8_SA(0, 1), a2 + hstep, voffA);
            PG8_WAIT_V(8); PG8_WAIT_L(0); PG8_BAR; PG8_MMA(0, 0, At, B0); PG8_MMA(0, 1, At, B1); PG8_BAR; PG8_SCHED;
            PG8_LDA(At, 1, 1); PG8_STAGE(PG8_SB(1, 0), b3, voffB); PG8_STAGE(PG8_SB(1, 1), b3 + hstep, voffB); PG8_STAGE(PG8_SA(1, 0), a3, voffA);
            PG8_WAIT_V(8); PG8_WAIT_L(0); PG8_BAR; PG8_MMA(1, 0, At, B0); PG8_MMA(1, 1, At, B1); PG8_BAR; PG8_SCHED;
            } else {
            PG8_LDB(B0, 0, 0); PG8_SCHED; PG8_LDA(At, 0, 0); PG8_STAGE(PG8_SA(1, 1), a1 + hstep, voffA);
            PG8_WAIT_L(8); PG8_BAR; PG8_WAIT_L(0); PG8_MMA(0, 0, At, B0); PG8_BAR; PG8_SCHED;
            PG8_LDB(B1, 0, 1); PG8_STAGE(PG8_SB(0, 0), b2, voffB);
            PG8_BAR; PG8_WAIT_L(0); PG8_MMA(0, 1, At, B1); PG8_BAR;
            PG8_LDA(At, 0, 1); PG8_STAGE(PG8_SA(0, 0), a2, voffA);
            PG8_BAR; PG8_WAIT_L(0); PG8_MMA(1, 0, At, B0); PG8_BAR; PG8_SCHED;
            PG8_STAGE(PG8_SB(0, 1), b2 + hstep, voffB);
            PG8_WAIT_V(6); PG8_BAR; PG8_MMA(1, 1, At, B1); PG8_BAR;
            PG8_LDB(B0, 1, 0); PG8_SCHED; PG8_LDA(At, 1, 0); PG8_STAGE(PG8_SA(0, 1), a2 + hstep, voffA);
            PG8_WAIT_L(8); PG8_BAR; PG8_WAIT_L(0); PG8_MMA(0, 0, At, B0); PG8_BAR; PG8_SCHED;
            PG8_LDB(B1, 1, 1); PG8_STAGE(PG8_SB(1, 0), b3, voffB);
            PG8_BAR; PG8_WAIT_L(0); PG8_MMA(0, 1, At, B1); PG8_BAR;
            PG8_LDA(At, 1, 1); PG8_STAGE(PG8_SA(1, 0), a3, voffA);
            PG8_BAR; PG8_WAIT_L(0); PG8_MMA(1, 0, At, B0); PG8_BAR; PG8_SCHED;
            PG8_STAGE(PG8_SB(1, 1), b3 + hstep, voffB);
            PG8_WAIT_V(6); PG8_BAR; PG8_MMA(1, 1, At, B1); PG8_BAR;
            }
        }
        if constexpr (F8 != 0) asm volatile("s_nop 15\n\ts_nop 7" ::: "memory");
        if constexpr (ALIGN_EPI) { if (wr == 0) PG8_BAR; }
        if constexpr (!Epi::AFTER_DRAIN) { E(acc, cur, wr, wc, fr, fq); S.done(cur); }
        if (!has_next) break;
#pragma unroll
        for (int a = 0; a < 2; ++a)
#pragma unroll
            for (int b = 0; b < 2; ++b)
#pragma unroll
                for (int m = 0; m < 4; ++m)
#pragma unroll
                    for (int n = 0; n < 2; ++n) acc[a][b][m][n] = (f32x4){0.f, 0.f, 0.f, 0.f};
        cur = nxt; cA = nA; cB = nB; ++ui;
        if constexpr (ALIGN_EPI) { if (wr == 1) PG8_BAR; }
    }
    PG8_WAIT_V(0);
    if constexpr (!ALIGN_EPI) { if (wr == 0) PG8_BAR; }
    PG8_BAR;
    if constexpr (Epi::AFTER_DRAIN) { E.fused(acc, cur, wr, wc, fr, fq, lds, wid, lane); S.done(cur); }
#undef PG8_SA
#undef PG8_SB
#undef PG8_STAGE
#undef PG8_LDA
#undef PG8_LDB
#undef PG8_MMA
#undef PG8_WAIT_V
#undef PG8_WAIT_L
#undef PG8_BAR
#undef PG8_SCHED
}
}

#include <hip/hip_bf16.h>
#include <cmath>
namespace attn_body {
using bf16=__hip_bfloat16;
using bf16x8=__attribute__((ext_vector_type(8)))short;
using s16x4=__attribute__((ext_vector_type(4)))short;
using f32x16=__attribute__((ext_vector_type(16)))float;
using u32x4=__attribute__((ext_vector_type(4)))unsigned;
constexpr int SEQ=8192,D=64;
constexpr int NW=8,QBLK=32,QB=QBLK*NW,KVBLK=64;
constexpr int ATTN_UNIT_ROWS=QB;
__device__ __forceinline__ int crow(int r,int hi){return (r&3)+8*(r>>2)+4*hi;}
#define SBAR() __builtin_amdgcn_sched_barrier(0)
__device__ __forceinline__ void cmask(f32x16&p0,f32x16&p1,int jb,int qrel,int hi){
  const float NEG=-INFINITY; int kb=64*jb+4*hi;
  #pragma unroll
  for(int r=0;r<16;++r){int kv=kb+(r&3)+8*(r>>2); if(kv>qrel)p0[r]=NEG; if(kv+32>qrel)p1[r]=NEG;}
}

constexpr int NSLOT=3, SLOTB=8192;
constexpr int LDS_K=0, LDS_V=NSLOT*SLOTB, LDS_WS=2*NSLOT*SLOTB, LDS_OST=LDS_WS+NW*64*4, LDS_BYTES=LDS_OST+NW*4096;
typedef float f32x4_t __attribute__((ext_vector_type(4)));
constexpr int LDS_TB=LDS_BYTES;
constexpr int TBN=776;
template<int MODE> __device__ __forceinline__ void wmask(f32x16&p0,f32x16&p1,const __attribute__((address_space(3))) float*tp){
  if constexpr(MODE==1){
    #pragma unroll
    for(int j=0;j<4;++j){ const f32x4_t a=*(const __attribute__((address_space(3))) f32x4_t*)(tp+8*j), b=*(const __attribute__((address_space(3))) f32x4_t*)(tp+8*j+32);
      #pragma unroll
      for(int i=0;i<4;++i){ p0[4*j+i]+=a[i]; p1[4*j+i]+=b[i]; } } }
}
constexpr float C2=0.125f*1.4426950408889634f;
__device__ __forceinline__ void glds16(const void*gsrc,unsigned lds_dst){unsigned keep;
  asm volatile("s_mov_b32 %0, m0\n\ts_mov_b32 m0, %2\n\ts_nop 0\n\tglobal_load_lds_dwordx4 %1, off\n\ts_mov_b32 m0, %0":"=&s"(keep):"v"(gsrc),"s"(lds_dst):"memory");}
__device__ __forceinline__ float max3f(float a,float b,float c){float r;asm("v_max3_f32 %0, %1, %2, %3":"=v"(r):"v"(a),"v"(b),"v"(c));return r;}
__device__ __forceinline__ float max2f(float a,float b){float r;asm("v_max_f32_e32 %0, %1, %2":"=v"(r):"v"(a),"v"(b));return r;}
__device__ __forceinline__ float fadd_s(float a,float b){float r;asm("v_add_f32_e32 %0, %1, %2":"=v"(r):"v"(a),"v"(b));return r;}
__device__ __forceinline__ float fsub_s(float a,float b){float r;asm("v_sub_f32_e32 %0, %1, %2":"=v"(r):"v"(a),"v"(b));return r;}
typedef float f32x2_t __attribute__((ext_vector_type(2))); typedef __bf16 bf16x2_t __attribute__((ext_vector_type(2)));
__device__ __forceinline__ unsigned cvtpk_s(float lo,float hi){f32x2_t v={lo,hi};bf16x2_t b=__builtin_convertvector(v,bf16x2_t);return __builtin_bit_cast(unsigned,b);}
#define WAIT_BAR(N) asm volatile("s_waitcnt vmcnt(" #N ") lgkmcnt(0)\n\ts_barrier":::"memory")

__device__ __forceinline__ void qkt(f32x16&p0,f32x16&p1,const char*Kslot,const bf16x8*qr,const f32x16&negm,int r32,int hi){
  const char*kb=Kslot+hi*1024+r32*16;
  #pragma unroll
  for(int d0=0;d0<4;++d0){
    const bf16x8 b0=*reinterpret_cast<const bf16x8*>(kb+d0*2048);
    const bf16x8 b1=*reinterpret_cast<const bf16x8*>(kb+d0*2048+512);
    if(d0==0){p0=__builtin_amdgcn_mfma_f32_32x32x16_bf16(b0,qr[0],negm,0,0,0);p1=__builtin_amdgcn_mfma_f32_32x32x16_bf16(b1,qr[0],negm,0,0,0);}
    else{p0=__builtin_amdgcn_mfma_f32_32x32x16_bf16(b0,qr[d0],p0,0,0,0);p1=__builtin_amdgcn_mfma_f32_32x32x16_bf16(b1,qr[d0],p1,0,0,0);}}
}
typedef __attribute__((address_space(3))) const char* lds_cptr;
typedef short v4i16_t __attribute__((ext_vector_type(4)));
__device__ __forceinline__ void kload8(bf16x8*kf,lds_cptr kp){
  kf[0]=*(const __attribute__((address_space(3))) bf16x8*)(kp);      kf[1]=*(const __attribute__((address_space(3))) bf16x8*)(kp+512);
  kf[2]=*(const __attribute__((address_space(3))) bf16x8*)(kp+2048); kf[3]=*(const __attribute__((address_space(3))) bf16x8*)(kp+2560);
  kf[4]=*(const __attribute__((address_space(3))) bf16x8*)(kp+4096); kf[5]=*(const __attribute__((address_space(3))) bf16x8*)(kp+4608);
  kf[6]=*(const __attribute__((address_space(3))) bf16x8*)(kp+6144); kf[7]=*(const __attribute__((address_space(3))) bf16x8*)(kp+6656);
}
__device__ __forceinline__ void kload2(bf16x8*kf,lds_cptr kp,int j){ kf[2*j]=*(const __attribute__((address_space(3))) bf16x8*)(kp+j*2048); kf[2*j+1]=*(const __attribute__((address_space(3))) bf16x8*)(kp+j*2048+512); }
__device__ __forceinline__ s16x4 vtr(lds_cptr p){ return __builtin_bit_cast(s16x4,__builtin_amdgcn_ds_read_tr16_b64_v4i16((__attribute__((address_space(3))) v4i16_t*)p)); }
__device__ __forceinline__ float rowmax(const f32x16&p0,const f32x16&p1){
  float a=max3f(p0[0],p0[1],p1[0]),b=max3f(p0[2],p0[3],p1[1]);a=max3f(a,p1[2],p1[3]);
  #pragma unroll
  for(int r=4;r<16;r+=4){a=max3f(a,p0[r],p0[r+1]);b=max3f(b,p0[r+2],p0[r+3]);a=max3f(a,p1[r],p1[r+1]);b=max3f(b,p1[r+2],p1[r+3]);}
  const float m=max2f(a,b);
  auto rr=__builtin_amdgcn_permlane32_swap(__float_as_uint(m),__float_as_uint(m),false,false);
  return max2f(__uint_as_float(rr[0]),__uint_as_float(rr[1]));
}
__device__ __forceinline__ void pv(f32x16*o,int vb,bf16x8 pa0,bf16x8 pa1,bf16x8 pa2,bf16x8 pa3){
  #pragma unroll
  for(int d0=0;d0<2;++d0){s16x4 lo[4],hi[4];
    #pragma unroll
    for(int ks=0;ks<4;++ks){
      asm volatile("ds_read_b64_tr_b16 %0,%1 offset:%c2":"=&v"(lo[ks]):"v"(vb),"i"(d0*4096+ks*1024):"memory");
      asm volatile("ds_read_b64_tr_b16 %0,%1 offset:%c2":"=&v"(hi[ks]):"v"(vb),"i"(d0*4096+ks*1024+512):"memory");}
    asm volatile("s_waitcnt lgkmcnt(0)":::"memory");SBAR();
    #define PK(k) (bf16x8){lo[k][0],lo[k][1],lo[k][2],lo[k][3],hi[k][0],hi[k][1],hi[k][2],hi[k][3]}
    o[d0]=__builtin_amdgcn_mfma_f32_32x32x16_bf16(pa0,PK(0),o[d0],0,0,0);
    o[d0]=__builtin_amdgcn_mfma_f32_32x32x16_bf16(pa1,PK(1),o[d0],0,0,0);
    o[d0]=__builtin_amdgcn_mfma_f32_32x32x16_bf16(pa2,PK(2),o[d0],0,0,0);
    o[d0]=__builtin_amdgcn_mfma_f32_32x32x16_bf16(pa3,PK(3),o[d0],0,0,0);
    #undef PK
  }
}

#ifndef ATTN_STORE16
#define ATTN_STORE16(p,v) (*(u32x4*)(p)=(v))
#endif
template<int THRL,int QP,int KP,int OP,int MODE,bool PART=false> __device__ __forceinline__ void attn_unit(int q0,int NT,const bf16*Qh,const bf16*__restrict__ Kh,const bf16*__restrict__ Vh,bf16*Oh,char*shm,const float*tbg=nullptr,float sink2=0.f,int kb0=0,float*Po=nullptr,float*Pml=nullptr){
  int tid_l=threadIdx.x; asm volatile("":"+v"(tid_l)); const int tid=tid_l,lane=tid&63,r32=lane&31,hi=lane>>5; const int wid=__builtin_amdgcn_readfirstlane(tid>>6);
  __attribute__((address_space(3))) float* tblL=(__attribute__((address_space(3))) float*)((__attribute__((address_space(3))) char*)shm+LDS_TB);
  if constexpr(MODE==1){
    #pragma unroll 1
    for(int idx=tid;idx<4*TBN;idx+=512){ const int kc=idx/TBN, j=idx-kc*TBN, src=j+kc-256; tblL[idx]=(src>=0&&src<=256)?tbg[src]:-INFINITY; } }

  const bf16*Qw=Qh+(long)(q0+wid*QBLK)*QP;

  const unsigned lds0=(unsigned)(uintptr_t)shm;
  float*wsf=(float*)(shm+LDS_WS)+wid*64;
  const bf16*ksrc=Kh+(long)lane*KP+wid*8;
  const bf16*vsrc=Vh+(long)(16*(wid&3)+(lane>>2))*KP+(wid>>2)*32+(lane&3)*8;
  const unsigned kdst=lds0+LDS_K+wid*1024, vdst=lds0+LDS_V+wid*1024;
  #define DMA_K(t,slot) glds16(ksrc+(long)(t)*KVBLK*KP,(unsigned)__builtin_amdgcn_readfirstlane(kdst+(slot)))
  #define DMA_V(t,slot) glds16(vsrc+(long)(t)*KVBLK*KP,(unsigned)__builtin_amdgcn_readfirstlane(vdst+(slot)))
  const int vb0=(int)(lds0+LDS_V)+((lane>>4)&1)*32+(lane&3)*8+(4*hi+((lane&15)>>2))*64;
  const char*Kbase=shm+LDS_K; bf16x8 kf[8];
  const lds_cptr shm3=(lds_cptr)shm; const lds_cptr kp0=shm3+LDS_K+hi*1024+r32*16; const lds_cptr vp0=shm3+LDS_V+((lane>>4)&1)*32+(lane&3)*8+(4*hi+((lane&15)>>2))*64;

  DMA_K(0,0);DMA_V(0,0);DMA_K(1,SLOTB);
  bf16x8 qr[4];
  #pragma unroll
  for(int d0=0;d0<4;++d0)qr[d0]=*reinterpret_cast<const bf16x8*>(&Qw[(long)r32*QP+d0*16+hi*8]);
  float mhat=0.f;f32x4_t lacc={0.f,0.f,0.f,0.f};f32x16 o[2];
  bf16x8 onesA; { const short ov=((lane&3)==0&&(((lane>>2)&1)==((lane>>4)&1)))?(short)0x3F80:(short)0; onesA=(bf16x8){ov,ov,ov,ov,ov,ov,ov,ov}; } asm volatile("":"+v"(onesA));o[0]=f32x16{};o[1]=f32x16{};f32x16 negm=f32x16{};asm volatile("":"+v"(negm));
  const int qrel=wid*QBLK+r32; const int qabs=q0+qrel;
  const int tb_base=kb0+4*hi-qabs+384, tb_k=tb_base&3;
  const __attribute__((address_space(3))) float*tp0=tblL+tb_k*TBN+(tb_base-tb_k);
  #define CMASK(P0,P1,t) wmask<MODE>(P0,P1,tp0+(t)*64)
  bool resc=false;
  #define START(P0,P1) do{ float rm=rowmax(P0,P1); if constexpr(MODE==1) rm=__builtin_fmaxf(rm,sink2); resc=false; \
    { const float dl=rm; mhat=fadd_s(mhat,dl); \
      _Pragma("unroll") for(int r=0;r<16;++r){P0[r]=fsub_s(P0[r],dl);P1[r]=fsub_s(P1[r],dl);} \
      _Pragma("unroll") for(int r=0;r<16;++r)negm[r]=-mhat; asm volatile("":"+v"(negm)); } \
    _Pragma("unroll") for(int r=0;r<16;++r)P0[r]=__builtin_amdgcn_exp2f(P0[r]); }while(0)
  #define RESC() do{ if(resc){ asm volatile("s_waitcnt lgkmcnt(0)":::"memory"); \
      _Pragma("unroll") for(int d_=0;d_<2;++d_) _Pragma("unroll") for(int r=0;r<16;++r)o[d_][r]*=wsf[crow(r,hi)]; } }while(0)
  f32x16 pA0,pA1,pB0,pB1;
  int sl_prev=0,sl_cur=0,sl_next=SLOTB;
  #define ROT() do{sl_prev=sl_cur;sl_cur=sl_next;sl_next=(sl_next==(NSLOT-1)*SLOTB)?0:sl_next+SLOTB;}while(0)
  DMA_K(2,2*SLOTB);
  WAIT_BAR(3);
  qkt(pA0,pA1,Kbase,qr,negm,r32,hi);asm volatile("s_nop 15\n\ts_nop 7":"+v"(pA0),"+v"(pA1));CMASK(pA0,pA1,0);
  START(pA0,pA1);
  _Pragma("unroll") for(int r=0;r<16;++r)pA1[r]=__builtin_amdgcn_exp2f(pA1[r]);
  WAIT_BAR(0);
  DMA_K(3,0);DMA_V(1,SLOTB);
  ROT();
  kload8(kf,kp0+sl_cur);
  WAIT_BAR(2);
  s16x4 vlo[8],vhi[8]; u32x4 pw0,pw1,pw2,pw3;
  #define PKW(P,B) cvtpk_s(P[B],P[B+1])
  #define PAF(k) __builtin_bit_cast(bf16x8,pw##k)
  #define VFR(i) (bf16x8){vlo[i][0],vlo[i][1],vlo[i][2],vlo[i][3],vhi[i][0],vhi[i][1],vhi[i][2],vhi[i][3]}
  #define PIN(x) asm volatile("":"+v"(x))
  #define MX3(a,b,c) __builtin_fmaxf(__builtin_fmaxf((a),(b)),(c))
  #define GAPA(MF,SM,W0,W1,PW) do{ MF; W0; W1; PIN(PW); SM; SBAR(); }while(0)
  #define LSUM(k) lacc=__builtin_amdgcn_mfma_f32_16x16x32_bf16(onesA,PAF(k),lacc,0,0,0)
  #define EX(v) __builtin_amdgcn_exp2f(v)
  #define GAPB(MF,X,B) do{ MF; X[B]=EX(X[B]); X[B+1]=EX(X[B+1]); X[B+2]=EX(X[B+2]); X[B+3]=EX(X[B+3]); PIN(X); SBAR(); }while(0)
  #define VRD(i) do{ vlo[i]=vtr(vp_+(((i)>>2)*4096+((i)&3)*1024)); vhi[i]=vtr(vp_+(((i)>>2)*4096+((i)&3)*1024+512)); }while(0)
  #define KRD(G,j) do{ if(G){ kload2(kf,kp0+sl_next,j); SBAR(); } }while(0)
  #define STEP(C0,C1,P0,P1,t,GK,GV,GL) do{ SBAR(); \
    const lds_cptr vp_=vp0+sl_prev; \
    VRD(0); SBAR(); \
    GAPA(C0=__builtin_amdgcn_mfma_f32_32x32x16_bf16(kf[0],qr[0],negm,0,0,0), (void)0, pw0[0]=PKW(P0,0), pw0[1]=PKW(P0,2), pw0); \
    VRD(4); SBAR(); GAPA(C1=__builtin_amdgcn_mfma_f32_32x32x16_bf16(kf[1],qr[0],negm,0,0,0), (void)0, pw0[2]=PKW(P0,4), pw0[3]=PKW(P0,6), pw0); \
    VRD(1); SBAR(); GAPA(C0=__builtin_amdgcn_mfma_f32_32x32x16_bf16(kf[2],qr[1],C0,0,0,0),   LSUM(0), pw1[0]=PKW(P0,8), pw1[1]=PKW(P0,10), pw1); \
    VRD(5); SBAR(); GAPA(C1=__builtin_amdgcn_mfma_f32_32x32x16_bf16(kf[3],qr[1],C1,0,0,0),   (void)0, pw1[2]=PKW(P0,12),pw1[3]=PKW(P0,14), pw1); \
    VRD(2); SBAR(); GAPA(C0=__builtin_amdgcn_mfma_f32_32x32x16_bf16(kf[4],qr[2],C0,0,0,0),   LSUM(1), pw2[0]=PKW(P1,0), pw2[1]=PKW(P1,2), pw2); \
    VRD(6); SBAR(); GAPA(C1=__builtin_amdgcn_mfma_f32_32x32x16_bf16(kf[5],qr[2],C1,0,0,0),   (void)0, pw2[2]=PKW(P1,4), pw2[3]=PKW(P1,6), pw2); \
    VRD(3); SBAR(); GAPA(C0=__builtin_amdgcn_mfma_f32_32x32x16_bf16(kf[6],qr[3],C0,0,0,0),   LSUM(2), pw3[0]=PKW(P1,8), pw3[1]=PKW(P1,10), pw3); \
    VRD(7); SBAR(); GAPA(C1=__builtin_amdgcn_mfma_f32_32x32x16_bf16(kf[7],qr[3],C1,0,0,0),   (void)0, pw3[2]=PKW(P1,12),pw3[3]=PKW(P1,14), pw3); \
    LSUM(3); SBAR(); \
    if(GK){DMA_K((t)+3,sl_cur);} if(GV){DMA_V((t)+1,sl_next);} \
    CMASK(C0,C1,t); \
    { float a=MX3(C0[0],C0[1],C1[0]),b=MX3(C0[2],C0[3],C1[1]); a=MX3(a,C1[2],C1[3]); \
      _Pragma("unroll") for(int r=4;r<16;r+=4){a=MX3(a,C0[r],C0[r+1]);b=MX3(b,C0[r+2],C0[r+3]);a=MX3(a,C1[r],C1[r+1]);b=MX3(b,C1[r+2],C1[r+3]);} \
      float rm=__builtin_fmaxf(a,b); { auto rr=__builtin_amdgcn_permlane32_swap(__float_as_uint(rm),__float_as_uint(rm),false,false); rm=__builtin_fmaxf(__uint_as_float(rr[0]),__uint_as_float(rr[1])); } \
      resc=false; \
      if(__builtin_expect(__any(rm>(float)THRL),0)){ const float dl=__builtin_fmaxf(rm,0.f); mhat+=dl; \
        _Pragma("unroll") for(int r=0;r<16;++r){C0[r]-=dl;C1[r]-=dl;} \
        _Pragma("unroll") for(int r=0;r<16;++r)negm[r]=-mhat; asm volatile("":"+v"(negm)); \
        const float f=__builtin_amdgcn_exp2f(-dl); lacc[0]*=f; if(hi==0)wsf[r32]=f; resc=true; } } \
    SBAR(); \
    GAPB(o[0]=__builtin_amdgcn_mfma_f32_32x32x16_bf16(PAF(0),VFR(0),o[0],0,0,0), C0,0); \
    GAPB(o[1]=__builtin_amdgcn_mfma_f32_32x32x16_bf16(PAF(0),VFR(4),o[1],0,0,0), C0,4); \
    KRD(GL,0); GAPB(o[0]=__builtin_amdgcn_mfma_f32_32x32x16_bf16(PAF(1),VFR(1),o[0],0,0,0), C0,8); \
    KRD(GL,1); GAPB(o[1]=__builtin_amdgcn_mfma_f32_32x32x16_bf16(PAF(1),VFR(5),o[1],0,0,0), C0,12); \
    KRD(GL,2); GAPB(o[0]=__builtin_amdgcn_mfma_f32_32x32x16_bf16(PAF(2),VFR(2),o[0],0,0,0), C1,0); \
    KRD(GL,3); GAPB(o[1]=__builtin_amdgcn_mfma_f32_32x32x16_bf16(PAF(2),VFR(6),o[1],0,0,0), C1,4); \
    GAPB(o[0]=__builtin_amdgcn_mfma_f32_32x32x16_bf16(PAF(3),VFR(3),o[0],0,0,0), C1,8); \
    GAPB(o[1]=__builtin_amdgcn_mfma_f32_32x32x16_bf16(PAF(3),VFR(7),o[1],0,0,0), C1,12); \
    }while(0)
  int t=1;
  #undef CMASK
  #define CMASK(P0,P1,t) wmask<MODE>(P0,P1,tp0+(t)*64)
  for(;t+5<NT;t+=2){
    STEP(pB0,pB1,pA0,pA1,t,true,true,true);     WAIT_BAR(2); RESC(); ROT();
    STEP(pA0,pA1,pB0,pB1,t+1,true,true,true);   WAIT_BAR(2); RESC(); ROT();
  }
  #undef CMASK
  #define CMASK(P0,P1,t) wmask<MODE>(P0,P1,tp0+(t)*64)
  #define ENDW(tt) do{ if((tt)+3<NT){WAIT_BAR(2);} else if((tt)+2<NT){WAIT_BAR(1);} else {WAIT_BAR(0);} }while(0)
  for(;t+1<NT;t+=2){
    STEP(pB0,pB1,pA0,pA1,t,(t+3<NT),(t+1<NT),(t+1<NT));       ENDW(t);   RESC(); ROT();
    STEP(pA0,pA1,pB0,pB1,t+1,(t+4<NT),(t+2<NT),(t+2<NT));     ENDW(t+1); RESC(); ROT();
  }
  STEP(pB0,pB1,pA0,pA1,NT-1,false,false,false); RESC();
  {
    pw0=(u32x4){PKW(pB0,0),PKW(pB0,2),PKW(pB0,4),PKW(pB0,6)};pw1=(u32x4){PKW(pB0,8),PKW(pB0,10),PKW(pB0,12),PKW(pB0,14)};pw2=(u32x4){PKW(pB1,0),PKW(pB1,2),PKW(pB1,4),PKW(pB1,6)};pw3=(u32x4){PKW(pB1,8),PKW(pB1,10),PKW(pB1,12),PKW(pB1,14)};
    LSUM(0); LSUM(1); LSUM(2); LSUM(3);
    SBAR(); pv(o,vb0+sl_cur,PAF(0),PAF(1),PAF(2),PAF(3)); }
  #undef PKW
  #undef PAF
  #undef VFR
  #undef PIN
  #undef MX3
  #undef GAPA
  #undef LSUM
  #undef GAPB
  #undef EX
  #undef VRD
  #undef KRD
  #undef STEP
  #undef ENDW
  float l_reg=lacc[0];
  if constexpr(MODE==1) l_reg+=__builtin_amdgcn_exp2f(sink2-mhat);
  if constexpr(PART){
    if(hi==0){ Pml[(wid*QBLK+r32)*2]=mhat; Pml[(wid*QBLK+r32)*2+1]=l_reg; }
    float*Pw=Po+(long)(wid*QBLK)*64+r32;
    #pragma unroll
    for(int r=0;r<16;++r){ Pw[crow(r,hi)*64]=o[0][r]; Pw[crow(r,hi)*64+32]=o[1][r]; }
  } else {
  if(hi==0)wsf[32+r32]=l_reg;asm volatile("s_waitcnt lgkmcnt(0)":::"memory");
  float rli[16];
  #pragma unroll
  for(int r=0;r<16;++r)rli[r]=__builtin_amdgcn_rcpf(wsf[32+crow(r,hi)]);
  bf16*Ow=Oh+(long)(q0+wid*QBLK)*OP;
  { bf16*stg=(bf16*)(shm+LDS_OST)+wid*2048;
    #pragma unroll
    for(int r=0;r<16;++r){const int orow=crow(r,hi);
      #pragma unroll
      for(int d0=0;d0<2;++d0)stg[orow*64+d0*32+r32]=__float2bfloat16(o[d0][r]*rli[r]);}
    asm volatile("s_waitcnt lgkmcnt(0)":::"memory");
    #pragma unroll
    for(int i=0;i<4;++i){const int row=i*8+(lane>>3),ch=lane&7; const u32x4 v=*(const u32x4*)(stg+row*64+ch*8); ATTN_STORE16(Ow+(long)row*OP+ch*8,v);} }
  }
  asm volatile("s_waitcnt lgkmcnt(0)\n\ts_barrier":::"memory");
  #undef DMA_K
  #undef DMA_V
  #undef CMASK
  #undef START
  #undef RESC
  #undef ROT
}
constexpr int ATTN_LDS_BYTES=LDS_BYTES+4*TBN*4;
#undef SBAR
#undef WAIT_BAR
}

namespace hg {
typedef short s16x4 __attribute__((ext_vector_type(4)));
typedef short s16x8 __attribute__((ext_vector_type(8)));
typedef float f32x4 __attribute__((ext_vector_type(4)));
typedef unsigned u32x4 __attribute__((ext_vector_type(4)));
typedef unsigned u32x2 __attribute__((ext_vector_type(2)));
#define HG_LAS __attribute__((address_space(3)))
constexpr int T = 8192, SEG = 128, NSEG = 64, HW = 512;
constexpr int PV = 272;
typedef float f32x2_t __attribute__((ext_vector_type(2))); typedef __bf16 bf16x2_t __attribute__((ext_vector_type(2)));
__device__ __forceinline__ unsigned pk(float lo, float hi) { f32x2_t v = {lo, hi}; bf16x2_t b = __builtin_convertvector(v, bf16x2_t); return __builtin_bit_cast(unsigned, b); }
#define HG_DPP_ADD(v, ctrl) v += __builtin_bit_cast(float, __builtin_amdgcn_update_dpp(0, __builtin_bit_cast(int, v), ctrl, 0xF, 0xF, true))
__device__ __forceinline__ float row16_sum(float v) { HG_DPP_ADD(v, 0xB1); HG_DPP_ADD(v, 0x4E); HG_DPP_ADD(v, 0x124); HG_DPP_ADD(v, 0x128); return v; }

__device__ __forceinline__ void pass1(int G, int bid, const _Float16* FF, const _Float16* FB, const unsigned short* BI, unsigned short* P, float* Dg, HG_LAS unsigned char* lds) {
    int tid_l = threadIdx.x; asm volatile("" : "+v"(tid_l));
    const int tid = tid_l, lane = tid & 63, w = __builtin_amdgcn_readfirstlane(tid >> 6), l16 = lane & 15, g = lane >> 4, c = tid & 127, qt = tid >> 7;
    constexpr int VT = 0, KT = 128 * PV, TQ = 3 * 128 * PV;
    for (int u = bid; u < 4 * NSEG; u += G) {
        const int h = u >> 6, seg = u & 63, tok0 = seg * SEG;
        const size_t ub = (size_t)tok0 * HW + h * 128; const int lo = 32 * qt * HW + c;
        unsigned vx[32]; float ff[32], fb[32];
        {
            const unsigned short* vb = BI + ub;
#pragma unroll
            for (int j = 0; j < 32; ++j) { vx[j] = (vb + j * HW)[lo]; ff[j] = (float)(FF + ub + j * HW)[lo]; fb[j] = (float)(FB + ub + j * HW)[lo]; }
        }
        {
#pragma unroll
            for (int jj = 0; jj < 4; ++jj) { u32x4 o; o.x = vx[8 * jj] | (vx[8 * jj + 1] << 16); o.y = vx[8 * jj + 2] | (vx[8 * jj + 3] << 16); o.z = vx[8 * jj + 4] | (vx[8 * jj + 5] << 16); o.w = vx[8 * jj + 6] | (vx[8 * jj + 7] << 16);
                *(HG_LAS u32x4*)(lds + VT + c * PV + (32 * qt + 8 * jj) * 2) = o; }
        }
        float kw0[32], kw1[32];
        {
            float run = 1.f;
#pragma unroll
            for (int j = 31; j >= 0; --j) { kw0[j] = (1.0f - ff[j]) * run; run *= ff[j]; }
            *(HG_LAS float*)(lds + TQ + (0 * 4 + qt) * 512 + c * 4) = run;
        }
        {
            float run = 1.f;
#pragma unroll
            for (int j = 0; j < 32; ++j) { kw1[j] = (1.0f - fb[j]) * run; run *= fb[j]; }
            *(HG_LAS float*)(lds + TQ + (1 * 4 + qt) * 512 + c * 4) = run;
        }
        __syncthreads();
        {
            float t0[4], t1[4];
#pragma unroll
            for (int q = 0; q < 4; ++q) { t0[q] = *(HG_LAS float*)(lds + TQ + (0 * 4 + q) * 512 + c * 4); t1[q] = *(HG_LAS float*)(lds + TQ + (1 * 4 + q) * 512 + c * 4); }
            float x0 = 1.f, x1 = 1.f;
#pragma unroll
            for (int q = 0; q < 4; ++q) { if (q > qt) x0 *= t0[q]; if (q < qt) x1 *= t1[q]; }
            if (qt == 0) { Dg[((size_t)(h * 2 + 0) * NSEG + seg) * 128 + c] = (t0[0] * t0[1]) * (t0[2] * t0[3]); Dg[((size_t)(h * 2 + 1) * NSEG + seg) * 128 + c] = (t1[0] * t1[1]) * (t1[2] * t1[3]); }
#pragma unroll
            for (int jj = 0; jj < 4; ++jj) { u32x4 o0, o1;
                o0.x = pk(kw0[8 * jj + 0] * x0, kw0[8 * jj + 1] * x0); o0.y = pk(kw0[8 * jj + 2] * x0, kw0[8 * jj + 3] * x0); o0.z = pk(kw0[8 * jj + 4] * x0, kw0[8 * jj + 5] * x0); o0.w = pk(kw0[8 * jj + 6] * x0, kw0[8 * jj + 7] * x0);
                o1.x = pk(kw1[8 * jj + 0] * x1, kw1[8 * jj + 1] * x1); o1.y = pk(kw1[8 * jj + 2] * x1, kw1[8 * jj + 3] * x1); o1.z = pk(kw1[8 * jj + 4] * x1, kw1[8 * jj + 5] * x1); o1.w = pk(kw1[8 * jj + 6] * x1, kw1[8 * jj + 7] * x1);
                *(HG_LAS u32x4*)(lds + KT + c * PV + (32 * qt + 8 * jj) * 2) = o0;
                *(HG_LAS u32x4*)(lds + KT + 128 * PV + c * PV + (32 * qt + 8 * jj) * 2) = o1; }
        }
        __syncthreads();
        {
            s16x8 bfr[4];
#pragma unroll
            for (int kk = 0; kk < 4; ++kk) bfr[kk] = *(const HG_LAS s16x8*)(lds + VT + (16 * w + l16) * PV + (32 * kk + 8 * g) * 2);
#pragma unroll
            for (int dir = 0; dir < 2; ++dir) {
                unsigned short* Pp = P + ((size_t)(h * 2 + dir) * NSEG + seg) * 16384 + (size_t)(16 * w) * 128; const int plo = l16 * 128 + 4 * g;
#pragma unroll
                for (int i = 0; i < 8; ++i) { f32x4 acc = (f32x4){0.f, 0.f, 0.f, 0.f};
#pragma unroll
                    for (int kk = 0; kk < 4; ++kk) { const s16x8 a = *(const HG_LAS s16x8*)(lds + KT + dir * 128 * PV + (16 * i + l16) * PV + (32 * kk + 8 * g) * 2);
                        acc = __builtin_amdgcn_mfma_f32_16x16x32_bf16(a, bfr[kk], acc, 0, 0, 0); }
                    { u32x2 o; o.x = pk(acc[0], acc[1]); o.y = pk(acc[2], acc[3]); *(u32x2*)(Pp + 16 * i + plo) = o; } }
            }
        }
        __syncthreads();
    }
}

__device__ __forceinline__ void scan(int G, int vcu, const unsigned short* P, const float* Dg, unsigned short* SS) {
    int tid_l = threadIdx.x; asm volatile("" : "+v"(tid_l));
    for (int e0 = vcu * 512; e0 < 8 * 16384; e0 += G * 512) {
        const int hd = e0 >> 14, dir = hd & 1, vc = (e0 & 16383) + tid_l, c = vc & 127;
        const int s0 = dir ? NSEG - 1 : 0, sd = dir ? -1 : 1;
        const unsigned short* Pb = P + ((size_t)hd * NSEG + s0) * 16384; const float* Db = Dg + ((size_t)hd * NSEG + s0) * 128; unsigned short* Sb = SS + ((size_t)hd * NSEG + s0) * 16384;
        float Sv = 0.f;
#pragma unroll 1
        for (int jb = 0; jb < NSEG; jb += 32) {
            unsigned p[32]; float d[32];
#pragma unroll
            for (int j = 0; j < 32; ++j) { p[j] = (Pb + (ptrdiff_t)((jb + j) * sd) * 16384)[vc]; d[j] = (Db + (ptrdiff_t)((jb + j) * sd) * 128)[c]; }
#pragma unroll
            for (int j = 0; j < 32; ++j) { (Sb + (ptrdiff_t)((jb + j) * sd) * 16384)[vc] = (unsigned short)(pk(Sv, 0.f) & 0xffffu); Sv = d[j] * Sv + __uint_as_float(p[j] << 16); }
        }
    }
}

__device__ __forceinline__ void pass2(int G, int bid, const unsigned short* BQ, const _Float16* FF, const _Float16* FB, const unsigned short* BI, const unsigned short* SGt, const unsigned short* SS,
                                      const float* gnw, unsigned short* MIX, HG_LAS unsigned char* lds) {
    int tid_l = threadIdx.x; asm volatile("" : "+v"(tid_l));
    const int tid = tid_l, lane = tid & 63, w = __builtin_amdgcn_readfirstlane(tid >> 6), l16 = lane & 15, g = lane >> 4, c = tid & 127, ch_t = tid >> 7;
    constexpr int VT = 0, QT = 128 * PV, KT = QT + 64 * PV, KPT = KT + 64 * PV, KPP = 144, DCH = KPT + 128 * KPP, NRM = DCH + 2048, RSTD = NRM + 4096;
    for (int u = bid; u < 4 * NSEG; u += G) {
        const int h = u >> 6, seg = u & 63, tok0 = seg * SEG;
        {
            const unsigned short* vb = BI + (size_t)tok0 * HW + h * 128; const int lo = 32 * ch_t * HW + c;
#pragma unroll
            for (int jj = 0; jj < 4; ++jj) { unsigned x[8];
#pragma unroll
                for (int j = 0; j < 8; ++j) x[j] = (vb + (8 * jj + j) * HW)[lo];
                u32x4 o; o.x = x[0] | (x[1] << 16); o.y = x[2] | (x[3] << 16); o.z = x[4] | (x[5] << 16); o.w = x[6] | (x[7] << 16);
                *(HG_LAS u32x4*)(lds + VT + c * PV + (32 * ch_t + 8 * jj) * 2) = o; }
        }
        f32x4 O[8];
#pragma unroll
        for (int i = 0; i < 8; ++i) O[i] = (f32x4){0.f, 0.f, 0.f, 0.f};
        float nf[16]; unsigned nq[16]; u32x2 sraw[8];
#define HG_LOAD_FQ(dir_, hh_) do { const _Float16* Fp_ = (dir_) ? FB : FF; const size_t ub_ = (size_t)(tok0 + 64 * (hh_)) * HW + h * 128; const int lo_ = 16 * ch_t * HW + c; \
            _Pragma("unroll") for (int j = 0; j < 16; ++j) { nf[j] = (float)(Fp_ + ub_ + j * HW)[lo_]; nq[j] = (BQ + ub_ + j * HW)[lo_]; } } while (0)
#define HG_LOAD_S(dir_) do { const unsigned short* sp_ = SS + ((size_t)(h * 2 + (dir_)) * NSEG + seg) * 16384 + (size_t)(16 * w) * 128 + l16 * 128 + 4 * g; \
            _Pragma("unroll") for (int i = 0; i < 8; ++i) sraw[i] = *(const u32x2*)(sp_ + 16 * i); } while (0)
        HG_LOAD_FQ(0, 0); HG_LOAD_S(0);
        f32x4 St[8];
#pragma unroll
        for (int st = 0; st < 4; ++st) {
            const int dir = st >> 1, hq = st & 1;
            {
                const int hh = dir ? 1 - hq : hq;
                if (hq == 0) {
#pragma unroll
                    for (int i = 0; i < 8; ++i) { St[i][0] = __uint_as_float(sraw[i].x << 16); St[i][1] = __uint_as_float(sraw[i].x & 0xffff0000u); St[i][2] = __uint_as_float(sraw[i].y << 16); St[i][3] = __uint_as_float(sraw[i].y & 0xffff0000u); } }
                {
                    float f[16], k[16], q[16];
#pragma unroll
                    for (int j = 0; j < 16; ++j) { f[j] = nf[j]; q[j] = __uint_as_float(nq[j] << 16); k[j] = 1.0f - f[j]; }
                    float kp[16]; float cum = 1.f, run = 1.f;
                    if (dir == 0) {
#pragma unroll
                        for (int j = 0; j < 16; ++j) { cum *= f[j]; q[j] *= cum; const float kk = k[j]; k[j] = kk * __builtin_amdgcn_rcpf(fmaxf(cum, 1e-30f)); kp[j] = kk; }
#pragma unroll
                        for (int j = 15; j >= 0; --j) { kp[j] *= run; run *= f[j]; }
                    } else {
#pragma unroll
                        for (int j = 15; j >= 0; --j) { cum *= f[j]; q[j] *= cum; const float kk = k[j]; k[j] = kk * __builtin_amdgcn_rcpf(fmaxf(cum, 1e-30f)); kp[j] = kk; }
#pragma unroll
                        for (int j = 0; j < 16; ++j) { kp[j] *= run; run *= f[j]; }
                    }
#pragma unroll
                    for (int j = 0; j < 16; ++j) { *(HG_LAS unsigned short*)(lds + QT + (16 * ch_t + j) * PV + c * 2) = (unsigned short)(pk(q[j], 0.f) & 0xffffu);
                                                   *(HG_LAS unsigned short*)(lds + KT + (16 * ch_t + j) * PV + c * 2) = (unsigned short)(pk(k[j], 0.f) & 0xffffu); }
                    u32x4 o0, o1; o0.x = pk(kp[0], kp[1]); o0.y = pk(kp[2], kp[3]); o0.z = pk(kp[4], kp[5]); o0.w = pk(kp[6], kp[7]); o1.x = pk(kp[8], kp[9]); o1.y = pk(kp[10], kp[11]); o1.z = pk(kp[12], kp[13]); o1.w = pk(kp[14], kp[15]);
                    *(HG_LAS u32x4*)(lds + KPT + c * KPP + (16 * ch_t) * 2) = o0; *(HG_LAS u32x4*)(lds + KPT + c * KPP + (16 * ch_t) * 2 + 16) = o1;
                    *(HG_LAS float*)(lds + DCH + ch_t * 512 + c * 4) = cum;
                }
                __syncthreads();
                if (st == 0) HG_LOAD_FQ(0, 1); else if (st == 1) { HG_LOAD_FQ(1, 1); HG_LOAD_S(1); } else if (st == 2) HG_LOAD_FQ(1, 0);
#pragma unroll
                for (int cq = 0; cq < 4; ++cq) {
                    const int ch = dir ? 3 - cq : cq, tr = 16 * ch, cg = 4 * hh + ch;
                    f32x4 at = (f32x4){0.f, 0.f, 0.f, 0.f};
                    s16x8 fa[4], fb4[4]; u32x2 qa[4], qb[4];
#pragma unroll
                    for (int m = 0; m < 4; ++m) { fa[m] = *(const HG_LAS s16x8*)(lds + KT + (tr + l16) * PV + (32 * m + 8 * g) * 2); fb4[m] = *(const HG_LAS s16x8*)(lds + QT + (tr + l16) * PV + (32 * m + 8 * g) * 2);
                        qa[m] = *(const HG_LAS u32x2*)(lds + QT + (tr + l16) * PV + (32 * m + 4 * g) * 2); qb[m] = *(const HG_LAS u32x2*)(lds + QT + (tr + l16) * PV + (32 * m + 16 + 4 * g) * 2); }
                    const u32x2 bv2 = *(const HG_LAS u32x2*)(lds + VT + (16 * w + l16) * PV + (64 * hh + tr + 4 * g) * 2);
#pragma unroll
                    for (int m = 0; m < 4; ++m) at = __builtin_amdgcn_mfma_f32_16x16x32_bf16(fa[m], fb4[m], at, 0, 0, 0);
#pragma unroll
                    for (int r = 0; r < 4; ++r) { const int s = 4 * g + r; const bool keep = dir ? (s >= l16) : (s <= l16); at[r] = keep ? at[r] : 0.f; }
                    u32x4 pa4; pa4.x = pk(at[0], at[1]); pa4.y = pk(at[2], at[3]); pa4.z = 0u; pa4.w = 0u; const s16x8 pa = __builtin_bit_cast(s16x8, pa4);
                    u32x4 bv4; bv4.x = bv2.x; bv4.y = bv2.y; bv4.z = 0u; bv4.w = 0u; const s16x8 bv = __builtin_bit_cast(s16x8, bv4);
                    f32x4 o = O[cg];
                    o = __builtin_amdgcn_mfma_f32_16x16x32_bf16(pa, bv, o, 0, 0, 0);
#pragma unroll
                    for (int m = 0; m < 4; ++m) { u32x4 sb; sb.x = pk(St[2 * m][0], St[2 * m][1]); sb.y = pk(St[2 * m][2], St[2 * m][3]); sb.z = pk(St[2 * m + 1][0], St[2 * m + 1][1]); sb.w = pk(St[2 * m + 1][2], St[2 * m + 1][3]);
                        u32x4 qq; qq.x = qa[m].x; qq.y = qa[m].y; qq.z = qb[m].x; qq.w = qb[m].y;
                        o = __builtin_amdgcn_mfma_f32_16x16x32_bf16(__builtin_bit_cast(s16x8, qq), __builtin_bit_cast(s16x8, sb), o, 0, 0, 0); }
                    O[cg] = o;
                    f32x4 dvv[8]; u32x2 a2v[8];
#pragma unroll
                    for (int i = 0; i < 8; ++i) { dvv[i] = *(const HG_LAS f32x4*)(lds + DCH + ch * 512 + (16 * i + 4 * g) * 4); a2v[i] = *(const HG_LAS u32x2*)(lds + KPT + (16 * i + l16) * KPP + (tr + 4 * g) * 2); }
#pragma unroll
                    for (int i = 0; i < 8; ++i) { u32x4 a4; a4.x = a2v[i].x; a4.y = a2v[i].y; a4.z = 0u; a4.w = 0u;
                        St[i] = __builtin_amdgcn_mfma_f32_16x16x32_bf16(__builtin_bit_cast(s16x8, a4), bv, St[i] * dvv[i], 0, 0, 0); }
                }
                __syncthreads();
            }
        }
#undef HG_LOAD_FQ
#undef HG_LOAD_S
        unsigned sgv[8][4];
        { const unsigned short* sgb = SGt + (size_t)tok0 * HW + h * 128 + 16 * w; const int slo = 4 * g * HW + l16;
#pragma unroll
          for (int cg = 0; cg < 8; ++cg)
#pragma unroll
              for (int r = 0; r < 4; ++r) sgv[cg][r] = (sgb + (16 * cg + r) * HW)[slo]; }
#pragma unroll
        for (int cg = 0; cg < 8; ++cg)
#pragma unroll
            for (int r = 0; r < 4; ++r) { const float s = row16_sum(O[cg][r] * O[cg][r]); if (l16 == 0) *(HG_LAS float*)(lds + NRM + w * 512 + (16 * cg + 4 * g + r) * 4) = s; }
        __syncthreads();
        if (tid < 128) { float s = 0.f;
#pragma unroll
            for (int ww = 0; ww < 8; ++ww) s += *(HG_LAS float*)(lds + NRM + ww * 512 + tid * 4);
            *(HG_LAS float*)(lds + RSTD + tid * 4) = 1.0f / sqrtf(s * (1.0f / 128.0f) + 1e-6f); }
        __syncthreads();
        {
            const float gw = gnw[16 * w + l16];
            unsigned short* mb = MIX + (size_t)tok0 * 2048 + 768 + h * 128 + 16 * w; const int mlo = 4 * g * 2048 + l16;
            asm volatile("" ::: "memory");
#pragma unroll
            for (int cg = 0; cg < 8; ++cg) { const f32x4 rs = *(const HG_LAS f32x4*)(lds + RSTD + (16 * cg + 4 * g) * 4);
#pragma unroll
                for (int r = 0; r < 4; ++r) {
                    const float y = O[cg][r] * rs[r] * gw * __uint_as_float(sgv[cg][r] << 16);
                    (mb + (16 * cg + r) * 2048)[mlo] = (unsigned short)(pk(y, 0.f) & 0xffffu); } }
        }
        __syncthreads();
    }
}
#undef HG_DPP_ADD
}

constexpr int NWAVES = 8;
#ifndef MK_SPLIT
#define MK_SPLIT 0
#endif
constexpr int S = 8192, DM = 2048, DFF = 5632, DIN = 5120, NL = 4;
constexpr int NGU = 2 * DFF;
constexpr float EPS = 1e-6f;
constexpr size_t MiB = 1u << 20;
constexpr size_t WS_CTL = 0, CTL_ZERO_BYTES = 1 * MiB;
constexpr size_t WS_TAB = 1 * MiB;
constexpr size_t TAB_RT = 0, TAB_CT = 16384, TAB_TB = 24576, TAB_LB = 40960;
constexpr size_t TAB_HS = 65536, TAB_WSC = 131072;
constexpr size_t WS_W = 2 * MiB;
constexpr size_t W_GU1 = 0, W_DN1 = 44 * MiB, W_WIN = 66 * MiB, W_WOUT = 86 * MiB, W_GU2 = 94 * MiB, W_DN2 = 138 * MiB, W_LAYER = 160 * MiB;
constexpr size_t WS_X = WS_W + NL * W_LAYER;
constexpr size_t WS_Y = WS_X + 64 * MiB;
constexpr size_t WS_H = WS_Y + 64 * MiB;
constexpr size_t WS_ACT = WS_H + 32 * MiB;
constexpr size_t WS_MIX = WS_ACT + 88 * MiB;
constexpr size_t WS_AQ = WS_MIX + 32 * MiB, WS_AK = WS_AQ + 12 * MiB, WS_AV = WS_AK + 4 * MiB, WS_CQ = WS_AV + 4 * MiB, WS_CK = WS_CQ + 12 * MiB, WS_CV = WS_CK + 4 * MiB;
constexpr size_t WS_B = WS_CV + 4 * MiB;
constexpr size_t WB_BQ = 0, WB_BI = 8 * MiB, WB_SG = 16 * MiB, WB_FF = 32 * MiB, WB_FB = 48 * MiB, WB_P = 64 * MiB;
constexpr size_t BSZ = 16 * MiB;
constexpr size_t WS_SS = WS_B + 9 * BSZ;
constexpr size_t WS_DG = WS_SS + 32 * MiB;
constexpr size_t WS_PO = WS_DG + 1 * MiB;
constexpr size_t WS_PML = WS_PO + 16 * MiB;
constexpr size_t WS_END = WS_PML + 1 * MiB;
constexpr int CW_BAR = 4096;
constexpr int CW_CQ = 1024;
constexpr int RING_OFF = 0, RING_BYTES = 131072;
constexpr int LDSCTL_OFF = RING_BYTES, MISC_OFF = LDSCTL_OFF + 320;
constexpr int LDS_BYTES = 147456;

#define GAS __attribute__((address_space(1)))
#define LAS __attribute__((address_space(3)))
typedef unsigned short bf16;
typedef unsigned v4u __attribute__((ext_vector_type(4)));
typedef unsigned v2u __attribute__((ext_vector_type(2)));
typedef float f32x4 __attribute__((ext_vector_type(4)));
typedef GAS unsigned gu32;
#define RLX_AGENT __ATOMIC_RELAXED, __HIP_MEMORY_SCOPE_AGENT
#define LDS_WAIT() asm volatile("s_waitcnt lgkmcnt(0)" ::: "memory")
#define VM_WAIT() asm volatile("s_waitcnt vmcnt(0)" ::: "memory")
__device__ __forceinline__ unsigned f2bf(float f) { unsigned u = __builtin_bit_cast(unsigned, f); return (u + 0x7fffu + ((u >> 16) & 1u)) >> 16; }
__device__ __forceinline__ unsigned pk2(float lo, float hi) { return f2bf(lo) | (f2bf(hi) << 16); }
__device__ __forceinline__ float bf2f(bf16 b) { return __uint_as_float((unsigned)b << 16); }

#define XB_TMO      128
#define XB_XCNT(j)  (256  + 64 * (j))
#define XB_XSUB(j)  (1280 + 64 * (j))
#define XB_XGEN(j)  (2304 + 64 * (j))
#define XB_TOP      3328
#define XB_TOPGEN   3392
#define XCD_BAR_WORDS 3456
#define XB_SPIN_CAP (1u << 18)

__device__ __forceinline__ unsigned xb_ld(unsigned* p)              { return __hip_atomic_load(p, __ATOMIC_RELAXED, __HIP_MEMORY_SCOPE_AGENT); }
__device__ __forceinline__ unsigned xb_add(unsigned* p, unsigned v) { return __hip_atomic_fetch_add(p, v, __ATOMIC_RELAXED, __HIP_MEMORY_SCOPE_AGENT); }
__device__ __forceinline__ unsigned xb_xcc_id() { return (unsigned)__builtin_amdgcn_s_getreg((3 << 11) | 20) & 0xFu; }
#define XB_SPIN(cond, bar) do { unsigned _sp = 0; while (cond) { __builtin_amdgcn_s_sleep(1); \
    if ((++_sp & 255u) == 0u) { if (xb_ld(&(bar)[XB_TMO])) break; if (_sp > XB_SPIN_CAP) { atomicAdd(&(bar)[XB_TMO], 1u); break; } } } } while (0)

struct XcdBarrier {
    unsigned* bar; unsigned x;
    volatile LAS unsigned* st;
};

__device__ __forceinline__ XcdBarrier xcd_barrier_post(unsigned* bar, volatile LAS unsigned* st) {
    XcdBarrier b; b.bar = bar; b.x = xb_xcc_id(); b.st = st;
    if (threadIdx.x == 0) (void)xb_add(&bar[XB_XCNT(b.x)], 1u);
    return b;
}
__device__ __forceinline__ void xcd_barrier_complete(unsigned* bar, unsigned x, unsigned& nloc, unsigned& nx) {
    const unsigned G = gridDim.x * gridDim.y * gridDim.z;
    unsigned sum, cnt, mine, sp = 0u;
    for (;;) {
        sum = 0u; cnt = 0u; mine = 0u;
#pragma unroll
        for (unsigned j = 0; j < 16; ++j) { const unsigned c = xb_ld(&bar[XB_XCNT(j)]); sum += c; cnt += (c > 0u) ? 1u : 0u; mine = (j == x) ? c : mine; }
        if (sum == G) break;
        __builtin_amdgcn_s_sleep(1);
        if ((++sp & 255u) == 0u) { if (xb_ld(&bar[XB_TMO])) break; if (sp > XB_SPIN_CAP) { atomicAdd(&bar[XB_TMO], 1u); break; } }
    }
    nloc = mine > 0u ? mine : 1u; nx = cnt > 0u ? cnt : 1u;
}

__device__ __forceinline__ void xcd_barrier(const XcdBarrier& b) {
    asm volatile("s_waitcnt vmcnt(0)" ::: "memory");
    __syncthreads();
    if (threadIdx.x == 0) {
        unsigned* bar = b.bar;
        __builtin_amdgcn_s_waitcnt(0);
        unsigned nloc = b.st[0], nx = b.st[1];
        if (nloc == 0u) { xcd_barrier_complete(bar, b.x, nloc, nx); b.st[0] = nloc; b.st[1] = nx; }
        const unsigned old = xb_add(&bar[XB_XSUB(b.x)], 1u);
        const unsigned gen = old / nloc;
        if (old + 1u == (gen + 1u) * nloc) {
            __builtin_amdgcn_fence(__ATOMIC_RELEASE, "agent");
            asm volatile("s_waitcnt vmcnt(0)" ::: "memory");
            const unsigned og = xb_add(&bar[XB_TOP], 1u);
            const unsigned tg = og / nx;
            if (og + 1u == (tg + 1u) * nx) xb_add(&bar[XB_TOPGEN], 1u);
            else XB_SPIN(xb_ld(&bar[XB_TOPGEN]) == tg, bar);
            __builtin_amdgcn_fence(__ATOMIC_ACQUIRE, "agent");
            xb_add(&bar[XB_XGEN(b.x)], 1u);
            asm volatile("s_waitcnt vmcnt(0)" ::: "memory");
        } else {
            XB_SPIN(xb_ld(&bar[XB_XGEN(b.x)]) == gen, bar);
            __builtin_amdgcn_fence(__ATOMIC_ACQUIRE, "agent");
            asm volatile("s_waitcnt vmcnt(0)" ::: "memory");
        }
    }
    __syncthreads();
}


struct Frame {
    LAS unsigned char* lds;
    volatile LAS unsigned* MISC;
    gu32* ctl;
    int tid, lane, wave, vcu, G;
};
__device__ __forceinline__ float wave_sum(float v) {
#pragma unroll
    for (int o = 1; o < 64; o <<= 1) v += __shfl_xor(v, o);
    return v;
}
__device__ __forceinline__ float wave_max(float v) {
#pragma unroll
    for (int o = 1; o < 64; o <<= 1) v = fmaxf(v, __shfl_xor(v, o));
    return v;
}
#define DPP_ADD(v, ctrl) v += __builtin_bit_cast(float, __builtin_amdgcn_update_dpp(0, __builtin_bit_cast(int, v), ctrl, 0xF, 0xF, true))
__device__ __forceinline__ float wave_sum_fast(float v) {
    DPP_ADD(v, 0xB1); DPP_ADD(v, 0x4E); DPP_ADD(v, 0x124); DPP_ADD(v, 0x128);
    { auto rr = __builtin_amdgcn_permlane16_swap(__float_as_uint(v), __float_as_uint(v), false, false); v = __uint_as_float(rr[0]) + __uint_as_float(rr[1]); }
    { auto rr = __builtin_amdgcn_permlane32_swap(__float_as_uint(v), __float_as_uint(v), false, false); v = __uint_as_float(rr[0]) + __uint_as_float(rr[1]); }
    return v;
}

struct ConvDesc { const float* src; unsigned char* dst; int N, K, f8; float sc; };
__device__ __forceinline__ unsigned pk4_i8(float a, float b, float c, float d) { const float M = 12582912.f;
    return __builtin_amdgcn_perm(__float_as_uint(b + M), __float_as_uint(a + M), 0x0c0c0400u) | __builtin_amdgcn_perm(__float_as_uint(d + M), __float_as_uint(c + M), 0x04000c0cu); }
__device__ __forceinline__ float cl127(float x) { return __builtin_amdgcn_fmed3f(x, -127.f, 127.f); }
constexpr unsigned I8_GU1_MASK = 0xEu, I8_GU2_MASK = 0xFu;
constexpr unsigned F8_DN1_MASK = 0x8u, F8_DN2_MASK = 0xCu;
static_assert((I8_GU1_MASK & 1u) == 0, "layer 0's first H comes from row_first (bf16) and its gate|up weights are converted before the scales exist");
static_assert((F8_DN1_MASK & ~I8_GU1_MASK) == 0 && (F8_DN2_MASK & ~I8_GU2_MASK) == 0, "only the int8 gate|up epilogue has an fp8-output form here");
constexpr int H8_SCL2 = 3, W8_SCL2 = 8, A8_SCL2 = 3;
__device__ __forceinline__ unsigned pk4_fp8(float a, float b, float c, float d, float sc) {
    a = __builtin_amdgcn_fmed3f(a * sc, -448.f, 448.f); b = __builtin_amdgcn_fmed3f(b * sc, -448.f, 448.f); c = __builtin_amdgcn_fmed3f(c * sc, -448.f, 448.f); d = __builtin_amdgcn_fmed3f(d * sc, -448.f, 448.f);
    int w = 0; w = __builtin_amdgcn_cvt_pk_fp8_f32(a, b, w, false); w = __builtin_amdgcn_cvt_pk_fp8_f32(c, d, w, true); return (unsigned)w;
}
__device__ __forceinline__ void conv_load(const ConvDesc& d, float (&v)[32], int lane) {
    const int lo = (lane >> 5) * d.N + (lane & 31);
#pragma unroll
    for (int i = 0; i < 32; ++i) v[i] = __builtin_nontemporal_load((d.src + (size_t)(2 * i) * d.N) + lo);
}
__device__ __forceinline__ void conv_store(const ConvDesc& d, const float (&v)[32], LAS float* scr, int lane) {
#pragma unroll
    for (int i = 0; i < 32; ++i) scr[(2 * i + (lane >> 5)) * 33 + (lane & 31)] = v[i];
    LDS_WAIT(); asm volatile("" ::: "memory");
    const int c = lane & 7;
#pragma unroll
    for (int j = 0; j < 4; ++j) { const int n = (lane >> 3) + 8 * j; const LAS float* s = scr + (8 * c) * 33 + n;
        if (d.f8 == 2) { v2u o; const float q = d.sc; o.x = pk4_i8(cl127(s[0 * 33] * q), cl127(s[1 * 33] * q), cl127(s[2 * 33] * q), cl127(s[3 * 33] * q)); o.y = pk4_i8(cl127(s[4 * 33] * q), cl127(s[5 * 33] * q), cl127(s[6 * 33] * q), cl127(s[7 * 33] * q));
            *(GAS v2u*)(d.dst + (size_t)n * d.K + 8 * c) = o; }
        else if (d.f8) { v2u o; o.x = pk4_fp8(s[0 * 33], s[1 * 33], s[2 * 33], s[3 * 33], (float)(1 << W8_SCL2)); o.y = pk4_fp8(s[4 * 33], s[5 * 33], s[6 * 33], s[7 * 33], (float)(1 << W8_SCL2));
            *(GAS v2u*)(d.dst + (size_t)n * d.K + 8 * c) = o; }
        else { v4u o; o.x = pk2(s[0 * 33], s[1 * 33]); o.y = pk2(s[2 * 33], s[3 * 33]); o.z = pk2(s[4 * 33], s[5 * 33]); o.w = pk2(s[6 * 33], s[7 * 33]);
            *(GAS v4u*)(d.dst + ((size_t)n * d.K + 8 * c) * 2) = o; } }
    LDS_WAIT(); asm volatile("" ::: "memory");
}
constexpr int I_G = (DM / 64) * (DFF / 32), I_D = (DFF / 64) * (DM / 32), I_IN = (DM / 64) * (DIN / 32), I_OUT = (DM / 64) * (DM / 32);
constexpr int I_LAYER = 6 * I_G + I_IN + I_OUT;
static_assert(I_D == I_G && I_LAYER % 4 == 0, "item counts");
#define CONV_PARAMS const float* cs_w_in, const float* cs_w_out, const float* cs_f1g, const float* cs_f1u, const float* cs_f1d, const float* cs_f2g, const float* cs_f2u, const float* cs_f2d
#define CONV_PASS cs_w_in, cs_w_out, cs_f1g, cs_f1u, cs_f1d, cs_f2g, cs_f2u, cs_f2d
#define CONV_INPUTS INP(1), INP(2), INP(3), INP(4), INP(5), INP(6), INP(7), INP(8)
__device__ __forceinline__ ConvDesc conv_desc(CONV_PARAMS, unsigned char* ws, int flat) {
    const int l = flat / I_LAYER; int r = flat - l * I_LAYER;
    unsigned char* wl = ws + WS_W + (size_t)l * W_LAYER;
    const float* W; int K, N, drow, kb, n0, f8 = 0; size_t woff; float sc = 1.f;
    if (r < 2 * I_G || (r >= 3 * I_G + I_IN + I_OUT && r < 5 * I_G + I_IN + I_OUT)) {
        const bool second = r >= 2 * I_G; if (second) r -= 3 * I_G + I_IN + I_OUT; f8 = (((second ? I8_GU2_MASK : I8_GU1_MASK) >> l) & 1u) ? 2 : 0;
        const bool up = r >= I_G; if (up) r -= I_G;
        if (f8 == 2) sc = 1.0f / ((const float*)(ws + WS_TAB + TAB_WSC))[l * 4 + (second ? 2 : 0) + (up ? 1 : 0)];
        W = (second ? (up ? cs_f2u : cs_f2g) : (up ? cs_f1u : cs_f1g)) + (size_t)l * DM * DFF; K = DM; N = DFF; woff = second ? W_GU2 : W_GU1;
        const int nblk = DFF / 32; kb = r / nblk; n0 = 32 * (r - kb * nblk); drow = (n0 >> 7) * 256 + (n0 & 127) + (up ? 128 : 0);
    } else if (r < 3 * I_G) {
        r -= 2 * I_G; f8 = (int)((F8_DN1_MASK >> l) & 1u); W = cs_f1d + (size_t)l * DFF * DM; K = DFF; N = DM; woff = W_DN1; const int nblk = DM / 32; kb = r / nblk; n0 = 32 * (r - kb * nblk); drow = n0;
    } else if (r < 3 * I_G + I_IN) {
        r -= 3 * I_G; W = cs_w_in + (size_t)l * DM * DIN; K = DM; N = DIN; woff = W_WIN; const int nblk = DIN / 32; kb = r / nblk; n0 = 32 * (r - kb * nblk);
        const int tile = n0 >> 8, q = n0 & 255; drow = tile * 256 + ((tile >= 15 && tile <= 18) ? (((q & 63) >> 5) * 128 + (q >> 6) * 32) : q);
    } else if (r < 3 * I_G + I_IN + I_OUT) {
        r -= 3 * I_G + I_IN; W = cs_w_out + (size_t)l * DM * DM; K = DM; N = DM; woff = W_WOUT; const int nblk = DM / 32; kb = r / nblk; n0 = 32 * (r - kb * nblk); drow = n0;
    } else {
        r -= 5 * I_G + I_IN + I_OUT; f8 = (int)((F8_DN2_MASK >> l) & 1u); W = cs_f2d + (size_t)l * DFF * DM; K = DFF; N = DM; woff = W_DN2; const int nblk = DM / 32; kb = r / nblk; n0 = 32 * (r - kb * nblk); drow = n0;
    }
    ConvDesc d; d.src = W + (size_t)(64 * kb) * N + n0; d.dst = wl + woff + (((size_t)drow * K + 64 * kb) << (f8 ? 0 : 1)); d.N = N; d.K = K; d.f8 = f8; d.sc = sc; return d;
}
__device__ __forceinline__ void conv_range(CONV_PARAMS, unsigned char* ws, int first, int stride, int end, LAS float* scr, int lane) {
    if (first >= end) return;
    const int last = first + ((end - 1 - first) / stride) * stride;
    float a[32], b[32], c[32]; ConvDesc da = conv_desc(CONV_PASS, ws, first), db, dc; conv_load(da, a, lane);
    int it = first;
    { const int nx = it + stride < last ? it + stride : last; db = conv_desc(CONV_PASS, ws, nx); conv_load(db, b, lane); }
#pragma unroll 1
    for (;;) {
        { const int nx = it + 2 * stride < last ? it + 2 * stride : last; dc = conv_desc(CONV_PASS, ws, nx); conv_load(dc, c, lane); }
        conv_store(da, a, scr, lane); it += stride; if (it >= end) break;
        { const int nx = it + 2 * stride < last ? it + 2 * stride : last; da = conv_desc(CONV_PASS, ws, nx); conv_load(da, a, lane); }
        conv_store(db, b, scr, lane); it += stride; if (it >= end) break;
        { const int nx = it + 2 * stride < last ? it + 2 * stride : last; db = conv_desc(CONV_PASS, ws, nx); conv_load(db, b, lane); }
        conv_store(dc, c, scr, lane); it += stride; if (it >= end) break;
    }
    VM_WAIT();
}
constexpr int CONV_K = 13, CONV_SLOT = 1024 * CONV_K, CONV_P0 = 2 * I_G, CONV_R = I_LAYER - 3 * CONV_SLOT, I_ALL = NL * I_LAYER;
static_assert(CONV_R >= 0 && CONV_P0 + 3 * CONV_SLOT + CONV_R == I_LAYER + CONV_P0, "conversion schedule period");
static_assert(CONV_P0 + CONV_SLOT >= 3 * I_G + I_IN + I_OUT && CONV_P0 + 2 * CONV_SLOT >= 5 * I_G + I_IN + I_OUT && CONV_P0 + 3 * CONV_SLOT >= I_LAYER, "each slot must cover what the phases before the next slot need");
__device__ __forceinline__ int t5_bucket(int rel) {
    const int n = rel < 0 ? -rel : rel;
    int b;
    if (n < 8) b = n; else { const int lg = 31 - __builtin_clz((unsigned)(n * n)); b = 8 + (lg - 6); if (b > 15) b = 15; }
    return (rel > 0 ? 16 : 0) + b;
}

struct Args { const float* in[15]; float* out; unsigned char* ws; int ph_lo, ph_hi; };

typedef _Float16 h16x4 __attribute__((ext_vector_type(4)));
template <bool XIN_F32> __device__ __forceinline__ f32x4 row_ldx(const void* X, size_t r, int lane, int j) {
    if constexpr (XIN_F32) return __builtin_nontemporal_load((const GAS f32x4*)((const float*)X + r * DM) + lane + 64 * j);
    else { const h16x4 v = __builtin_nontemporal_load((const GAS h16x4*)((const _Float16*)X + r * DM) + lane + 64 * j); return __builtin_convertvector(v, f32x4); }
}
template <bool XIN_F32, bool XOUT_F32, int H8 = 0>
__device__ __forceinline__ void row_phase(const Frame& F, const void* X, const bf16* Y, void* Xout, bf16* Hout, const float* wpost, const float* wnext, float coef, int r_first, int r_step, float* HS = nullptr) {
    f32x4 x[8]; v2u yb[8];
    if (r_first < S) { const GAS v2u* yr = (const GAS v2u*)(Y + (size_t)r_first * DM) + F.lane;
#pragma unroll
        for (int j = 0; j < 8; ++j) { yb[j] = __builtin_nontemporal_load(yr + 64 * j); x[j] = row_ldx<XIN_F32>(X, (size_t)r_first, F.lane, j); } }
#pragma unroll 1
    for (int k = 0; k < 4; ++k) { const int r = r_first + k * r_step; if (r >= S) break;
        const int rn = r + r_step; const bool more = (k < 3) && (rn < S);
        f32x4 xn[8]; v2u ybn[8];
        if (more) { const GAS v2u* yr = (const GAS v2u*)(Y + (size_t)rn * DM) + F.lane;
#pragma unroll
            for (int j = 0; j < 8; ++j) { ybn[j] = __builtin_nontemporal_load(yr + 64 * j); xn[j] = row_ldx<XIN_F32>(X, (size_t)rn, F.lane, j); } }
        f32x4 y[8]; float s = 0.f;
#pragma unroll
        for (int j = 0; j < 8; ++j) { y[j] = (f32x4){__uint_as_float(yb[j].x << 16), __uint_as_float(yb[j].x & 0xffff0000u), __uint_as_float(yb[j].y << 16), __uint_as_float(yb[j].y & 0xffff0000u)};
            s += (y[j].x * y[j].x + y[j].y * y[j].y) + (y[j].z * y[j].z + y[j].w * y[j].w); }
        const float r1 = coef / sqrtf(wave_sum(s) * (1.f / DM) + EPS); float s2 = 0.f;
#pragma unroll
        for (int j = 0; j < 8; ++j) { const f32x4 w = *((const GAS f32x4*)wpost + F.lane + 64 * j); x[j] = x[j] + y[j] * r1 * w;
            if constexpr (XOUT_F32) __builtin_nontemporal_store(x[j], (GAS f32x4*)((float*)Xout + (size_t)r * DM) + F.lane + 64 * j);
            else __builtin_nontemporal_store(__builtin_convertvector(x[j], h16x4), (GAS h16x4*)((_Float16*)Xout + (size_t)r * DM) + F.lane + 64 * j);
            s2 += (x[j].x * x[j].x + x[j].y * x[j].y) + (x[j].z * x[j].z + x[j].w * x[j].w); }
        if (Hout) { const float r2 = 1.f / sqrtf(wave_sum(s2) * (1.f / DM) + EPS);
            if constexpr (H8 == 2) { GAS unsigned* ho = (GAS unsigned*)((unsigned char*)Hout + (size_t)r * DM) + F.lane;
                f32x4 v[8]; float am = 1e-20f;
#pragma unroll
                for (int j = 0; j < 8; ++j) { const f32x4 w = *((const GAS f32x4*)wnext + F.lane + 64 * j); v[j] = x[j] * r2 * w; am = fmaxf(fmaxf(am, fmaxf(fabsf(v[j].x), fabsf(v[j].y))), fmaxf(fabsf(v[j].z), fabsf(v[j].w))); }
                am = wave_max(am); const float qs = 127.f / am; if (F.lane == 0) HS[r] = am * (1.f / 127.f);
#pragma unroll
                for (int j = 0; j < 8; ++j) ho[64 * j] = pk4_i8(v[j].x * qs, v[j].y * qs, v[j].z * qs, v[j].w * qs); }
            else if constexpr (H8 == 1) { GAS unsigned* ho = (GAS unsigned*)((unsigned char*)Hout + (size_t)r * DM) + F.lane;
#pragma unroll
                for (int j = 0; j < 8; ++j) { const f32x4 w = *((const GAS f32x4*)wnext + F.lane + 64 * j); const f32x4 v = x[j] * r2 * w; ho[64 * j] = pk4_fp8(v.x, v.y, v.z, v.w, (float)(1 << H8_SCL2)); } }
            else { GAS v2u* ho = (GAS v2u*)(Hout + (size_t)r * DM) + F.lane;
#pragma unroll
            for (int j = 0; j < 8; ++j) { const f32x4 w = *((const GAS f32x4*)wnext + F.lane + 64 * j); const f32x4 v = x[j] * r2 * w; v2u o; o.x = pk2(v.x, v.y); o.y = pk2(v.z, v.w); ho[64 * j] = o; } } }
        if (more) {
#pragma unroll
            for (int j = 0; j < 8; ++j) { x[j] = xn[j]; yb[j] = ybn[j]; } }
    }
}
__device__ __forceinline__ void row_first(const Frame& F, const float* Xin, bf16* Hout, const float* wnext) {
    const int gw = F.vcu * NWAVES + F.wave, NGW = F.G * NWAVES;
    for (int r = gw; r < S; r += NGW) {
        const GAS f32x4* xr = (const GAS f32x4*)(Xin + (size_t)r * DM) + F.lane;
        f32x4 x[8]; float s2 = 0.f;
#pragma unroll
        for (int j = 0; j < 8; ++j) { x[j] = xr[64 * j]; s2 += (x[j].x * x[j].x + x[j].y * x[j].y) + (x[j].z * x[j].z + x[j].w * x[j].w); }
        const float r2 = 1.f / sqrtf(wave_sum(s2) * (1.f / DM) + EPS);
        GAS v2u* ho = (GAS v2u*)(Hout + (size_t)r * DM) + F.lane;
#pragma unroll
        for (int j = 0; j < 8; ++j) { const f32x4 w = *((const GAS f32x4*)wnext + F.lane + 64 * j); const f32x4 v = x[j] * r2 * w; v2u o; o.x = pk2(v.x, v.y); o.y = pk2(v.z, v.w); ho[64 * j] = o; }
    }
}

__device__ __forceinline__ unsigned long long rt() { return __builtin_amdgcn_s_memrealtime(); }
#define IDLE_PULL(nwg_, slot_, ks_) do { const int c_ = BID(), g_ = GRD(); \
    if (g_ == 256) { PHASE_FRAME(); const int base_ = CONV_P0 + l * I_LAYER + (slot_) * CONV_SLOT, end_ = base_ + CONV_SLOT < I_ALL ? base_ + CONV_SLOT : I_ALL, mid_ = base_ + (ks_) * 1024 < end_ ? base_ + (ks_) * 1024 : end_; \
        LAS float* scr_ = (LAS float*)(F.lds + RING_OFF + F.wave * 16384); \
          \
        if (c_ >= 128) conv_range(CONV_INPUTS, ws, base_ + (c_ - 128) * NWAVES + F.wave, 1024, mid_, scr_, F.lane); \
        else conv_range(CONV_INPUTS, ws, mid_ + c_ * NWAVES + F.wave, 1024, end_, scr_, F.lane); } } while (0)
#define WSL() ({ GAS unsigned char* p_ = (GAS unsigned char*)args.ws; asm volatile("" : "+s"(p_)); (unsigned char*)p_; })
#define BID() ({ int b_ = (int)blockIdx.x; asm volatile("" : "+s"(b_)); b_; })
#define GRD() ({ int g_ = (int)gridDim.x; asm volatile("" : "+s"(g_)); g_; })
#define INP(i) ({ int i_ = (i); asm volatile("" : "+s"(i_)); (const float*)(const GAS float*)args.in[i_]; })
#define PHASE_FRAME() Frame F = F0; { asm volatile("" : "+s"(F.vcu), "+s"(F.G)); int t_ = threadIdx.x; asm volatile("" : "+v"(t_)); F.tid = t_; F.lane = t_ & 63; F.wave = __builtin_amdgcn_readfirstlane(t_ >> 6); }
typedef pg8::EpiSwiGLUI8<-1> EpiI8; typedef pg8::EpiSwiGLUI8<A8_SCL2> EpiI8o8;
typedef pg8::EpiBf16YT<A8_SCL2 + W8_SCL2> Epi8DN;
__global__ void __launch_bounds__(NWAVES * 64, 2) fwd(Args args) {
    extern __shared__ __attribute__((aligned(16))) unsigned char lds[];
    Frame F0;
    F0.lds = (LAS unsigned char*)lds;
    F0.MISC = (volatile LAS unsigned*)(F0.lds + MISC_OFF);
    F0.tid = threadIdx.x; F0.lane = F0.tid & 63; F0.wave = __builtin_amdgcn_readfirstlane(F0.tid >> 6);
    F0.G = gridDim.x; { const int bx = blockIdx.x; F0.vcu = (F0.G % 8 == 0) ? (bx % 8) * (F0.G / 8) + bx / 8 : bx; }
    F0.ctl = (gu32*)(args.ws + WS_CTL);
    for (int u = F0.tid; u < (LDS_BYTES - LDSCTL_OFF) / 4; u += NWAVES * 64) ((LAS unsigned*)(F0.lds + LDSCTL_OFF))[u] = 0u;
    __syncthreads();
    const int lo = args.ph_lo, hi = args.ph_hi;
    XcdBarrier bar; bar.bar = (unsigned*)(F0.ctl + CW_BAR); bar.x = 0; bar.st = nullptr;
    if (hi - lo > 1) bar = xcd_barrier_post((unsigned*)(F0.ctl + CW_BAR), F0.MISC + 8);
    int ph = 0;
#define PH_ON (lo <= ph && ph < hi)
#define PH_END do { if (lo <= ph && ph + 1 < hi) { XcdBarrier b2_ = bar; { GAS unsigned* bp_ = (GAS unsigned*)bar.bar; asm volatile("" : "+s"(bp_), "+s"(b2_.x)); b2_.bar = (unsigned*)bp_; } xcd_barrier(b2_); } ++ph; } while (0)

    if (PH_ON) {
        PHASE_FRAME(); unsigned char* ws = WSL();
        LAS float* scr = (LAS float*)(F.lds + RING_OFF + F.wave * 16384);
        const int gw = F.vcu * NWAVES + F.wave, NGW = F.G * NWAVES;
        {
            float* wsc = (float*)(ws + WS_TAB + TAB_WSC); LAS float* red = (LAS float*)(F.lds + RING_OFF);
            for (int j = (F.G == 256) ? F.vcu : 0; j < NL * 4; j += (F.G == 256) ? F.G : 1) { const int lj = j >> 2, kd = j & 3;
                const float* W = (kd == 0 ? INP(3) : kd == 1 ? INP(4) : kd == 2 ? INP(6) : INP(7)) + (size_t)lj * DM * DFF;
                float ss = 0.f, am = 0.f;
                for (int i = 0; i < 16; ++i) { const float w = W[(size_t)(F.tid * 16 + i) * 1407]; ss += w * w; am = fmaxf(am, fabsf(w)); }
                ss = wave_sum(ss); am = wave_max(am);
                __syncthreads(); if (F.lane == 0) { red[F.wave] = ss; red[8 + F.wave] = am; } __syncthreads();
                if (F.tid == 0) { float s2 = 0.f, a2 = 0.f; for (int w = 0; w < NWAVES; ++w) { s2 += red[w]; a2 = fmaxf(a2, red[8 + w]); }
                    (void)a2; wsc[j] = fmaxf(4.0f * sqrtf(s2 * (1.f / 8192.f)), 1e-20f) * (1.f / 127.f); }
            }
            VM_WAIT(); __syncthreads();
        }
        conv_range(CONV_INPUTS, ws, gw, NGW, (F.G == 256) ? CONV_P0 : I_LAYER, scr, F.lane);
        {
            float* rtab = (float*)(ws + WS_TAB + TAB_RT); float* ctab = (float*)(ws + WS_TAB + TAB_CT); float* tbt = (float*)(ws + WS_TAB + TAB_TB); float* lbs = (float*)(ws + WS_TAB + TAB_LB);
            const float* hg_lb = INP(12); const float* rel_b = INP(14);
            const int gid = F.vcu * (NWAVES * 64) + F.tid;
            if (gid < 3072) {
                const int pos = gid >> 4, j = gid & 15; const int p = pos < 128 ? pos : pos - 128;
                const float inv = 1.0f / exp2f((float)j * (1.0f / 16.0f) * 13.287712379549449f);
                const float ang = (float)p * inv;
                double rev = (double)ang * 0.15915494309189535; rev -= rint(rev); const float rv = (float)rev;
                float* dst = (pos < 128 ? rtab + pos * 32 : ctab + p * 32) + 2 * j;
                dst[0] = __builtin_amdgcn_cosf(rv); dst[1] = __builtin_amdgcn_sinf(rv);
            }
            if (gid < 12 * 257) { const int h = gid / 257, r = gid - h * 257; tbt[h * 260 + r] = rel_b[t5_bucket(r - 128) * 12 + h] * pg8::LOG2E; }
            if (gid < 1024) {
                float v[NL], mx = -INFINITY;
#pragma unroll
                for (int l = 0; l < NL; ++l) { v[l] = hg_lb[l * 1024 + gid]; mx = fmaxf(mx, v[l]); }
                float sum = 0.f;
#pragma unroll
                for (int l = 0; l < NL; ++l) { v[l] = __expf(v[l] - mx); sum += v[l]; }
                float c = 0.f; lbs[gid] = 0.f;
#pragma unroll
                for (int l = 1; l < NL; ++l) { c += v[l] / sum; lbs[l * 1024 + gid] = c; }
            }
        }
        row_first(F, INP(0), (bf16*)(ws + WS_H), INP(9));
    }
    PH_END;

    for (int l = 0; l < NL; ++l) {
        if (PH_ON) { unsigned char* ws = WSL(); const unsigned char* wl = ws + WS_W + (size_t)l * W_LAYER;
            pg8::StaticOrder so; so.init(S, NGU, GRD(), BID());
            if ((I8_GU1_MASK >> l) & 1u) { pg8::Gemm g{(const bf16*)(ws + WS_H), (const bf16*)(wl + W_GU1), S, NGU, DM / 2};
                const float* hs = (const float*)(ws + WS_TAB + TAB_HS); const float* wsc = (const float*)(ws + WS_TAB + TAB_WSC) + l * 4 + 0;
                if ((F8_DN1_MASK >> l) & 1u) { EpiI8o8 E{(bf16*)(ws + WS_ACT), DFF, hs, wsc[0], wsc[1]}; pg8::gemm_phase<EpiI8o8, pg8::StaticOrder, true, true, 2>(F0.lds + RING_OFF, g, so, E); }
                else { EpiI8 E{(bf16*)(ws + WS_ACT), DFF, hs, wsc[0], wsc[1]}; pg8::gemm_phase<EpiI8, pg8::StaticOrder, true, true, 2>(F0.lds + RING_OFF, g, so, E); } }
            else { pg8::Gemm g{(const bf16*)(ws + WS_H), (const bf16*)(wl + W_GU1), S, NGU, DM};
                pg8::EpiSwiGLU E{(bf16*)(ws + WS_ACT), DFF}; pg8::gemm_phase<pg8::EpiSwiGLU, pg8::StaticOrder, true, true>(F0.lds + RING_OFF, g, so, E); }
            IDLE_PULL(0, 0, ((I8_GU1_MASK >> l) & 1u) ? 11 : CONV_K); }
        PH_END;
        if (PH_ON) { unsigned char* ws = WSL(); const unsigned char* wl = ws + WS_W + (size_t)l * W_LAYER;
            pg8::StaticOrder so; so.init(S, DM, GRD(), BID());
            if ((F8_DN1_MASK >> l) & 1u) { pg8::Gemm g{(const bf16*)(ws + WS_ACT), (const bf16*)(wl + W_DN1), S, DM, DFF / 2};
                Epi8DN E{(bf16*)(ws + WS_Y), DM}; pg8::gemm_phase<Epi8DN, pg8::StaticOrder, false, true, 1>(F0.lds + RING_OFF, g, so, E); }
            else { pg8::Gemm g{(const bf16*)(ws + WS_ACT), (const bf16*)(wl + W_DN1), S, DM, DFF};
                pg8::EpiBf16Y E{(bf16*)(ws + WS_Y), DM}; pg8::gemm_phase<pg8::EpiBf16Y, pg8::StaticOrder, false, true>(F0.lds + RING_OFF, g, so, E); } }
        PH_END;
        if (PH_ON) { PHASE_FRAME(); unsigned char* ws = WSL(); const float* nw = INP(9) + (size_t)l * 6 * DM;
            if (l == 0) row_phase<true, false>(F, INP(0), (const bf16*)(ws + WS_Y), ws + WS_X, (bf16*)(ws + WS_H), nw + 1 * DM, nw + 2 * DM, 0.5f, F.vcu * NWAVES + F.wave, F.G * NWAVES);
            else row_phase<false, false>(F, ws + WS_X, (const bf16*)(ws + WS_Y), ws + WS_X, (bf16*)(ws + WS_H), nw + 1 * DM, nw + 2 * DM, 0.5f, F.vcu * NWAVES + F.wave, F.G * NWAVES); }
        PH_END;
        if (PH_ON) { unsigned char* ws = WSL(); const unsigned char* wl = ws + WS_W + (size_t)l * W_LAYER;
            pg8::Gemm g{(const bf16*)(ws + WS_H), (const bf16*)(wl + W_WIN), S, DIN, DM}; pg8::StaticOrder so; so.init(S, DIN, GRD(), BID());
            unsigned char* Bb = ws + WS_B;
            pg8::EpiWin E{(bf16*)(ws + WS_AQ), (bf16*)(ws + WS_AK), (bf16*)(ws + WS_AV), (bf16*)(ws + WS_CQ), (bf16*)(ws + WS_CK), (bf16*)(ws + WS_CV),
                          Bb,
                          (const float*)(ws + WS_TAB + TAB_LB) + l * 1024, INP(11) + l * 128, (const float*)(ws + WS_TAB + TAB_RT), (const float*)(ws + WS_TAB + TAB_CT)};
            pg8::gemm_phase<pg8::EpiWin, pg8::StaticOrder, true, true>(F0.lds + RING_OFF, g, so, E); IDLE_PULL(0, 1, CONV_K); }
        PH_END;
        if (PH_ON) {
            { unsigned char* ws = WSL(); unsigned char* Bb = ws + WS_B;
              hg::pass1(GRD(), BID(), (const _Float16*)(Bb + WB_FF), (const _Float16*)(Bb + WB_FB), (const bf16*)(Bb + WB_BI), (bf16*)(Bb + WB_P), (float*)(ws + WS_DG), F0.lds + RING_OFF); }
            { unsigned char* ws = WSL();
              const attn_body::bf16* CQ = (const attn_body::bf16*)(ws + WS_CQ); const attn_body::bf16* CK = (const attn_body::bf16*)(ws + WS_CK); const attn_body::bf16* CV = (const attn_body::bf16*)(ws + WS_CV);
              attn_body::bf16* MIXo = (attn_body::bf16*)(ws + WS_MIX);
              const int gA = GRD(); const int bA = (gA == 256) ? ({ int v_ = F0.vcu; asm volatile("" : "+s"(v_)); v_; }) : BID();
              if (gA == 256) {
                { const int u = bA, h = u >> 5, qb = u & 31, kvh = h / 3;
                  attn_body::attn_unit<8, 768, 256, 2048, 0>(qb * 256, S / 64, CQ + h * 64, CK + kvh * 64, CV + kvh * 64, MIXo + 1280 + h * 64, (char*)lds + RING_OFF); }
                { const int su = bA >> 1, half = bA & 1, u = 256 + su, h = u >> 5, qb = u & 31, kvh = h / 3, kt0 = half ? 60 : 0, nt = half ? 68 : 60;
                  float* po = (float*)(ws + WS_PO) + ((size_t)su * 2 + half) * 16384; float* pml = (float*)(ws + WS_PML) + ((size_t)su * 2 + half) * 512;
                  attn_body::attn_unit<8, 768, 256, 2048, 0, true>(qb * 256, nt, CQ + h * 64, CK + kvh * 64 + (size_t)kt0 * 64 * 256, CV + kvh * 64 + (size_t)kt0 * 64 * 256, MIXo, (char*)lds + RING_OFF,
                                                                  nullptr, 0.f, 0, po, pml); }
              } else {
                for (int u = bA; u < 384; u += gA) { const int h = u >> 5, qb = u & 31, kvh = h / 3;
                  attn_body::attn_unit<8, 768, 256, 2048, 0>(qb * 256, S / 64, CQ + h * 64, CK + kvh * 64, CV + kvh * 64, MIXo + 1280 + h * 64, (char*)lds + RING_OFF); }
              } }
            { unsigned char* ws = WSL();
              const attn_body::bf16* AQp = (const attn_body::bf16*)(ws + WS_AQ); const attn_body::bf16* AKp = (const attn_body::bf16*)(ws + WS_AK); const attn_body::bf16* AVp = (const attn_body::bf16*)(ws + WS_AV);
              attn_body::bf16* MIXo = (attn_body::bf16*)(ws + WS_MIX); const float* tbp = (const float*)(ws + WS_TAB + TAB_TB); const float* skp = INP(10) + l * 12;
              const int gB = GRD(); const int vB = (gB == 256) ? ({ int v_ = F0.vcu; asm volatile("" : "+s"(v_)); v_; }) : BID();
              const int nun = (gB == 256) ? ((vB & 1) ? 1 : 2) : (vB < 384 ? (384 - vB + gB - 1) / gB : 0);
              for (int ui = 0; ui < nun; ++ui) { const int u = (gB == 256) ? (ui ? 256 + (vB >> 1) : vB) : vB + ui * gB;
                const int h = u >> 5, qb = u & 31, kvh = h / 3;
                const int t_lo = qb * 4 - 2 < 0 ? 0 : qb * 4 - 2, t_hi = qb * 4 + 6 > S / 64 ? S / 64 : qb * 4 + 6;
                attn_body::attn_unit<8, 768, 256, 2048, 1>(qb * 256, t_hi - t_lo, AQp + h * 64, AKp + kvh * 64 + (size_t)t_lo * 64 * 256, AVp + kvh * 64 + (size_t)t_lo * 64 * 256, MIXo + h * 64, (char*)lds + RING_OFF,
                                                           tbp + h * 260, skp[h] * pg8::LOG2E, t_lo * 64); } }
        }
        PH_END;
        if (PH_ON) { unsigned char* ws = WSL(); hg::scan(GRD(), ({ int v_ = F0.vcu; asm volatile("" : "+s"(v_)); v_; }), (const bf16*)(ws + WS_B + WB_P), (const float*)(ws + WS_DG), (bf16*)(ws + WS_SS)); }
        PH_END;
        if (PH_ON) { unsigned char* ws = WSL(); unsigned char* Bb = ws + WS_B;
            if (GRD() == 256) {
                int t_ = threadIdx.x; asm volatile("" : "+v"(t_)); const int bM = BID(), su = bM >> 1, u = 256 + su, h = u >> 5, qb = u & 31;
                const int row = 128 * (bM & 1) + (t_ >> 2), c0 = (t_ & 3) * 16;
                const float* p0 = (const float*)(ws + WS_PO) + ((size_t)su * 2) * 16384 + row * 64 + c0; const float* p1 = p0 + 16384;
                const float* ml0 = (const float*)(ws + WS_PML) + ((size_t)su * 2) * 512 + row * 2; const float* ml1 = ml0 + 512;
                const float m0 = ml0[0], l0 = ml0[1], m1 = ml1[0], l1 = ml1[1], mm = fmaxf(m0, m1), w0 = __builtin_amdgcn_exp2f(m0 - mm), w1 = __builtin_amdgcn_exp2f(m1 - mm);
                const float inv = 1.0f / (l0 * w0 + l1 * w1), a0 = w0 * inv, a1 = w1 * inv;
                bf16* op = (bf16*)(ws + WS_MIX) + (size_t)(qb * 256 + row) * 2048 + 1280 + h * 64 + c0;
#pragma unroll
                for (int j = 0; j < 2; ++j) { const f32x4 x0 = *(const f32x4*)(p0 + 8 * j), x1 = *(const f32x4*)(p0 + 8 * j + 4), y0 = *(const f32x4*)(p1 + 8 * j), y1 = *(const f32x4*)(p1 + 8 * j + 4);
                    const f32x4 r0 = x0 * a0 + y0 * a1, r1 = x1 * a0 + y1 * a1; v4u o; o.x = pk2(r0.x, r0.y); o.y = pk2(r0.z, r0.w); o.z = pk2(r1.x, r1.y); o.w = pk2(r1.z, r1.w);
                    *(v4u*)(op + 8 * j) = o; }
            }
            hg::pass2(GRD(), BID(), (const bf16*)(Bb + WB_BQ), (const _Float16*)(Bb + WB_FF), (const _Float16*)(Bb + WB_FB), (const bf16*)(Bb + WB_BI), (const bf16*)(Bb + WB_SG), (const bf16*)(ws + WS_SS), INP(13) + l * 128, (bf16*)(ws + WS_MIX), F0.lds + RING_OFF); }
        PH_END;
        if (PH_ON) { unsigned char* ws = WSL(); const unsigned char* wl = ws + WS_W + (size_t)l * W_LAYER;
            pg8::Gemm g{(const bf16*)(ws + WS_MIX), (const bf16*)(wl + W_WOUT), S, DM, DM}; pg8::StaticOrder so; so.init(S, DM, GRD(), BID());
            pg8::EpiBf16Y E{(bf16*)(ws + WS_Y), DM}; pg8::gemm_phase<pg8::EpiBf16Y, pg8::StaticOrder, false, true>(F0.lds + RING_OFF, g, so, E); }
        PH_END;
        if (PH_ON) { PHASE_FRAME(); unsigned char* ws = WSL(); const float* nw = INP(9) + (size_t)l * 6 * DM;
            if ((I8_GU2_MASK >> l) & 1u) row_phase<false, false, 2>(F, ws + WS_X, (const bf16*)(ws + WS_Y), ws + WS_X, (bf16*)(ws + WS_H), nw + 3 * DM, nw + 4 * DM, 1.0f, F.vcu * NWAVES + F.wave, F.G * NWAVES, (float*)(ws + WS_TAB + TAB_HS));
            else row_phase<false, false, 0>(F, ws + WS_X, (const bf16*)(ws + WS_Y), ws + WS_X, (bf16*)(ws + WS_H), nw + 3 * DM, nw + 4 * DM, 1.0f, F.vcu * NWAVES + F.wave, F.G * NWAVES); }
        PH_END;
        if (PH_ON) { unsigned char* ws = WSL(); const unsigned char* wl = ws + WS_W + (size_t)l * W_LAYER;
            pg8::StaticOrder so; so.init(S, NGU, GRD(), BID());
            if ((I8_GU2_MASK >> l) & 1u) { pg8::Gemm g{(const bf16*)(ws + WS_H), (const bf16*)(wl + W_GU2), S, NGU, DM / 2};
                const float* hs = (const float*)(ws + WS_TAB + TAB_HS); const float* wsc = (const float*)(ws + WS_TAB + TAB_WSC) + l * 4 + 2;
                if ((F8_DN2_MASK >> l) & 1u) { EpiI8o8 E{(bf16*)(ws + WS_ACT), DFF, hs, wsc[0], wsc[1]}; pg8::gemm_phase<EpiI8o8, pg8::StaticOrder, true, true, 2>(F0.lds + RING_OFF, g, so, E); }
                else { EpiI8 E{(bf16*)(ws + WS_ACT), DFF, hs, wsc[0], wsc[1]}; pg8::gemm_phase<EpiI8, pg8::StaticOrder, true, true, 2>(F0.lds + RING_OFF, g, so, E); } }
            else { pg8::Gemm g{(const bf16*)(ws + WS_H), (const bf16*)(wl + W_GU2), S, NGU, DM};
                pg8::EpiSwiGLU E{(bf16*)(ws + WS_ACT), DFF}; pg8::gemm_phase<pg8::EpiSwiGLU, pg8::StaticOrder, true, true>(F0.lds + RING_OFF, g, so, E); }
            IDLE_PULL(0, 2, ((I8_GU2_MASK >> l) & 1u) ? 11 : CONV_K); }
        PH_END;
        if (PH_ON) { unsigned char* ws = WSL(); const unsigned char* wl = ws + WS_W + (size_t)l * W_LAYER;
            pg8::StaticOrder so; so.init(S, DM, GRD(), BID());
            if ((F8_DN2_MASK >> l) & 1u) { pg8::Gemm g{(const bf16*)(ws + WS_ACT), (const bf16*)(wl + W_DN2), S, DM, DFF / 2};
                Epi8DN E{(bf16*)(ws + WS_Y), DM}; pg8::gemm_phase<Epi8DN, pg8::StaticOrder, false, true, 1>(F0.lds + RING_OFF, g, so, E); }
            else { pg8::Gemm g{(const bf16*)(ws + WS_ACT), (const bf16*)(wl + W_DN2), S, DM, DFF};
                pg8::EpiBf16Y E{(bf16*)(ws + WS_Y), DM}; pg8::gemm_phase<pg8::EpiBf16Y, pg8::StaticOrder, false, true>(F0.lds + RING_OFF, g, so, E); } }
        PH_END;
        if (PH_ON) { PHASE_FRAME(); unsigned char* ws = WSL(); const float* nw = INP(9) + (size_t)l * 6 * DM; const bool lastl = (l == NL - 1);
            { const int g_ = GRD(); LAS float* scr_ = (LAS float*)(F.lds + RING_OFF + F.wave * 16384);
                if (g_ == 256) { const int base_ = CONV_P0 + l * I_LAYER + 3 * CONV_SLOT, end_ = base_ + CONV_R < I_ALL ? base_ + CONV_R : I_ALL;
                    conv_range(CONV_INPUTS, ws, base_ + F.vcu * NWAVES + F.wave, F.G * NWAVES, end_, scr_, F.lane); }
                else if (!lastl) conv_range(CONV_INPUTS, ws, (l + 1) * I_LAYER + F.vcu * NWAVES + F.wave, F.G * NWAVES, (l + 2) * I_LAYER, scr_, F.lane); }
            if (lastl) row_phase<false, true>(F, ws + WS_X, (const bf16*)(ws + WS_Y), (float*)(GAS float*)args.out, (bf16*)nullptr, nw + 5 * DM, nw + 6 * DM, 0.5f, F.vcu * NWAVES + F.wave, F.G * NWAVES);
            else if ((I8_GU1_MASK >> (l + 1)) & 1u) row_phase<false, false, 2>(F, ws + WS_X, (const bf16*)(ws + WS_Y), ws + WS_X, (bf16*)(ws + WS_H), nw + 5 * DM, nw + 6 * DM, 0.5f, F.vcu * NWAVES + F.wave, F.G * NWAVES, (float*)(ws + WS_TAB + TAB_HS));
            else row_phase<false, false>(F, ws + WS_X, (const bf16*)(ws + WS_Y), ws + WS_X, (bf16*)(ws + WS_H), nw + 5 * DM, nw + 6 * DM, 0.5f, F.vcu * NWAVES + F.wave, F.G * NWAVES); }
        PH_END;
    }
#undef PH_ON
#undef PH_END
}
constexpr int N_PHASES = 1 + NL * 12;

extern "C" void kernel_launch(void* const* d_in, const int* in_sizes, int n_in, void* d_out, int out_size, void* d_ws, size_t ws_size, hipStream_t stream) {
    static int grid = 0;
    if (grid == 0) {
        if (n_in != 15 || in_sizes[0] != S * DM || out_size != S * DM || ws_size < WS_END) { fprintf(stderr, "kernel_launch: unexpected shapes / workspace (n_in %d, in0 %d, out %d, ws %zu < %zu); nothing launched\n", n_in, n_in > 0 ? in_sizes[0] : -1, out_size, ws_size, (size_t)WS_END); grid = -1; return; }
        int dev = 0, cus = 0, per_cu = 0;
        if (hipGetDevice(&dev) != hipSuccess || hipDeviceGetAttribute(&cus, hipDeviceAttributeMultiprocessorCount, dev) != hipSuccess) { grid = -1; return; }
        if (hipFuncSetAttribute((const void*)fwd, hipFuncAttributeMaxDynamicSharedMemorySize, LDS_BYTES) != hipSuccess) { fprintf(stderr, "kernel_launch: hipFuncSetAttribute failed\n"); grid = -1; return; }
        if (hipOccupancyMaxActiveBlocksPerMultiprocessor(&per_cu, (const void*)fwd, NWAVES * 64, LDS_BYTES) != hipSuccess || per_cu < 1)
            fprintf(stderr, "kernel_launch: note: occupancy query reports %d workgroups per CU\n", per_cu);
        (void)hipGetLastError();
        grid = cus;
    }
    if (grid < 0) return;
    if (hipMemsetAsync((char*)d_ws + WS_CTL, 0, CTL_ZERO_BYTES, stream) != hipSuccess) { fprintf(stderr, "kernel_launch: memset failed\n"); return; }
    Args a{};
    for (int i = 0; i < 15; ++i) a.in[i] = (const float*)d_in[i];
    a.out = (float*)d_out; a.ws = (unsigned char*)d_ws;
#if MK_SPLIT
    for (int p = 0; p < N_PHASES; ++p) { a.ph_lo = p; a.ph_hi = p + 1; hipLaunchKernelGGL(fwd, dim3(grid), dim3(NWAVES * 64), LDS_BYTES, stream, a); }
#else
    a.ph_lo = 0; a.ph_hi = N_PHASES;
    hipLaunchKernelGGL(fwd, dim3(grid), dim3(NWAVES * 64), LDS_BYTES, stream, a);
#endif
    const hipError_t le = hipPeekAtLastError();
    if (le != hipSuccess) fprintf(stderr, "kernel_launch: launch failed: %s\n", hipGetErrorName(le));
}
```

```cpp
#include <hip/hip_runtime.h>
#include <hip/hip_bf16.h>
#include <cstdio>
#include <cstdint>
#include <cmath>
namespace pg8 {
#define PG8_LAS __attribute__((address_space(3)))
typedef unsigned short bf16_t;
typedef short bf16x8 __attribute__((ext_vector_type(8)));
typedef float f32x4 __attribute__((ext_vector_type(4)));
typedef unsigned u32x4 __attribute__((ext_vector_type(4)));
constexpr int BM = 256, BK = 64, HALF = 128, HTB = HALF * BK * 2  , STAGE_BYTES = 8 * HTB, NXCD = 8, WGM = 4;

__host__ __device__ __forceinline__ int lds_byte(int r, int c) { const int st = (r >> 4) * 2 + (c >> 5), rr = r & 15, cc = c & 31, ob = rr * 64 + cc * 2; return st * 1024 + (ob ^ (((ob >> 9) & 1) << 5)); }
__host__ __device__ __forceinline__ void stage_rc(int b, int& R, int& C) { const int st = b / 1024, sb = b % 1024, swz = sb ^ (((sb >> 9) & 1) << 5); R = (st >> 1) * 16 + swz / 64; C = (st & 1) * 32 + (swz % 64) / 2; }
__host__ __device__ __forceinline__ int perm32(int rho) { const int n = rho >> 4, i = rho & 15; return 8 * (i >> 2) + 4 * n + (i & 3); }

struct Unit { int pm, pn; };
struct Gemm { const bf16_t* A; const bf16_t* Bt; int M, N, K; };

struct StaticOrder {
    int nM, nN, nwg, G, c, wgm;
    __host__ __device__ void init(int M, int N, int G_, int c_, int wgm_ = WGM) { nM = M / BM; nN = N / BM; nwg = nM * nN; G = G_; c = c_; wgm = wgm_; }
    __host__ __device__ bool next(int i, Unit& u) const {
        const long L = (long)i * G + c; if (L >= nwg) return false;
        int wgid = (int)L; { const int q = nwg / NXCD, r = nwg % NXCD, xcd = wgid % NXCD, off = wgid / NXCD; wgid = (xcd < r ? xcd * (q + 1) : r * (q + 1) + (xcd - r) * q) + off; }
        const int nig = wgm * nN, gid = wgid / nig, fm = gid * wgm, gsz = (nM - fm) < wgm ? (nM - fm) : wgm;
        u.pm = fm + ((wgid % nig) % gsz); u.pn = (wgid % nig) / gsz; return true;
    }
    __device__ __forceinline__ void a_ready(const Unit&) const {}
    __device__ __forceinline__ void done(const Unit&) const {}
};

__device__ __forceinline__ unsigned cvt_pk_bf16(float lo, float hi) { unsigned r; asm volatile("v_cvt_pk_bf16_f32 %0, %1, %2" : "=v"(r) : "v"(lo), "v"(hi)); return r; }
typedef float f32x2 __attribute__((ext_vector_type(2)));
constexpr float LOG2E = 1.4426950408889634f;
constexpr float QSCALE = 0.125f * 1.4426950408889634f;
__device__ __forceinline__ float sigmoid_f(float x) { return __builtin_amdgcn_rcpf(1.0f + __builtin_amdgcn_exp2f(-LOG2E * x)); }

struct EpiF32 {
    static constexpr bool PERM = false, AFTER_DRAIN = false;
    float* C; int ldc;
    __device__ __forceinline__ void operator()(const f32x4 (&acc)[2][2][4][2], const Unit& u, int wr, int wc, int fr, int fq) const {
        const int row0 = u.pm * BM + wr * 64 + fr, col0 = u.pn * BM + wc * 32 + 4 * fq;
#pragma unroll
        for (int ai = 0; ai < 2; ++ai)
#pragma unroll
            for (int m = 0; m < 4; ++m) { float* rowp = C + (size_t)(row0 + ai * HALF + m * 16) * ldc + col0;
#pragma unroll
                for (int bj = 0; bj < 2; ++bj)
#pragma unroll
                    for (int n = 0; n < 2; ++n) *(f32x4*)(rowp + bj * HALF + n * 16) = acc[ai][bj][m][n]; }
    }
};


__device__ __forceinline__ unsigned pk4_e4m3(float a, float b, float c, float d) {
    a = __builtin_amdgcn_fmed3f(a, -448.f, 448.f); b = __builtin_amdgcn_fmed3f(b, -448.f, 448.f); c = __builtin_amdgcn_fmed3f(c, -448.f, 448.f); d = __builtin_amdgcn_fmed3f(d, -448.f, 448.f);
    int w = 0; w = __builtin_amdgcn_cvt_pk_fp8_f32(a, b, w, false); w = __builtin_amdgcn_cvt_pk_fp8_f32(c, d, w, true); return (unsigned)w;
}
template <int SCL2> struct EpiBf16YT {
    static constexpr bool PERM = true, AFTER_DRAIN = false;
    static constexpr float GS = 1.0f / (float)(1u << SCL2);
    bf16_t* O; int ldc;
    __device__ __forceinline__ void operator()(const f32x4 (&acc)[2][2][4][2], const Unit& u, int wr, int wc, int fr, int fq) const {
        const int row0 = u.pm * BM + wr * 64 + fr, col0 = u.pn * BM + wc * 32 + 8 * fq;
#pragma unroll
        for (int ai = 0; ai < 2; ++ai)
#pragma unroll
            for (int m = 0; m < 4; ++m) { bf16_t* rowp = O + (size_t)(row0 + ai * HALF + m * 16) * ldc + col0;
#pragma unroll
                for (int bj = 0; bj < 2; ++bj) { f32x4 v0 = acc[ai][bj][m][0], v1 = acc[ai][bj][m][1]; if constexpr (SCL2 != 0) { v0 = v0 * GS; v1 = v1 * GS; }
                    u32x4 w; w.x = cvt_pk_bf16(v0[0], v0[1]); w.y = cvt_pk_bf16(v0[2], v0[3]); w.z = cvt_pk_bf16(v1[0], v1[1]); w.w = cvt_pk_bf16(v1[2], v1[3]);
                    *(u32x4*)(rowp + bj * HALF) = w; } }
    }
};
typedef EpiBf16YT<0> EpiBf16Y;

template <int SCL2, int O8 = -1> struct EpiSwiGLUT {
    static constexpr bool PERM = true, AFTER_DRAIN = false;
    static constexpr float GS = 1.0f / (float)(1u << SCL2), PC = (float)(1u << SCL2) * (float)(1u << SCL2) / (float)(1u << (O8 < 0 ? 0 : O8));
    bf16_t* O; int ldc;
    __device__ __forceinline__ void operator()(const f32x4 (&acc)[2][2][4][2], const Unit& u, int wr, int wc, int fr, int fq) const {
        const int row0 = u.pm * BM + wr * 64 + fr, col0 = u.pn * HALF + wc * 32 + 8 * fq;
#pragma unroll
        for (int ai = 0; ai < 2; ++ai)
#pragma unroll
            for (int m = 0; m < 4; ++m) { bf16_t* rowp = O + (size_t)(row0 + ai * HALF + m * 16) * ldc + col0;
                float o[8];
                { float g[8], t[8];
#pragma unroll
                  for (int n = 0; n < 2; ++n)
#pragma unroll
                      for (int i = 0; i < 4; ++i) { g[4 * n + i] = acc[ai][0][m][n][i]; o[4 * n + i] = g[4 * n + i] * acc[ai][1][m][n][i]; }
#pragma unroll
                  for (int i = 0; i < 8; ++i) t[i] = (-LOG2E * GS) * g[i];
#pragma unroll
                  for (int i = 0; i < 8; ++i) t[i] = __builtin_amdgcn_exp2f(t[i]);
#pragma unroll
                  for (int i = 0; i < 8; ++i) { if constexpr (SCL2 == 0 && O8 < 0) t[i] = 1.0f + t[i]; else t[i] = __builtin_fmaf(t[i], PC, PC); }
#pragma unroll
                  for (int i = 0; i < 8; ++i) t[i] = __builtin_amdgcn_rcpf(t[i]);
#pragma unroll
                  for (int i = 0; i < 8; ++i) o[i] *= t[i]; }
                if constexpr (O8 >= 0) { typedef unsigned u32x2_t __attribute__((ext_vector_type(2))); u32x2_t w; w.x = pk4_e4m3(o[0], o[1], o[2], o[3]); w.y = pk4_e4m3(o[4], o[5], o[6], o[7]);
                    *(u32x2_t*)((unsigned char*)O + (size_t)(row0 + ai * HALF + m * 16) * ldc + col0) = w; }
                else { u32x4 w; w.x = cvt_pk_bf16(o[0], o[1]); w.y = cvt_pk_bf16(o[2], o[3]); w.z = cvt_pk_bf16(o[4], o[5]); w.w = cvt_pk_bf16(o[6], o[7]);
                    *(u32x4*)rowp = w; } }
    }
};
typedef EpiSwiGLUT<0> EpiSwiGLU;
template <int O8> struct EpiSwiGLUI8 {
    static constexpr bool PERM = true, AFTER_DRAIN = false;
    static constexpr float OS = (float)(1u << (O8 < 0 ? 0 : O8));
    bf16_t* O; int ldc; const float* hs; float wg, wu;
    __device__ __forceinline__ void operator()(const f32x4 (&acc)[2][2][4][2], const Unit& u, int wr, int wc, int fr, int fq) const {
        const int row0 = u.pm * BM + wr * 64 + fr, col0 = u.pn * HALF + wc * 32 + 8 * fq;
        float hv[8];
#pragma unroll
        for (int q = 0; q < 8; ++q) hv[q] = hs[row0 + (q >> 2) * HALF + (q & 3) * 16];
#pragma unroll
        for (int ai = 0; ai < 2; ++ai)
#pragma unroll
            for (int m = 0; m < 4; ++m) { const int row = row0 + ai * HALF + m * 16; const float h = hv[ai * 4 + m];
                const float c1 = -LOG2E * h * wg, pc = __builtin_amdgcn_rcpf(h * h * wg * wu * OS);
                float o[8];
                { float g[8], t[8];
#pragma unroll
                  for (int n = 0; n < 2; ++n)
#pragma unroll
                      for (int i = 0; i < 4; ++i) { const float fg = acc[ai][0][m][n][i], fu = acc[ai][1][m][n][i];
                          g[4 * n + i] = (float)__float_as_int(fg); o[4 * n + i] = g[4 * n + i] * (float)__float_as_int(fu); }
#pragma unroll
                  for (int i = 0; i < 8; ++i) t[i] = c1 * g[i];
#pragma unroll
                  for (int i = 0; i < 8; ++i) t[i] = __builtin_amdgcn_exp2f(t[i]);
#pragma unroll
                  for (int i = 0; i < 8; ++i) t[i] = __builtin_fmaf(t[i], pc, pc);
#pragma unroll
                  for (int i = 0; i < 8; ++i) t[i] = __builtin_amdgcn_rcpf(t[i]);
#pragma unroll
                  for (int i = 0; i < 8; ++i) o[i] *= t[i]; }
                if constexpr (O8 >= 0) { typedef unsigned u32x2_t __attribute__((ext_vector_type(2))); u32x2_t w; w.x = pk4_e4m3(o[0], o[1], o[2], o[3]); w.y = pk4_e4m3(o[4], o[5], o[6], o[7]);
                    *(u32x2_t*)((unsigned char*)O + (size_t)row * ldc + col0) = w; }
                else { u32x4 w; w.x = cvt_pk_bf16(o[0], o[1]); w.y = cvt_pk_bf16(o[2], o[3]); w.z = cvt_pk_bf16(o[4], o[5]); w.w = cvt_pk_bf16(o[6], o[7]);
                    *(u32x4*)(O + (size_t)row * ldc + col0) = w; } }
    }
};

struct EpiWin {
    static constexpr bool PERM = true, AFTER_DRAIN = false;
    bf16_t *AQ, *AK, *AV, *CQ, *CK, *CV;
    unsigned char* Bb;
    const float* lb;
    const float* qkw;
    const float* rtab; const float* ctab;
    __device__ __forceinline__ void operator()(const f32x4 (&acc)[2][2][4][2], const Unit& u, int wr, int wc, int fr, int fq) const {
        const int pn = u.pn, row0 = u.pm * BM + wr * 64 + fr, cl = wc * 32 + 8 * fq;
        if (pn < 5 || pn == 19) {
            bf16_t* base; int ldc, colt; float sc = 1.f;
            if (pn < 3) { base = AQ; ldc = 768; colt = pn * 256; sc = QSCALE; } else if (pn == 3) { base = AK; ldc = 256; colt = 0; } else if (pn == 4) { base = AV; ldc = 256; colt = 0; } else { base = CV; ldc = 256; colt = 0; }
#pragma unroll
            for (int ai = 0; ai < 2; ++ai)
#pragma unroll
                for (int m = 0; m < 4; ++m) { bf16_t* rowp = base + (size_t)(row0 + ai * HALF + m * 16) * ldc + colt + cl;
#pragma unroll
                    for (int bj = 0; bj < 2; ++bj) { const f32x4 v0 = acc[ai][bj][m][0] * sc, v1 = acc[ai][bj][m][1] * sc;
                        u32x4 w; w.x = cvt_pk_bf16(v0[0], v0[1]); w.y = cvt_pk_bf16(v0[2], v0[3]); w.z = cvt_pk_bf16(v1[0], v1[1]); w.w = cvt_pk_bf16(v1[2], v1[3]);
                        *(u32x4*)(rowp + bj * HALF) = w; } }
        } else if (pn < 15) {
            const int sec = (pn - 5) >> 1, colt = ((pn - 5) & 1) * 256;
            if (sec == 1 || sec == 2) {
                float* o2 = (float*)(Bb + ((size_t)(sec + 1) << 24)); const float* lbp = lb + (sec == 2 ? 512 : 0);
#pragma unroll
                for (int bj = 0; bj < 2; ++bj) { const int col = colt + bj * HALF + cl;
                    const f32x4 lv0 = *(const f32x4*)(lbp + col), lv1 = *(const f32x4*)(lbp + col + 4);
#pragma unroll
                    for (int ai = 0; ai < 2; ++ai)
#pragma unroll
                        for (int m = 0; m < 4; ++m) { const size_t off = (size_t)(row0 + ai * HALF + m * 16) * 512 + col;
                            const f32x4 a0 = acc[ai][bj][m][0], a1 = acc[ai][bj][m][1]; f32x4 f0, f1;
#pragma unroll
                            for (int i = 0; i < 4; ++i) { f0[i] = lv0[i] + (1.f - lv0[i]) * sigmoid_f(a0[i]); f1[i] = lv1[i] + (1.f - lv1[i]) * sigmoid_f(a1[i]); }
                            typedef _Float16 h16x8_t __attribute__((ext_vector_type(8))); typedef float f32x8_t __attribute__((ext_vector_type(8)));
                            const f32x8_t f8 = {f0[0], f0[1], f0[2], f0[3], f1[0], f1[1], f1[2], f1[3]};
                            *(h16x8_t*)((_Float16*)o2 + off) = __builtin_convertvector(f8, h16x8_t); } }
            } else {
                bf16_t* o1 = (bf16_t*)(Bb + ((size_t)(sec == 0 ? 0 : sec - 2) << 23));
#pragma unroll
                for (int bj = 0; bj < 2; ++bj) { const int col = colt + bj * HALF + cl;
#pragma unroll
                    for (int ai = 0; ai < 2; ++ai)
#pragma unroll
                        for (int m = 0; m < 4; ++m) { const size_t off = (size_t)(row0 + ai * HALF + m * 16) * 512 + col;
                            f32x4 a0 = acc[ai][bj][m][0], a1 = acc[ai][bj][m][1];
                            if (sec != 3) {
#pragma unroll
                                for (int i = 0; i < 4; ++i) { a0[i] = a0[i] * sigmoid_f(a0[i]); a1[i] = a1[i] * sigmoid_f(a1[i]); } }
                            u32x4 w; w.x = cvt_pk_bf16(a0[0], a0[1]); w.y = cvt_pk_bf16(a0[2], a0[3]); w.z = cvt_pk_bf16(a1[0], a1[1]); w.w = cvt_pk_bf16(a1[2], a1[3]);
                            *(u32x4*)(o1 + off) = w; } }
            }
        } else {
            const bool isq = pn < 18; bf16_t* base = isq ? CQ : CK; const int ldc = isq ? 768 : 256, head = (isq ? (pn - 15) * 4 : 0) + wc;
            const float* w = qkw + (isq ? 0 : 64); const float sc = isq ? QSCALE : 1.f;
            f32x4 wv[2][2];
#pragma unroll
            for (int bj = 0; bj < 2; ++bj)
#pragma unroll
                for (int n = 0; n < 2; ++n) wv[bj][n] = *(const f32x4*)(w + 32 * bj + 8 * fq + 4 * n) * sc;
#pragma unroll
            for (int ai = 0; ai < 2; ++ai)
#pragma unroll
                for (int m = 0; m < 4; ++m) { const int row = row0 + ai * HALF + m * 16;
                    float ss = 0.f;
#pragma unroll
                    for (int bj = 0; bj < 2; ++bj)
#pragma unroll
                        for (int n = 0; n < 2; ++n) { const f32x4 x = acc[ai][bj][m][n]; ss += (x[0] * x[0] + x[1] * x[1]) + (x[2] * x[2] + x[3] * x[3]); }
                    ss += __shfl_xor(ss, 16); ss += __shfl_xor(ss, 32);
                    const float r = __builtin_amdgcn_rsqf(ss * (1.0f / 64.0f) + 1e-6f);
                    bf16_t* rowp = base + (size_t)row * ldc + head * 64 + 8 * fq;
                    f32x4 csv[2][2];
#pragma unroll
                    for (int bj = 0; bj < 2; ++bj) { const float* tab = bj == 0 ? rtab + (size_t)(row >> 6) * 32 : ctab + (size_t)(row & 63) * 32;
#pragma unroll
                        for (int n = 0; n < 2; ++n) csv[bj][n] = *(const f32x4*)(tab + (4 * fq + 2 * n) * 2); }
#pragma unroll
                    for (int bj = 0; bj < 2; ++bj) {
                        float o[8];
#pragma unroll
                        for (int n = 0; n < 2; ++n) { const f32x4 x = acc[ai][bj][m][n] * r * wv[bj][n]; const f32x4 cs = csv[bj][n];
                            o[4 * n + 0] = x[0] * cs[0] - x[1] * cs[1]; o[4 * n + 1] = x[0] * cs[1] + x[1] * cs[0];
                            o[4 * n + 2] = x[2] * cs[2] - x[3] * cs[3]; o[4 * n + 3] = x[2] * cs[3] + x[3] * cs[2]; }
                        u32x4 wd; wd.x = cvt_pk_bf16(o[0], o[1]); wd.y = cvt_pk_bf16(o[2], o[3]); wd.z = cvt_pk_bf16(o[4], o[5]); wd.w = cvt_pk_bf16(o[6], o[7]);
                        *(u32x4*)(rowp + 32 * bj) = wd; } }
        }
    }
};
typedef int i32x8 __attribute__((ext_vector_type(8))); typedef int i32x4 __attribute__((ext_vector_type(4)));
template <class Epi, class Sched, bool ALIGN_EPI = false, bool SP2 = false, int F8 = 0>
__device__ __forceinline__ void gemm_phase(PG8_LAS unsigned char* lds, const Gemm g, const Sched& S, const Epi& E) {
    int tid_l = threadIdx.x; asm volatile("" : "+v"(tid_l)); const int tid = tid_l, wid = __builtin_amdgcn_readfirstlane(tid >> 6), lane = tid & 63, wr = wid >> 2, wc = wid & 3, fr = lane & 15, fq = lane >> 4;
    const int K = g.K, nt = K / BK;
    unsigned voffA[2], voffB[2];
#pragma unroll
    for (int i = 0; i < 2; ++i) { int R, C; stage_rc(tid * 16 + i * 8192, R, C); const int Rb = Epi::PERM ? ((R & ~31) + perm32(R & 31)) : R;
        voffA[i] = (unsigned)(R * K + C) * 2u; voffB[i] = (unsigned)(Rb * K + C) * 2u; }
    const size_t kstep = (size_t)(BK * 2);
    const size_t hstep = (size_t)HALF * K * 2;
    const size_t tstep = 2 * hstep;
    const unsigned ldsw = (unsigned)wid * 1024u;
    const int aoff = lds_byte(wr * 64 + fr, fq * 8), boff = lds_byte(wc * 32 + fr, fq * 8);
#define PG8_SA(b, h) (((b) * 2 + (h)) * HTB)
#define PG8_SB(b, h) ((4 + (b) * 2 + (h)) * HTB)
#define PG8_STAGE(bufoff, gbase, voff) do { _Pragma("unroll") for (int _i = 0; _i < 2; ++_i) \
        __builtin_amdgcn_global_load_lds((const unsigned*)((const char*)(gbase) + (voff)[_i]), (PG8_LAS unsigned*)(lds + (bufoff) + ldsw + _i * 8192), 16, 0, 0); } while (0)
#define PG8_J8(x, y) __builtin_shufflevector(__builtin_bit_cast(i32x4, x), __builtin_bit_cast(i32x4, y), 0, 1, 2, 3, 4, 5, 6, 7)
#define PG8_LDA(dst, b, h) do { _Pragma("unroll") for (int m = 0; m < 4; ++m) _Pragma("unroll") for (int k = 0; k < 2; ++k) dst[m][k] = *(const PG8_LAS bf16x8*)(lds + PG8_SA(b, h) + aoff + m * 2048 + k * 1024); \
        if constexpr (F8 == 1) { _Pragma("unroll") for (int m = 0; m < 4; ++m) dst##8[m] = PG8_J8(dst[m][0], dst[m][1]); } } while (0)
#define PG8_LDB(dst, b, h) do { _Pragma("unroll") for (int n = 0; n < 2; ++n) _Pragma("unroll") for (int k = 0; k < 2; ++k) dst[n][k] = *(const PG8_LAS bf16x8*)(lds + PG8_SB(b, h) + boff + n * 2048 + k * 1024); \
        if constexpr (F8 == 1) { _Pragma("unroll") for (int n = 0; n < 2; ++n) dst##8[n] = PG8_J8(dst[n][0], dst[n][1]); } } while (0)
#define PG8_MMA(ai, bj, At, Bt) do { __builtin_amdgcn_s_setprio(1); \
        if constexpr (F8 == 2) { _Pragma("unroll") for (int m = 0; m < 4; ++m) _Pragma("unroll") for (int n = 0; n < 2; ++n) _Pragma("unroll") for (int k = 0; k < 2; ++k) asm volatile("v_mfma_i32_16x16x64_i8 %0, %1, %2, %0" : "+v"(acc[ai][bj][m][n]) : "v"(Bt[n][k]), "v"(At[m][k])); } \
        else if constexpr (F8 == 1) { _Pragma("unroll") for (int m = 0; m < 4; ++m) _Pragma("unroll") for (int n = 0; n < 2; ++n) asm volatile("v_mfma_f32_16x16x128_f8f6f4 %0, %1, %2, %0" : "+v"(acc[ai][bj][m][n]) : "v"(Bt##8[n]), "v"(At##8[m])); } \
        else { _Pragma("unroll") for (int m = 0; m < 4; ++m) _Pragma("unroll") for (int n = 0; n < 2; ++n) _Pragma("unroll") for (int k = 0; k < 2; ++k) \
        acc[ai][bj][m][n] = __builtin_amdgcn_mfma_f32_16x16x32_bf16(Bt[n][k], At[m][k], acc[ai][bj][m][n], 0, 0, 0); } __builtin_amdgcn_s_setprio(0); } while (0)
#define PG8_WAIT_V(n) asm volatile("s_waitcnt vmcnt(" #n ")" ::: "memory")
#define PG8_WAIT_L(n) asm volatile("s_waitcnt lgkmcnt(" #n ")" ::: "memory")
#define PG8_BAR __builtin_amdgcn_s_barrier()
#define PG8_SCHED __builtin_amdgcn_sched_barrier(0)
    Unit cur, nxt; int ui = 0;
    if (!S.next(0, cur)) return;
    f32x4 acc[2][2][4][2];
#pragma unroll
    for (int a = 0; a < 2; ++a)
#pragma unroll
        for (int b = 0; b < 2; ++b)
#pragma unroll
            for (int m = 0; m < 4; ++m)
#pragma unroll
                for (int n = 0; n < 2; ++n) acc[a][b][m][n] = (f32x4){0.f, 0.f, 0.f, 0.f};
    bf16x8 At[4][2], B0[2][2], B1[2][2]; i32x8 At8[4], B08[2], B18[2];
    const char* cA = (const char*)g.A + (size_t)cur.pm * tstep; const char* cB = (const char*)g.Bt + (size_t)cur.pn * tstep;
    S.a_ready(cur);
    if constexpr (SP2) {
        PG8_STAGE(PG8_SB(0, 0), cB, voffB); PG8_STAGE(PG8_SB(0, 1), cB + hstep, voffB); PG8_STAGE(PG8_SA(0, 0), cA, voffA); PG8_STAGE(PG8_SA(0, 1), cA + hstep, voffA);
        PG8_STAGE(PG8_SB(1, 0), cB + kstep, voffB); PG8_STAGE(PG8_SA(1, 0), cA + kstep, voffA); PG8_STAGE(PG8_SB(1, 1), cB + hstep + kstep, voffB);
        if (wr == 1) PG8_BAR;
        PG8_WAIT_V(8); PG8_BAR;
        PG8_WAIT_V(6); PG8_BAR;
    } else {
        PG8_STAGE(PG8_SB(0, 0), cB, voffB); PG8_STAGE(PG8_SA(0, 0), cA, voffA); PG8_STAGE(PG8_SB(0, 1), cB + hstep, voffB); PG8_STAGE(PG8_SA(0, 1), cA + hstep, voffA);
        if (wr == 1) PG8_BAR;
        PG8_WAIT_V(4); PG8_BAR;
        PG8_STAGE(PG8_SB(1, 0), cB + kstep, voffB); PG8_STAGE(PG8_SA(1, 0), cA + kstep, voffA); PG8_STAGE(PG8_SB(1, 1), cB + hstep + kstep, voffB);
        PG8_WAIT_V(6); PG8_BAR;
    }
    for (;;) {
        const bool has_next = S.next(ui + 1, nxt);
        const char* nA = has_next ? (const char*)g.A + (size_t)nxt.pm * tstep : cA; const char* nB = has_next ? (const char*)g.Bt + (size_t)nxt.pn * tstep : cB;
        for (int t = 0; t < nt; t += 2) {
            const bool last = (t == nt - 2);
            const char* a1 = cA + (size_t)(t + 1) * kstep;
            const char* a2 = last ? nA : cA + (size_t)(t + 2) * kstep; const char* b2 = last ? nB : cB + (size_t)(t + 2) * kstep;
            const char* a3 = a2 + kstep; const char* b3 = b2 + kstep;
            if (last && has_next) S.a_ready(nxt);
            if constexpr (SP2) {
            PG8_LDB(B0, 0, 0); PG8_LDB(B1, 0, 1); PG8_SCHED; PG8_LDA(At, 0, 0); PG8_STAGE(PG8_SA(1, 1), a1 + hstep, voffA);
            PG8_WAIT_V(8); PG8_WAIT_L(0); PG8_BAR; PG8_MMA(0, 0, At, B0); PG8_MMA(0, 1, At, B1); PG8_BAR; PG8_SCHED;
            PG8_LDA(At, 0, 1); PG8_STAGE(PG8_SB(0, 0), b2, voffB); PG8_STAGE(PG8_SB(0, 1), b2 + hstep, voffB); PG8_STAGE(PG8_SA(0, 0), a2, voffA);
            PG8_WAIT_V(8); PG8_WAIT_L(0); PG8_BAR; PG8_MMA(1, 0, At, B0); PG8_MMA(1, 1, At, B1); PG8_BAR; PG8_SCHED;
            PG8_LDB(B0, 1, 0); PG8_LDB(B1, 1, 1); PG8_SCHED; PG8_LDA(At, 1, 0); PG8_STAGE(PG8_SA(0, 1), a2 + hstep, voffA);
            PG8_WAIT_V(8); PG8_WAIT_L(0); PG8_BAR; PG8_MMA(0, 0, At, B0); PG8_MMA(0, 1, At, B1); PG8_BAR; PG8_SCHED;
            PG8_LDA(At, 1, 1); PG8_STAGE(PG8_SB(1, 0), b3, voffB); PG8_STAGE(PG8_SB(1, 1), b3 + hstep, voffB); PG8_STAGE(PG8_SA(1, 0), a3, voffA);
            PG8_WAIT_V(8); PG8_WAIT_L(0); PG8_BAR; PG8_MMA(1, 0, At, B0); PG8_MMA(1, 1, At, B1); PG8_BAR; PG8_SCHED;
            } else {
            PG8_LDB(B0, 0, 0); PG8_SCHED; PG8_LDA(At, 0, 0); PG8_STAGE(PG8_SA(1, 1), a1 + hstep, voffA);
            PG8_WAIT_L(8); PG8_BAR; PG8_WAIT_L(0); PG8_MMA(0, 0, At, B0); PG8_BAR; PG8_SCHED;
            PG8_LDB(B1, 0, 1); PG8_STAGE(PG8_SB(0, 0), b2, voffB);
            PG8_BAR; PG8_WAIT_L(0); PG8_MMA(0, 1, At, B1); PG8_BAR;
            PG8_LDA(At, 0, 1); PG8_STAGE(PG8_SA(0, 0), a2, voffA);
            PG8_BAR; PG8_WAIT_L(0); PG8_MMA(1, 0, At, B0); PG8_BAR; PG8_SCHED;
            PG8_STAGE(PG8_SB(0, 1), b2 + hstep, voffB);
            PG8_WAIT_V(6); PG8_BAR; PG8_MMA(1, 1, At, B1); PG8_BAR;
            PG8_LDB(B0, 1, 0); PG8_SCHED; PG8_LDA(At, 1, 0); PG8_STAGE(PG8_SA(0, 1), a2 + hstep, voffA);
            PG8_WAIT_L(8); PG8_BAR; PG8_WAIT_L(0); PG8_MMA(0, 0, At, B0); PG8_BAR; PG8_SCHED;
            PG8_LDB(B1, 1, 1); PG8_STAGE(PG8_SB(1, 0), b3, voffB);
            PG8_BAR; PG8_WAIT_L(0); PG8_MMA(0, 1, At, B1); PG8_BAR;
            PG8_LDA(At, 1, 1); PG8_STAGE(PG8_SA(1, 0), a3, voffA);
            PG8_BAR; PG8_WAIT_L(0); PG8_MMA(1, 0, At, B0); PG8_BAR; PG8_SCHED;
            PG8_STAGE(PG8_SB(1, 1), b3 + hstep, voffB);
            PG8_WAIT_V(6); PG8_BAR; PG8_MMA(1, 1, At, B1); PG8_BAR;
            }
        }
        if constexpr (F8 != 0) asm volatile("s_nop 15\n\ts_nop 7" ::: "memory");
        if constexpr (ALIGN_EPI) { if (wr == 0) PG8_BAR; }
        if constexpr (!Epi::AFTER_DRAIN) { E(acc, cur, wr, wc, fr, fq); S.done(cur); }
        if (!has_next) break;
#pragma unroll
        for (int a = 0; a < 2; ++a)
#pragma unroll
            for (int b = 0; b < 2; ++b)
#pragma unroll
                for (int m = 0; m < 4; ++m)
#pragma unroll
                    for (int n = 0; n < 2; ++n) acc[a][b][m][n] = (f32x4){0.f, 0.f, 0.f, 0.f};
        cur = nxt; cA = nA; cB = nB; ++ui;
        if constexpr (ALIGN_EPI) { if (wr == 1) PG8_BAR; }
    }
    PG8_WAIT_V(0);
    if constexpr (!ALIGN_EPI) { if (wr == 0) PG8_BAR; }
    PG8_BAR;
    if constexpr (Epi::AFTER_DRAIN) { E.fused(acc, cur, wr, wc, fr, fq, lds, wid, lane); S.done(cur); }
#undef PG8_SA
#undef PG8_SB
#undef PG8_STAGE
#undef PG8_LDA
#undef PG8_LDB
#undef PG8_MMA
#undef PG8_WAIT_V
#undef PG8_WAIT_L
#undef PG8_BAR
#undef PG8_SCHED
}
}

#include <hip/hip_bf16.h>
#include <cmath>
namespace attn_body {
using bf16=__hip_bfloat16;
using bf16x8=__attribute__((ext_vector_type(8)))short;
using s16x4=__attribute__((ext_vector_type(4)))short;
using f32x16=__attribute__((ext_vector_type(16)))float;
using u32x4=__attribute__((ext_vector_type(4)))unsigned;
constexpr int SEQ=8192,D=64;
constexpr int NW=8,QBLK=32,QB=QBLK*NW,KVBLK=64;
constexpr int ATTN_UNIT_ROWS=QB;
__device__ __forceinline__ int crow(int r,int hi){return (r&3)+8*(r>>2)+4*hi;}
#define SBAR() __builtin_amdgcn_sched_barrier(0)
__device__ __forceinline__ void cmask(f32x16&p0,f32x16&p1,int jb,int qrel,int hi){
  const float NEG=-INFINITY; int kb=64*jb+4*hi;
  #pragma unroll
  for(int r=0;r<16;++r){int kv=kb+(r&3)+8*(r>>2); if(kv>qrel)p0[r]=NEG; if(kv+32>qrel)p1[r]=NEG;}
}

constexpr int NSLOT=3, SLOTB=8192;
constexpr int LDS_K=0, LDS_V=NSLOT*SLOTB, LDS_WS=2*NSLOT*SLOTB, LDS_OST=LDS_WS+NW*64*4, LDS_BYTES=LDS_OST+NW*4096;
typedef float f32x4_t __attribute__((ext_vector_type(4)));
constexpr int LDS_TB=LDS_BYTES;
constexpr int TBN=776;
template<int MODE> __device__ __forceinline__ void wmask(f32x16&p0,f32x16&p1,const __attribute__((address_space(3))) float*tp){
  if constexpr(MODE==1){
    #pragma unroll
    for(int j=0;j<4;++j){ const f32x4_t a=*(const __attribute__((address_space(3))) f32x4_t*)(tp+8*j), b=*(const __attribute__((address_space(3))) f32x4_t*)(tp+8*j+32);
      #pragma unroll
      for(int i=0;i<4;++i){ p0[4*j+i]+=a[i]; p1[4*j+i]+=b[i]; } } }
}
constexpr float C2=0.125f*1.4426950408889634f;
__device__ __forceinline__ void glds16(const void*gsrc,unsigned lds_dst){unsigned keep;
  asm volatile("s_mov_b32 %0, m0\n\ts_mov_b32 m0, %2\n\ts_nop 0\n\tglobal_load_lds_dwordx4 %1, off\n\ts_mov_b32 m0, %0":"=&s"(keep):"v"(gsrc),"s"(lds_dst):"memory");}
__device__ __forceinline__ float max3f(float a,float b,float c){float r;asm("v_max3_f32 %0, %1, %2, %3":"=v"(r):"v"(a),"v"(b),"v"(c));return r;}
__device__ __forceinline__ float max2f(float a,float b){float r;asm("v_max_f32_e32 %0, %1, %2":"=v"(r):"v"(a),"v"(b));return r;}
__device__ __forceinline__ float fadd_s(float a,float b){float r;asm("v_add_f32_e32 %0, %1, %2":"=v"(r):"v"(a),"v"(b));return r;}
__device__ __forceinline__ float fsub_s(float a,float b){float r;asm("v_sub_f32_e32 %0, %1, %2":"=v"(r):"v"(a),"v"(b));return r;}
typedef float f32x2_t __attribute__((ext_vector_type(2))); typedef __bf16 bf16x2_t __attribute__((ext_vector_type(2)));
__device__ __forceinline__ unsigned cvtpk_s(float lo,float hi){f32x2_t v={lo,hi};bf16x2_t b=__builtin_convertvector(v,bf16x2_t);return __builtin_bit_cast(unsigned,b);}
#define WAIT_BAR(N) asm volatile("s_waitcnt vmcnt(" #N ") lgkmcnt(0)\n\ts_barrier":::"memory")

__device__ __forceinline__ void qkt(f32x16&p0,f32x16&p1,const char*Kslot,const bf16x8*qr,const f32x16&negm,int r32,int hi){
  const char*kb=Kslot+hi*1024+r32*16;
  #pragma unroll
  for(int d0=0;d0<4;++d0){
    const bf16x8 b0=*reinterpret_cast<const bf16x8*>(kb+d0*2048);
    const bf16x8 b1=*reinterpret_cast<const bf16x8*>(kb+d0*2048+512);
    if(d0==0){p0=__builtin_amdgcn_mfma_f32_32x32x16_bf16(b0,qr[0],negm,0,0,0);p1=__builtin_amdgcn_mfma_f32_32x32x16_bf16(b1,qr[0],negm,0,0,0);}
    else{p0=__builtin_amdgcn_mfma_f32_32x32x16_bf16(b0,qr[d0],p0,0,0,0);p1=__builtin_amdgcn_mfma_f32_32x32x16_bf16(b1,qr[d0],p1,0,0,0);}}
}
typedef __attribute__((address_space(3))) const char* lds_cptr;
typedef short v4i16_t __attribute__((ext_vector_type(4)));
__device__ __forceinline__ void kload8(bf16x8*kf,lds_cptr kp){
  kf[0]=*(const __attribute__((address_space(3))) bf16x8*)(kp);      kf[1]=*(const __attribute__((address_space(3))) bf16x8*)(kp+512);
  kf[2]=*(const __attribute__((address_space(3))) bf16x8*)(kp+2048); kf[3]=*(const __attribute__((address_space(3))) bf16x8*)(kp+2560);
  kf[4]=*(const __attribute__((address_space(3))) bf16x8*)(kp+4096); kf[5]=*(const __attribute__((address_space(3))) bf16x8*)(kp+4608);
  kf[6]=*(const __attribute__((address_space(3))) bf16x8*)(kp+6144); kf[7]=*(const __attribute__((address_space(3))) bf16x8*)(kp+6656);
}
__device__ __forceinline__ void kload2(bf16x8*kf,lds_cptr kp,int j){ kf[2*j]=*(const __attribute__((address_space(3))) bf16x8*)(kp+j*2048); kf[2*j+1]=*(const __attribute__((address_space(3))) bf16x8*)(kp+j*2048+512); }
__device__ __forceinline__ s16x4 vtr(lds_cptr p){ return __builtin_bit_cast(s16x4,__builtin_amdgcn_ds_read_tr16_b64_v4i16((__attribute__((address_space(3))) v4i16_t*)p)); }
__device__ __forceinline__ float rowmax(const f32x16&p0,const f32x16&p1){
  float a=max3f(p0[0],p0[1],p1[0]),b=max3f(p0[2],p0[3],p1[1]);a=max3f(a,p1[2],p1[3]);
  #pragma unroll
  for(int r=4;r<16;r+=4){a=max3f(a,p0[r],p0[r+1]);b=max3f(b,p0[r+2],p0[r+3]);a=max3f(a,p1[r],p1[r+1]);b=max3f(b,p1[r+2],p1[r+3]);}
  const float m=max2f(a,b);
  auto rr=__builtin_amdgcn_permlane32_swap(__float_as_uint(m),__float_as_uint(m),false,false);
  return max2f(__uint_as_float(rr[0]),__uint_as_float(rr[1]));
}
__device__ __forceinline__ void pv(f32x16*o,int vb,bf16x8 pa0,bf16x8 pa1,bf16x8 pa2,bf16x8 pa3){
  #pragma unroll
  for(int d0=0;d0<2;++d0){s16x4 lo[4],hi[4];
    #pragma unroll
    for(int ks=0;ks<4;++ks){
      asm volatile("ds_read_b64_tr_b16 %0,%1 offset:%c2":"=&v"(lo[ks]):"v"(vb),"i"(d0*4096+ks*1024):"memory");
      asm volatile("ds_read_b64_tr_b16 %0,%1 offset:%c2":"=&v"(hi[ks]):"v"(vb),"i"(d0*4096+ks*1024+512):"memory");}
    asm volatile("s_waitcnt lgkmcnt(0)":::"memory");SBAR();
    #define PK(k) (bf16x8){lo[k][0],lo[k][1],lo[k][2],lo[k][3],hi[k][0],hi[k][1],hi[k][2],hi[k][3]}
    o[d0]=__builtin_amdgcn_mfma_f32_32x32x16_bf16(pa0,PK(0),o[d0],0,0,0);
    o[d0]=__builtin_amdgcn_mfma_f32_32x32x16_bf16(pa1,PK(1),o[d0],0,0,0);
    o[d0]=__builtin_amdgcn_mfma_f32_32x32x16_bf16(pa2,PK(2),o[d0],0,0,0);
    o[d0]=__builtin_amdgcn_mfma_f32_32x32x16_bf16(pa3,PK(3),o[d0],0,0,0);
    #undef PK
  }
}

#ifndef ATTN_STORE16
#define ATTN_STORE16(p,v) (*(u32x4*)(p)=(v))
#endif
template<int THRL,int QP,int KP,int OP,int MODE,bool PART=false> __device__ __forceinline__ void attn_unit(int q0,int NT,const bf16*Qh,const bf16*__restrict__ Kh,const bf16*__restrict__ Vh,bf16*Oh,char*shm,const float*tbg=nullptr,float sink2=0.f,int kb0=0,float*Po=nullptr,float*Pml=nullptr){
  int tid_l=threadIdx.x; asm volatile("":"+v"(tid_l)); const int tid=tid_l,lane=tid&63,r32=lane&31,hi=lane>>5; const int wid=__builtin_amdgcn_readfirstlane(tid>>6);
  __attribute__((address_space(3))) float* tblL=(__attribute__((address_space(3))) float*)((__attribute__((address_space(3))) char*)shm+LDS_TB);
  if constexpr(MODE==1){
    #pragma unroll 1
    for(int idx=tid;idx<4*TBN;idx+=512){ const int kc=idx/TBN, j=idx-kc*TBN, src=j+kc-256; tblL[idx]=(src>=0&&src<=256)?tbg[src]:-INFINITY; } }

  const bf16*Qw=Qh+(long)(q0+wid*QBLK)*QP;

  const unsigned lds0=(unsigned)(uintptr_t)shm;
  float*wsf=(float*)(shm+LDS_WS)+wid*64;
  const bf16*ksrc=Kh+(long)lane*KP+wid*8;
  const bf16*vsrc=Vh+(long)(16*(wid&3)+(lane>>2))*KP+(wid>>2)*32+(lane&3)*8;
  const unsigned kdst=lds0+LDS_K+wid*1024, vdst=lds0+LDS_V+wid*1024;
  #define DMA_K(t,slot) glds16(ksrc+(long)(t)*KVBLK*KP,(unsigned)__builtin_amdgcn_readfirstlane(kdst+(slot)))
  #define DMA_V(t,slot) glds16(vsrc+(long)(t)*KVBLK*KP,(unsigned)__builtin_amdgcn_readfirstlane(vdst+(slot)))
  const int vb0=(int)(lds0+LDS_V)+((lane>>4)&1)*32+(lane&3)*8+(4*hi+((lane&15)>>2))*64;
  const char*Kbase=shm+LDS_K; bf16x8 kf[8];
  const lds_cptr shm3=(lds_cptr)shm; const lds_cptr kp0=shm3+LDS_K+hi*1024+r32*16; const lds_cptr vp0=shm3+LDS_V+((lane>>4)&1)*32+(lane&3)*8+(4*hi+((lane&15)>>2))*64;

  DMA_K(0,0);DMA_V(0,0);DMA_K(1,SLOTB);
  bf16x8 qr[4];
  #pragma unroll
  for(int d0=0;d0<4;++d0)qr[d0]=*reinterpret_cast<const bf16x8*>(&Qw[(long)r32*QP+d0*16+hi*8]);
  float mhat=0.f;f32x4_t lacc={0.f,0.f,0.f,0.f};f32x16 o[2];
  bf16x8 onesA; { const short ov=((lane&3)==0&&(((lane>>2)&1)==((lane>>4)&1)))?(short)0x3F80:(short)0; onesA=(bf16x8){ov,ov,ov,ov,ov,ov,ov,ov}; } asm volatile("":"+v"(onesA));o[0]=f32x16{};o[1]=f32x16{};f32x16 negm=f32x16{};asm volatile("":"+v"(negm));
  const int qrel=wid*QBLK+r32; const int qabs=q0+qrel;
  const int tb_base=kb0+4*hi-qabs+384, tb_k=tb_base&3;
  const __attribute__((address_space(3))) float*tp0=tblL+tb_k*TBN+(tb_base-tb_k);
  #define CMASK(P0,P1,t) wmask<MODE>(P0,P1,tp0+(t)*64)
  bool resc=false;
  #define START(P0,P1) do{ float rm=rowmax(P0,P1); if constexpr(MODE==1) rm=__builtin_fmaxf(rm,sink2); resc=false; \
    { const float dl=rm; mhat=fadd_s(mhat,dl); \
      _Pragma("unroll") for(int r=0;r<16;++r){P0[r]=fsub_s(P0[r],dl);P1[r]=fsub_s(P1[r],dl);} \
      _Pragma("unroll") for(int r=0;r<16;++r)negm[r]=-mhat; asm volatile("":"+v"(negm)); } \
    _Pragma("unroll") for(int r=0;r<16;++r)P0[r]=__builtin_amdgcn_exp2f(P0[r]); }while(0)
  #define RESC() do{ if(resc){ asm volatile("s_waitcnt lgkmcnt(0)":::"memory"); \
      _Pragma("unroll") for(int d_=0;d_<2;++d_) _Pragma("unroll") for(int r=0;r<16;++r)o[d_][r]*=wsf[crow(r,hi)]; } }while(0)
  f32x16 pA0,pA1,pB0,pB1;
  int sl_prev=0,sl_cur=0,sl_next=SLOTB;
  #define ROT() do{sl_prev=sl_cur;sl_cur=sl_next;sl_next=(sl_next==(NSLOT-1)*SLOTB)?0:sl_next+SLOTB;}while(0)
  DMA_K(2,2*SLOTB);
  WAIT_BAR(3);
  qkt(pA0,pA1,Kbase,qr,negm,r32,hi);asm volatile("s_nop 15\n\ts_nop 7":"+v"(pA0),"+v"(pA1));CMASK(pA0,pA1,0);
  START(pA0,pA1);
  _Pragma("unroll") for(int r=0;r<16;++r)pA1[r]=__builtin_amdgcn_exp2f(pA1[r]);
  WAIT_BAR(0);
  DMA_K(3,0);DMA_V(1,SLOTB);
  ROT();
  kload8(kf,kp0+sl_cur);
  WAIT_BAR(2);
  s16x4 vlo[8],vhi[8]; u32x4 pw0,pw1,pw2,pw3;
  #define PKW(P,B) cvtpk_s(P[B],P[B+1])
  #define PAF(k) __builtin_bit_cast(bf16x8,pw##k)
  #define VFR(i) (bf16x8){vlo[i][0],vlo[i][1],vlo[i][2],vlo[i][3],vhi[i][0],vhi[i][1],vhi[i][2],vhi[i][3]}
  #define PIN(x) asm volatile("":"+v"(x))
  #define MX3(a,b,c) __builtin_fmaxf(__builtin_fmaxf((a),(b)),(c))
  #define GAPA(MF,SM,W0,W1,PW) do{ MF; W0; W1; PIN(PW); SM; SBAR(); }while(0)
  #define LSUM(k) lacc=__builtin_amdgcn_mfma_f32_16x16x32_bf16(onesA,PAF(k),lacc,0,0,0)
  #define EX(v) __builtin_amdgcn_exp2f(v)
  #define GAPB(MF,X,B) do{ MF; X[B]=EX(X[B]); X[B+1]=EX(X[B+1]); X[B+2]=EX(X[B+2]); X[B+3]=EX(X[B+3]); PIN(X); SBAR(); }while(0)
  #define VRD(i) do{ vlo[i]=vtr(vp_+(((i)>>2)*4096+((i)&3)*1024)); vhi[i]=vtr(vp_+(((i)>>2)*4096+((i)&3)*1024+512)); }while(0)
  #define KRD(G,j) do{ if(G){ kload2(kf,kp0+sl_next,j); SBAR(); } }while(0)
  #define STEP(C0,C1,P0,P1,t,GK,GV,GL) do{ SBAR(); \
    const lds_cptr vp_=vp0+sl_prev; \
    VRD(0); SBAR(); \
    GAPA(C0=__builtin_amdgcn_mfma_f32_32x32x16_bf16(kf[0],qr[0],negm,0,0,0), (void)0, pw0[0]=PKW(P0,0), pw0[1]=PKW(P0,2), pw0); \
    VRD(4); SBAR(); GAPA(C1=__builtin_amdgcn_mfma_f32_32x32x16_bf16(kf[1],qr[0],negm,0,0,0), (void)0, pw0[2]=PKW(P0,4), pw0[3]=PKW(P0,6), pw0); \
    VRD(1); SBAR(); GAPA(C0=__builtin_amdgcn_mfma_f32_32x32x16_bf16(kf[2],qr[1],C0,0,0,0),   LSUM(0), pw1[0]=PKW(P0,8), pw1[1]=PKW(P0,10), pw1); \
    VRD(5); SBAR(); GAPA(C1=__builtin_amdgcn_mfma_f32_32x32x16_bf16(kf[3],qr[1],C1,0,0,0),   (void)0, pw1[2]=PKW(P0,12),pw1[3]=PKW(P0,14), pw1); \
    VRD(2); SBAR(); GAPA(C0=__builtin_amdgcn_mfma_f32_32x32x16_bf16(kf[4],qr[2],C0,0,0,0),   LSUM(1), pw2[0]=PKW(P1,0), pw2[1]=PKW(P1,2), pw2); \
    VRD(6); SBAR(); GAPA(C1=__builtin_amdgcn_mfma_f32_32x32x16_bf16(kf[5],qr[2],C1,0,0,0),   (void)0, pw2[2]=PKW(P1,4), pw2[3]=PKW(P1,6), pw2); \
    VRD(3); SBAR(); GAPA(C0=__builtin_amdgcn_mfma_f32_32x32x16_bf16(kf[6],qr[3],C0,0,0,0),   LSUM(2), pw3[0]=PKW(P1,8), pw3[1]=PKW(P1,10), pw3); \
    VRD(7); SBAR(); GAPA(C1=__builtin_amdgcn_mfma_f32_32x32x16_bf16(kf[7],qr[3],C1,0,0,0),   (void)0, pw3[2]=PKW(P1,12),pw3[3]=PKW(P1,14), pw3); \
    LSUM(3); SBAR(); \
    if(GK){DMA_K((t)+3,sl_cur);} if(GV){DMA_V((t)+1,sl_next);} \
    CMASK(C0,C1,t); \
    { float a=MX3(C0[0],C0[1],C1[0]),b=MX3(C0[2],C0[3],C1[1]); a=MX3(a,C1[2],C1[3]); \
      _Pragma("unroll") for(int r=4;r<16;r+=4){a=MX3(a,C0[r],C0[r+1]);b=MX3(b,C0[r+2],C0[r+3]);a=MX3(a,C1[r],C1[r+1]);b=MX3(b,C1[r+2],C1[r+3]);} \
      float rm=__builtin_fmaxf(a,b); { auto rr=__builtin_amdgcn_permlane32_swap(__float_as_uint(rm),__float_as_uint(rm),false,false); rm=__builtin_fmaxf(__uint_as_float(rr[0]),__uint_as_float(rr[1])); } \
      resc=false; \
      if(__builtin_expect(__any(rm>(float)THRL),0)){ const float dl=__builtin_fmaxf(rm,0.f); mhat+=dl; \
        _Pragma("unroll") for(int r=0;r<16;++r){C0[r]-=dl;C1[r]-=dl;} \
        _Pragma("unroll") for(int r=0;r<16;++r)negm[r]=-mhat; asm volatile("":"+v"(negm)); \
        const float f=__builtin_amdgcn_exp2f(-dl); lacc[0]*=f; if(hi==0)wsf[r32]=f; resc=true; } } \
    SBAR(); \
    GAPB(o[0]=__builtin_amdgcn_mfma_f32_32x32x16_bf16(PAF(0),VFR(0),o[0],0,0,0), C0,0); \
    GAPB(o[1]=__builtin_amdgcn_mfma_f32_32x32x16_bf16(PAF(0),VFR(4),o[1],0,0,0), C0,4); \
    KRD(GL,0); GAPB(o[0]=__builtin_amdgcn_mfma_f32_32x32x16_bf16(PAF(1),VFR(1),o[0],0,0,0), C0,8); \
    KRD(GL,1); GAPB(o[1]=__builtin_amdgcn_mfma_f32_32x32x16_bf16(PAF(1),VFR(5),o[1],0,0,0), C0,12); \
    KRD(GL,2); GAPB(o[0]=__builtin_amdgcn_mfma_f32_32x32x16_bf16(PAF(2),VFR(2),o[0],0,0,0), C1,0); \
    KRD(GL,3); GAPB(o[1]=__builtin_amdgcn_mfma_f32_32x32x16_bf16(PAF(2),VFR(6),o[1],0,0,0), C1,4); \
    GAPB(o[0]=__builtin_amdgcn_mfma_f32_32x32x16_bf16(PAF(3),VFR(3),o[0],0,0,0), C1,8); \
    GAPB(o[1]=__builtin_amdgcn_mfma_f32_32x32x16_bf16(PAF(3),VFR(7),o[1],0,0,0), C1,12); \
    }while(0)
  int t=1;
  #undef CMASK
  #define CMASK(P0,P1,t) wmask<MODE>(P0,P1,tp0+(t)*64)
  for(;t+5<NT;t+=2){
    STEP(pB0,pB1,pA0,pA1,t,true,true,true);     WAIT_BAR(2); RESC(); ROT();
    STEP(pA0,pA1,pB0,pB1,t+1,true,true,true);   WAIT_BAR(2); RESC(); ROT();
  }
  #undef CMASK
  #define CMASK(P0,P1,t) wmask<MODE>(P0,P1,tp0+(t)*64)
  #define ENDW(tt) do{ if((tt)+3<NT){WAIT_BAR(2);} else if((tt)+2<NT){WAIT_BAR(1);} else {WAIT_BAR(0);} }while(0)
  for(;t+1<NT;t+=2){
    STEP(pB0,pB1,pA0,pA1,t,(t+3<NT),(t+1<NT),(t+1<NT));       ENDW(t);   RESC(); ROT();
    STEP(pA0,pA1,pB0,pB1,t+1,(t+4<NT),(t+2<NT),(t+2<NT));     ENDW(t+1); RESC(); ROT();
  }
  STEP(pB0,pB1,pA0,pA1,NT-1,false,false,false); RESC();
  {
    pw0=(u32x4){PKW(pB0,0),PKW(pB0,2),PKW(pB0,4),PKW(pB0,6)};pw1=(u32x4){PKW(pB0,8),PKW(pB0,10),PKW(pB0,12),PKW(pB0,14)};pw2=(u32x4){PKW(pB1,0),PKW(pB1,2),PKW(pB1,4),PKW(pB1,6)};pw3=(u32x4){PKW(pB1,8),PKW(pB1,10),PKW(pB1,12),PKW(pB1,14)};
    LSUM(0); LSUM(1); LSUM(2); LSUM(3);
    SBAR(); pv(o,vb0+sl_cur,PAF(0),PAF(1),PAF(2),PAF(3)); }
  #undef PKW
  #undef PAF
  #undef VFR
  #undef PIN
  #undef MX3
  #undef GAPA
  #undef LSUM
  #undef GAPB
  #undef EX
  #undef VRD
  #undef KRD
  #undef STEP
  #undef ENDW
  float l_reg=lacc[0];
  if constexpr(MODE==1) l_reg+=__builtin_amdgcn_exp2f(sink2-mhat);
  if constexpr(PART){
    if(hi==0){ Pml[(wid*QBLK+r32)*2]=mhat; Pml[(wid*QBLK+r32)*2+1]=l_reg; }
    float*Pw=Po+(long)(wid*QBLK)*64+r32;
    #pragma unroll
    for(int r=0;r<16;++r){ Pw[crow(r,hi)*64]=o[0][r]; Pw[crow(r,hi)*64+32]=o[1][r]; }
  } else {
  if(hi==0)wsf[32+r32]=l_reg;asm volatile("s_waitcnt lgkmcnt(0)":::"memory");
  float rli[16];
  #pragma unroll
  for(int r=0;r<16;++r)rli[r]=__builtin_amdgcn_rcpf(wsf[32+crow(r,hi)]);
  bf16*Ow=Oh+(long)(q0+wid*QBLK)*OP;
  { bf16*stg=(bf16*)(shm+LDS_OST)+wid*2048;
    #pragma unroll
    for(int r=0;r<16;++r){const int orow=crow(r,hi);
      #pragma unroll
      for(int d0=0;d0<2;++d0)stg[orow*64+d0*32+r32]=__float2bfloat16(o[d0][r]*rli[r]);}
    asm volatile("s_waitcnt lgkmcnt(0)":::"memory");
    #pragma unroll
    for(int i=0;i<4;++i){const int row=i*8+(lane>>3),ch=lane&7; const u32x4 v=*(const u32x4*)(stg+row*64+ch*8); ATTN_STORE16(Ow+(long)row*OP+ch*8,v);} }
  }
  asm volatile("s_waitcnt lgkmcnt(0)\n\ts_barrier":::"memory");
  #undef DMA_K
  #undef DMA_V
  #undef CMASK
  #undef START
  #undef RESC
  #undef ROT
}
constexpr int ATTN_LDS_BYTES=LDS_BYTES+4*TBN*4;
#undef SBAR
#undef WAIT_BAR
}

namespace hg {
typedef short s16x4 __attribute__((ext_vector_type(4)));
typedef short s16x8 __attribute__((ext_vector_type(8)));
typedef float f32x4 __attribute__((ext_vector_type(4)));
typedef unsigned u32x4 __attribute__((ext_vector_type(4)));
typedef unsigned u32x2 __attribute__((ext_vector_type(2)));
#define HG_LAS __attribute__((address_space(3)))
constexpr int T = 8192, SEG = 128, NSEG = 64, HW = 512;
constexpr int PV = 272;
typedef float f32x2_t __attribute__((ext_vector_type(2))); typedef __bf16 bf16x2_t __attribute__((ext_vector_type(2)));
__device__ __forceinline__ unsigned pk(float lo, float hi) { f32x2_t v = {lo, hi}; bf16x2_t b = __builtin_convertvector(v, bf16x2_t); return __builtin_bit_cast(unsigned, b); }
#define HG_DPP_ADD(v, ctrl) v += __builtin_bit_cast(float, __builtin_amdgcn_update_dpp(0, __builtin_bit_cast(int, v), ctrl, 0xF, 0xF, true))
__device__ __forceinline__ float row16_sum(float v) { HG_DPP_ADD(v, 0xB1); HG_DPP_ADD(v, 0x4E); HG_DPP_ADD(v, 0x124); HG_DPP_ADD(v, 0x128); return v; }

__device__ __forceinline__ void pass1(int G, int bid, const _Float16* FF, const _Float16* FB, const unsigned short* BI, unsigned short* P, float* Dg, HG_LAS unsigned char* lds) {
    int tid_l = threadIdx.x; asm volatile("" : "+v"(tid_l));
    const int tid = tid_l, lane = tid & 63, w = __builtin_amdgcn_readfirstlane(tid >> 6), l16 = lane & 15, g = lane >> 4, c = tid & 127, qt = tid >> 7;
    constexpr int VT = 0, KT = 128 * PV, TQ = 3 * 128 * PV;
    for (int u = bid; u < 4 * NSEG; u += G) {
        const int h = u >> 6, seg = u & 63, tok0 = seg * SEG;
        const size_t ub = (size_t)tok0 * HW + h * 128; const int lo = 32 * qt * HW + c;
        unsigned vx[32]; float ff[32], fb[32];
        {
            const unsigned short* vb = BI + ub;
#pragma unroll
            for (int j = 0; j < 32; ++j) { vx[j] = (vb + j * HW)[lo]; ff[j] = (float)(FF + ub + j * HW)[lo]; fb[j] = (float)(FB + ub + j * HW)[lo]; }
        }
        {
#pragma unroll
            for (int jj = 0; jj < 4; ++jj) { u32x4 o; o.x = vx[8 * jj] | (vx[8 * jj + 1] << 16); o.y = vx[8 * jj + 2] | (vx[8 * jj + 3] << 16); o.z = vx[8 * jj + 4] | (vx[8 * jj + 5] << 16); o.w = vx[8 * jj + 6] | (vx[8 * jj + 7] << 16);
                *(HG_LAS u32x4*)(lds + VT + c * PV + (32 * qt + 8 * jj) * 2) = o; }
        }
        float kw0[32], kw1[32];
        {
            float run = 1.f;
#pragma unroll
            for (int j = 31; j >= 0; --j) { kw0[j] = (1.0f - ff[j]) * run; run *= ff[j]; }
            *(HG_LAS float*)(lds + TQ + (0 * 4 + qt) * 512 + c * 4) = run;
        }
        {
            float run = 1.f;
#pragma unroll
            for (int j = 0; j < 32; ++j) { kw1[j] = (1.0f - fb[j]) * run; run *= fb[j]; }
            *(HG_LAS float*)(lds + TQ + (1 * 4 + qt) * 512 + c * 4) = run;
        }
        __syncthreads();
        {
            float t0[4], t1[4];
#pragma unroll
            for (int q = 0; q < 4; ++q) { t0[q] = *(HG_LAS float*)(lds + TQ + (0 * 4 + q) * 512 + c * 4); t1[q] = *(HG_LAS float*)(lds + TQ + (1 * 4 + q) * 512 + c * 4); }
            float x0 = 1.f, x1 = 1.f;
#pragma unroll
            for (int q = 0; q < 4; ++q) { if (q > qt) x0 *= t0[q]; if (q < qt) x1 *= t1[q]; }
            if (qt == 0) { Dg[((size_t)(h * 2 + 0) * NSEG + seg) * 128 + c] = (t0[0] * t0[1]) * (t0[2] * t0[3]); Dg[((size_t)(h * 2 + 1) * NSEG + seg) * 128 + c] = (t1[0] * t1[1]) * (t1[2] * t1[3]); }
#pragma unroll
            for (int jj = 0; jj < 4; ++jj) { u32x4 o0, o1;
                o0.x = pk(kw0[8 * jj + 0] * x0, kw0[8 * jj + 1] * x0); o0.y = pk(kw0[8 * jj + 2] * x0, kw0[8 * jj + 3] * x0); o0.z = pk(kw0[8 * jj + 4] * x0, kw0[8 * jj + 5] * x0); o0.w = pk(kw0[8 * jj + 6] * x0, kw0[8 * jj + 7] * x0);
                o1.x = pk(kw1[8 * jj + 0] * x1, kw1[8 * jj + 1] * x1); o1.y = pk(kw1[8 * jj + 2] * x1, kw1[8 * jj + 3] * x1); o1.z = pk(kw1[8 * jj + 4] * x1, kw1[8 * jj + 5] * x1); o1.w = pk(kw1[8 * jj + 6] * x1, kw1[8 * jj + 7] * x1);
                *(HG_LAS u32x4*)(lds + KT + c * PV + (32 * qt + 8 * jj) * 2) = o0;
                *(HG_LAS u32x4*)(lds + KT + 128 * PV + c * PV + (32 * qt + 8 * jj) * 2) = o1; }
        }
        __syncthreads();
        {
            s16x8 bfr[4];
#pragma unroll
            for (int kk = 0; kk < 4; ++kk) bfr[kk] = *(const HG_LAS s16x8*)(lds + VT + (16 * w + l16) * PV + (32 * kk + 8 * g) * 2);
#pragma unroll
            for (int dir = 0; dir < 2; ++dir) {
                unsigned short* Pp = P + ((size_t)(h * 2 + dir) * NSEG + seg) * 16384 + (size_t)(16 * w) * 128; const int plo = l16 * 128 + 4 * g;
#pragma unroll
                for (int i = 0; i < 8; ++i) { f32x4 acc = (f32x4){0.f, 0.f, 0.f, 0.f};
#pragma unroll
                    for (int kk = 0; kk < 4; ++kk) { const s16x8 a = *(const HG_LAS s16x8*)(lds + KT + dir * 128 * PV + (16 * i + l16) * PV + (32 * kk + 8 * g) * 2);
                        acc = __builtin_amdgcn_mfma_f32_16x16x32_bf16(a, bfr[kk], acc, 0, 0, 0); }
                    { u32x2 o; o.x = pk(acc[0], acc[1]); o.y = pk(acc[2], acc[3]); *(u32x2*)(Pp + 16 * i + plo) = o; } }
            }
        }
        __syncthreads();
    }
}

__device__ __forceinline__ void scan(int G, int vcu, const unsigned short* P, const float* Dg, unsigned short* SS) {
    int tid_l = threadIdx.x; asm volatile("" : "+v"(tid_l));
    for (int e0 = vcu * 512; e0 < 8 * 16384; e0 += G * 512) {
        const int hd = e0 >> 14, dir = hd & 1, vc = (e0 & 16383) + tid_l, c = vc & 127;
        const int s0 = dir ? NSEG - 1 : 0, sd = dir ? -1 : 1;
        const unsigned short* Pb = P + ((size_t)hd * NSEG + s0) * 16384; const float* Db = Dg + ((size_t)hd * NSEG + s0) * 128; unsigned short* Sb = SS + ((size_t)hd * NSEG + s0) * 16384;
        float Sv = 0.f;
#pragma unroll 1
        for (int jb = 0; jb < NSEG; jb += 32) {
            unsigned p[32]; float d[32];
#pragma unroll
            for (int j = 0; j < 32; ++j) { p[j] = (Pb + (ptrdiff_t)((jb + j) * sd) * 16384)[vc]; d[j] = (Db + (ptrdiff_t)((jb + j) * sd) * 128)[c]; }
#pragma unroll
            for (int j = 0; j < 32; ++j) { (Sb + (ptrdiff_t)((jb + j) * sd) * 16384)[vc] = (unsigned short)(pk(Sv, 0.f) & 0xffffu); Sv = d[j] * Sv + __uint_as_float(p[j] << 16); }
        }
    }
}

__device__ __forceinline__ void pass2(int G, int bid, const unsigned short* BQ, const _Float16* FF, const _Float16* FB, const unsigned short* BI, const unsigned short* SGt, const unsigned short* SS,
                                      const float* gnw, unsigned short* MIX, HG_LAS unsigned char* lds) {
    int tid_l = threadIdx.x; asm volatile("" : "+v"(tid_l));
    const int tid = tid_l, lane = tid & 63, w = __builtin_amdgcn_readfirstlane(tid >> 6), l16 = lane & 15, g = lane >> 4, c = tid & 127, ch_t = tid >> 7;
    constexpr int VT = 0, QT = 128 * PV, KT = QT + 64 * PV, KPT = KT + 64 * PV, KPP = 144, DCH = KPT + 128 * KPP, NRM = DCH + 2048, RSTD = NRM + 4096;
    for (int u = bid; u < 4 * NSEG; u += G) {
        const int h = u >> 6, seg = u & 63, tok0 = seg * SEG;
        {
            const unsigned short* vb = BI + (size_t)tok0 * HW + h * 128; const int lo = 32 * ch_t * HW + c;
#pragma unroll
            for (int jj = 0; jj < 4; ++jj) { unsigned x[8];
#pragma unroll
                for (int j = 0; j < 8; ++j) x[j] = (vb + (8 * jj + j) * HW)[lo];
                u32x4 o; o.x = x[0] | (x[1] << 16); o.y = x[2] | (x[3] << 16); o.z = x[4] | (x[5] << 16); o.w = x[6] | (x[7] << 16);
                *(HG_LAS u32x4*)(lds + VT + c * PV + (32 * ch_t + 8 * jj) * 2) = o; }
        }
        f32x4 O[8];
#pragma unroll
        for (int i = 0; i < 8; ++i) O[i] = (f32x4){0.f, 0.f, 0.f, 0.f};
        float nf[16]; unsigned nq[16]; u32x2 sraw[8];
#define HG_LOAD_FQ(dir_, hh_) do { const _Float16* Fp_ = (dir_) ? FB : FF; const size_t ub_ = (size_t)(tok0 + 64 * (hh_)) * HW + h * 128; const int lo_ = 16 * ch_t * HW + c; \
            _Pragma("unroll") for (int j = 0; j < 16; ++j) { nf[j] = (float)(Fp_ + ub_ + j * HW)[lo_]; nq[j] = (BQ + ub_ + j * HW)[lo_]; } } while (0)
#define HG_LOAD_S(dir_) do { const unsigned short* sp_ = SS + ((size_t)(h * 2 + (dir_)) * NSEG + seg) * 16384 + (size_t)(16 * w) * 128 + l16 * 128 + 4 * g; \
            _Pragma("unroll") for (int i = 0; i < 8; ++i) sraw[i] = *(const u32x2*)(sp_ + 16 * i); } while (0)
        HG_LOAD_FQ(0, 0); HG_LOAD_S(0);
        f32x4 St[8];
#pragma unroll
        for (int st = 0; st < 4; ++st) {
            const int dir = st >> 1, hq = st & 1;
            {
                const int hh = dir ? 1 - hq : hq;
                if (hq == 0) {
#pragma unroll
                    for (int i = 0; i < 8; ++i) { St[i][0] = __uint_as_float(sraw[i].x << 16); St[i][1] = __uint_as_float(sraw[i].x & 0xffff0000u); St[i][2] = __uint_as_float(sraw[i].y << 16); St[i][3] = __uint_as_float(sraw[i].y & 0xffff0000u); } }
                {
                    float f[16], k[16], q[16];
#pragma unroll
                    for (int j = 0; j < 16; ++j) { f[j] = nf[j]; q[j] = __uint_as_float(nq[j] << 16); k[j] = 1.0f - f[j]; }
                    float kp[16]; float cum = 1.f, run = 1.f;
                    if (dir == 0) {
#pragma unroll
                        for (int j = 0; j < 16; ++j) { cum *= f[j]; q[j] *= cum; const float kk = k[j]; k[j] = kk * __builtin_amdgcn_rcpf(fmaxf(cum, 1e-30f)); kp[j] = kk; }
#pragma unroll
                        for (int j = 15; j >= 0; --j) { kp[j] *= run; run *= f[j]; }
                    } else {
#pragma unroll
                        for (int j = 15; j >= 0; --j) { cum *= f[j]; q[j] *= cum; const float kk = k[j]; k[j] = kk * __builtin_amdgcn_rcpf(fmaxf(cum, 1e-30f)); kp[j] = kk; }
#pragma unroll
                        for (int j = 0; j < 16; ++j) { kp[j] *= run; run *= f[j]; }
                    }
#pragma unroll
                    for (int j = 0; j < 16; ++j) { *(HG_LAS unsigned short*)(lds + QT + (16 * ch_t + j) * PV + c * 2) = (unsigned short)(pk(q[j], 0.f) & 0xffffu);
                                                   *(HG_LAS unsigned short*)(lds + KT + (16 * ch_t + j) * PV + c * 2) = (unsigned short)(pk(k[j], 0.f) & 0xffffu); }
                    u32x4 o0, o1; o0.x = pk(kp[0], kp[1]); o0.y = pk(kp[2], kp[3]); o0.z = pk(kp[4], kp[5]); o0.w = pk(kp[6], kp[7]); o1.x = pk(kp[8], kp[9]); o1.y = pk(kp[10], kp[11]); o1.z = pk(kp[12], kp[13]); o1.w = pk(kp[14], kp[15]);
                    *(HG_LAS u32x4*)(lds + KPT + c * KPP + (16 * ch_t) * 2) = o0; *(HG_LAS u32x4*)(lds + KPT + c * KPP + (16 * ch_t) * 2 + 16) = o1;
                    *(HG_LAS float*)(lds + DCH + ch_t * 512 + c * 4) = cum;
                }
                __syncthreads();
                if (st == 0) HG_LOAD_FQ(0, 1); else if (st == 1) { HG_LOAD_FQ(1, 1); HG_LOAD_S(1); } else if (st == 2) HG_LOAD_FQ(1, 0);
#pragma unroll
                for (int cq = 0; cq < 4; ++cq) {
                    const int ch = dir ? 3 - cq : cq, tr = 16 * ch, cg = 4 * hh + ch;
                    f32x4 at = (f32x4){0.f, 0.f, 0.f, 0.f};
                    s16x8 fa[4], fb4[4]; u32x2 qa[4], qb[4];
#pragma unroll
                    for (int m = 0; m < 4; ++m) { fa[m] = *(const HG_LAS s16x8*)(lds + KT + (tr + l16) * PV + (32 * m + 8 * g) * 2); fb4[m] = *(const HG_LAS s16x8*)(lds + QT + (tr + l16) * PV + (32 * m + 8 * g) * 2);
                        qa[m] = *(const HG_LAS u32x2*)(lds + QT + (tr + l16) * PV + (32 * m + 4 * g) * 2); qb[m] = *(const HG_LAS u32x2*)(lds + QT + (tr + l16) * PV + (32 * m + 16 + 4 * g) * 2); }
                    const u32x2 bv2 = *(const HG_LAS u32x2*)(lds + VT + (16 * w + l16) * PV + (64 * hh + tr + 4 * g) * 2);
#pragma unroll
                    for (int m = 0; m < 4; ++m) at = __builtin_amdgcn_mfma_f32_16x16x32_bf16(fa[m], fb4[m], at, 0, 0, 0);
#pragma unroll
                    for (int r = 0; r < 4; ++r) { const int s = 4 * g + r; const bool keep = dir ? (s >= l16) : (s <= l16); at[r] = keep ? at[r] : 0.f; }
                    u32x4 pa4; pa4.x = pk(at[0], at[1]); pa4.y = pk(at[2], at[3]); pa4.z = 0u; pa4.w = 0u; const s16x8 pa = __builtin_bit_cast(s16x8, pa4);
                    u32x4 bv4; bv4.x = bv2.x; bv4.y = bv2.y; bv4.z = 0u; bv4.w = 0u; const s16x8 bv = __builtin_bit_cast(s16x8, bv4);
                    f32x4 o = O[cg];
                    o = __builtin_amdgcn_mfma_f32_16x16x32_bf16(pa, bv, o, 0, 0, 0);
#pragma unroll
                    for (int m = 0; m < 4; ++m) { u32x4 sb; sb.x = pk(St[2 * m][0], St[2 * m][1]); sb.y = pk(St[2 * m][2], St[2 * m][3]); sb.z = pk(St[2 * m + 1][0], St[2 * m + 1][1]); sb.w = pk(St[2 * m + 1][2], St[2 * m + 1][3]);
                        u32x4 qq; qq.x = qa[m].x; qq.y = qa[m].y; qq.z = qb[m].x; qq.w = qb[m].y;
                        o = __builtin_amdgcn_mfma_f32_16x16x32_bf16(__builtin_bit_cast(s16x8, qq), __builtin_bit_cast(s16x8, sb), o, 0, 0, 0); }
                    O[cg] = o;
                    f32x4 dvv[8]; u32x2 a2v[8];
#pragma unroll
                    for (int i = 0; i < 8; ++i) { dvv[i] = *(const HG_LAS f32x4*)(lds + DCH + ch * 512 + (16 * i + 4 * g) * 4); a2v[i] = *(const HG_LAS u32x2*)(lds + KPT + (16 * i + l16) * KPP + (tr + 4 * g) * 2); }
#pragma unroll
                    for (int i = 0; i < 8; ++i) { u32x4 a4; a4.x = a2v[i].x; a4.y = a2v[i].y; a4.z = 0u; a4.w = 0u;
                        St[i] = __builtin_amdgcn_mfma_f32_16x16x32_bf16(__builtin_bit_cast(s16x8, a4), bv, St[i] * dvv[i], 0, 0, 0); }
                }
                __syncthreads();
            }
        }
#undef HG_LOAD_FQ
#undef HG_LOAD_S
        unsigned sgv[8][4];
        { const unsigned short* sgb = SGt + (size_t)tok0 * HW + h * 128 + 16 * w; const int slo = 4 * g * HW + l16;
#pragma unroll
          for (int cg = 0; cg < 8; ++cg)
#pragma unroll
              for (int r = 0; r < 4; ++r) sgv[cg][r] = (sgb + (16 * cg + r) * HW)[slo]; }
#pragma unroll
        for (int cg = 0; cg < 8; ++cg)
#pragma unroll
            for (int r = 0; r < 4; ++r) { const float s = row16_sum(O[cg][r] * O[cg][r]); if (l16 == 0) *(HG_LAS float*)(lds + NRM + w * 512 + (16 * cg + 4 * g + r) * 4) = s; }
        __syncthreads();
        if (tid < 128) { float s = 0.f;
#pragma unroll
            for (int ww = 0; ww < 8; ++ww) s += *(HG_LAS float*)(lds + NRM + ww * 512 + tid * 4);
            *(HG_LAS float*)(lds + RSTD + tid * 4) = 1.0f / sqrtf(s * (1.0f / 128.0f) + 1e-6f); }
        __syncthreads();
        {
            const float gw = gnw[16 * w + l16];
            unsigned short* mb = MIX + (size_t)tok0 * 2048 + 768 + h * 128 + 16 * w; const int mlo = 4 * g * 2048 + l16;
            asm volatile("" ::: "memory");
#pragma unroll
            for (int cg = 0; cg < 8; ++cg) { const f32x4 rs = *(const HG_LAS f32x4*)(lds + RSTD + (16 * cg + 4 * g) * 4);
#pragma unroll
                for (int r = 0; r < 4; ++r) {
                    const float y = O[cg][r] * rs[r] * gw * __uint_as_float(sgv[cg][r] << 16);
                    (mb + (16 * cg + r) * 2048)[mlo] = (unsigned short)(pk(y, 0.f) & 0xffffu); } }
        }
        __syncthreads();
    }
}
#undef HG_DPP_ADD
}

constexpr int NWAVES = 8;
#ifndef MK_SPLIT
#define MK_SPLIT 0
#endif
constexpr int S = 8192, DM = 2048, DFF = 5632, DIN = 5120, NL = 4;
constexpr int NGU = 2 * DFF;
constexpr float EPS = 1e-6f;
constexpr size_t MiB = 1u << 20;
constexpr size_t WS_CTL = 0, CTL_ZERO_BYTES = 1 * MiB;
constexpr size_t WS_TAB = 1 * MiB;
constexpr size_t TAB_RT = 0, TAB_CT = 16384, TAB_TB = 24576, TAB_LB = 40960;
constexpr size_t TAB_HS = 65536, TAB_WSC = 131072;
constexpr size_t WS_W = 2 * MiB;
constexpr size_t W_GU1 = 0, W_DN1 = 44 * MiB, W_WIN = 66 * MiB, W_WOUT = 86 * MiB, W_GU2 = 94 * MiB, W_DN2 = 138 * MiB, W_LAYER = 160 * MiB;
constexpr size_t WS_X = WS_W + NL * W_LAYER;
constexpr size_t WS_Y = WS_X + 64 * MiB;
constexpr size_t WS_H = WS_Y + 64 * MiB;
constexpr size_t WS_ACT = WS_H + 32 * MiB;
constexpr size_t WS_MIX = WS_ACT + 88 * MiB;
constexpr size_t WS_AQ = WS_MIX + 32 * MiB, WS_AK = WS_AQ + 12 * MiB, WS_AV = WS_AK + 4 * MiB, WS_CQ = WS_AV + 4 * MiB, WS_CK = WS_CQ + 12 * MiB, WS_CV = WS_CK + 4 * MiB;
constexpr size_t WS_B = WS_CV + 4 * MiB;
constexpr size_t WB_BQ = 0, WB_BI = 8 * MiB, WB_SG = 16 * MiB, WB_FF = 32 * MiB, WB_FB = 48 * MiB, WB_P = 64 * MiB;
constexpr size_t BSZ = 16 * MiB;
constexpr size_t WS_SS = WS_B + 9 * BSZ;
constexpr size_t WS_DG = WS_SS + 32 * MiB;
constexpr size_t WS_PO = WS_DG + 1 * MiB;
constexpr size_t WS_PML = WS_PO + 16 * MiB;
constexpr size_t WS_END = WS_PML + 1 * MiB;
constexpr int CW_BAR = 4096;
constexpr int CW_CQ = 1024;
constexpr int RING_OFF = 0, RING_BYTES = 131072;
constexpr int LDSCTL_OFF = RING_BYTES, MISC_OFF = LDSCTL_OFF + 320;
constexpr int LDS_BYTES = 147456;

#define GAS __attribute__((address_space(1)))
#define LAS __attribute__((address_space(3)))
typedef unsigned short bf16;
typedef unsigned v4u __attribute__((ext_vector_type(4)));
typedef unsigned v2u __attribute__((ext_vector_type(2)));
typedef float f32x4 __attribute__((ext_vector_type(4)));
typedef GAS unsigned gu32;
#define RLX_AGENT __ATOMIC_RELAXED, __HIP_MEMORY_SCOPE_AGENT
#define LDS_WAIT() asm volatile("s_waitcnt lgkmcnt(0)" ::: "memory")
#define VM_WAIT() asm volatile("s_waitcnt vmcnt(0)" ::: "memory")
__device__ __forceinline__ unsigned f2bf(float f) { unsigned u = __builtin_bit_cast(unsigned, f); return (u + 0x7fffu + ((u >> 16) & 1u)) >> 16; }
__device__ __forceinline__ unsigned pk2(float lo, float hi) { return f2bf(lo) | (f2bf(hi) << 16); }
__device__ __forceinline__ float bf2f(bf16 b) { return __uint_as_float((unsigned)b << 16); }

#define XB_TMO      128
#define XB_XCNT(j)  (256  + 64 * (j))
#define XB_XSUB(j)  (1280 + 64 * (j))
#define XB_XGEN(j)  (2304 + 64 * (j))
#define XB_TOP      3328
#define XB_TOPGEN   3392
#define XCD_BAR_WORDS 3456
#define XB_SPIN_CAP (1u << 18)

__device__ __forceinline__ unsigned xb_ld(unsigned* p)              { return __hip_atomic_load(p, __ATOMIC_RELAXED, __HIP_MEMORY_SCOPE_AGENT); }
__device__ __forceinline__ unsigned xb_add(unsigned* p, unsigned v) { return __hip_atomic_fetch_add(p, v, __ATOMIC_RELAXED, __HIP_MEMORY_SCOPE_AGENT); }
__device__ __forceinline__ unsigned xb_xcc_id() { return (unsigned)__builtin_amdgcn_s_getreg((3 << 11) | 20) & 0xFu; }
#define XB_SPIN(cond, bar) do { unsigned _sp = 0; while (cond) { __builtin_amdgcn_s_sleep(1); \
    if ((++_sp & 255u) == 0u) { if (xb_ld(&(bar)[XB_TMO])) break; if (_sp > XB_SPIN_CAP) { atomicAdd(&(bar)[XB_TMO], 1u); break; } } } } while (0)

struct XcdBarrier {
    unsigned* bar; unsigned x;
    volatile LAS unsigned* st;
};

__device__ __forceinline__ XcdBarrier xcd_barrier_post(unsigned* bar, volatile LAS unsigned* st) {
    XcdBarrier b; b.bar = bar; b.x = xb_xcc_id(); b.st = st;
    if (threadIdx.x == 0) (void)xb_add(&bar[XB_XCNT(b.x)], 1u);
    return b;
}
__device__ __forceinline__ void xcd_barrier_complete(unsigned* bar, unsigned x, unsigned& nloc, unsigned& nx) {
    const unsigned G = gridDim.x * gridDim.y * gridDim.z;
    unsigned sum, cnt, mine, sp = 0u;
    for (;;) {
        sum = 0u; cnt = 0u; mine = 0u;
#pragma unroll
        for (unsigned j = 0; j < 16; ++j) { const unsigned c = xb_ld(&bar[XB_XCNT(j)]); sum += c; cnt += (c > 0u) ? 1u : 0u; mine = (j == x) ? c : mine; }
        if (sum == G) break;
        __builtin_amdgcn_s_sleep(1);
        if ((++sp & 255u) == 0u) { if (xb_ld(&bar[XB_TMO])) break; if (sp > XB_SPIN_CAP) { atomicAdd(&bar[XB_TMO], 1u); break; } }
    }
    nloc = mine > 0u ? mine : 1u; nx = cnt > 0u ? cnt : 1u;
}

__device__ __forceinline__ void xcd_barrier(const XcdBarrier& b) {
    asm volatile("s_waitcnt vmcnt(0)" ::: "memory");
    __syncthreads();
    if (threadIdx.x == 0) {
        unsigned* bar = b.bar;
        __builtin_amdgcn_s_waitcnt(0);
        unsigned nloc = b.st[0], nx = b.st[1];
        if (nloc == 0u) { xcd_barrier_complete(bar, b.x, nloc, nx); b.st[0] = nloc; b.st[1] = nx; }
        const unsigned old = xb_add(&bar[XB_XSUB(b.x)], 1u);
        const unsigned gen = old / nloc;
        if (old + 1u == (gen + 1u) * nloc) {
            __builtin_amdgcn_fence(__ATOMIC_RELEASE, "agent");
            asm volatile("s_waitcnt vmcnt(0)" ::: "memory");
            const unsigned og = xb_add(&bar[XB_TOP], 1u);
            const unsigned tg = og / nx;
            if (og + 1u == (tg + 1u) * nx) xb_add(&bar[XB_TOPGEN], 1u);
            else XB_SPIN(xb_ld(&bar[XB_TOPGEN]) == tg, bar);
            __builtin_amdgcn_fence(__ATOMIC_ACQUIRE, "agent");
            xb_add(&bar[XB_XGEN(b.x)], 1u);
            asm volatile("s_waitcnt vmcnt(0)" ::: "memory");
        } else {
            XB_SPIN(xb_ld(&bar[XB_XGEN(b.x)]) == gen, bar);
            __builtin_amdgcn_fence(__ATOMIC_ACQUIRE, "agent");
            asm volatile("s_waitcnt vmcnt(0)" ::: "memory");
        }
    }
    __syncthreads();
}


struct Frame {
    LAS unsigned char* lds;
    volatile LAS unsigned* MISC;
    gu32* ctl;
    int tid, lane, wave, vcu, G;
};
__device__ __forceinline__ float wave_sum(float v) {
#pragma unroll
    for (int o = 1; o < 64; o <<= 1) v += __shfl_xor(v, o);
    return v;
}
__device__ __forceinline__ float wave_max(float v) {
#pragma unroll
    for (int o = 1; o < 64; o <<= 1) v = fmaxf(v, __shfl_xor(v, o));
    return v;
}
#define DPP_ADD(v, ctrl) v += __builtin_bit_cast(float, __builtin_amdgcn_update_dpp(0, __builtin_bit_cast(int, v), ctrl, 0xF, 0xF, true))
__device__ __forceinline__ float wave_sum_fast(float v) {
    DPP_ADD(v, 0xB1); DPP_ADD(v, 0x4E); DPP_ADD(v, 0x124); DPP_ADD(v, 0x128);
    { auto rr = __builtin_amdgcn_permlane16_swap(__float_as_uint(v), __float_as_uint(v), false, false); v = __uint_as_float(rr[0]) + __uint_as_float(rr[1]); }
    { auto rr = __builtin_amdgcn_permlane32_swap(__float_as_uint(v), __float_as_uint(v), false, false); v = __uint_as_float(rr[0]) + __uint_as_float(rr[1]); }
    return v;
}

struct ConvDesc { const float* src; unsigned char* dst; int N, K, f8; float sc; };
__device__ __forceinline__ unsigned pk4_i8(float a, float b, float c, float d) { const float M = 12582912.f;
    return __builtin_amdgcn_perm(__float_as_uint(b + M), __float_as_uint(a + M), 0x0c0c0400u) | __builtin_amdgcn_perm(__float_as_uint(d + M), __float_as_uint(c + M), 0x04000c0cu); }
__device__ __forceinline__ float cl127(float x) { return __builtin_amdgcn_fmed3f(x, -127.f, 127.f); }
constexpr unsigned I8_GU1_MASK = 0xEu, I8_GU2_MASK = 0xFu;
constexpr unsigned F8_DN1_MASK = 0x8u, F8_DN2_MASK = 0xCu;
static_assert((I8_GU1_MASK & 1u) == 0, "layer 0's first H comes from row_first (bf16) and its gate|up weights are converted before the scales exist");
static_assert((F8_DN1_MASK & ~I8_GU1_MASK) == 0 && (F8_DN2_MASK & ~I8_GU2_MASK) == 0, "only the int8 gate|up epilogue has an fp8-output form here");
constexpr int H8_SCL2 = 3, W8_SCL2 = 8, A8_SCL2 = 3;
__device__ __forceinline__ unsigned pk4_fp8(float a, float b, float c, float d, float sc) {
    a = __builtin_amdgcn_fmed3f(a * sc, -448.f, 448.f); b = __builtin_amdgcn_fmed3f(b * sc, -448.f, 448.f); c = __builtin_amdgcn_fmed3f(c * sc, -448.f, 448.f); d = __builtin_amdgcn_fmed3f(d * sc, -448.f, 448.f);
    int w = 0; w = __builtin_amdgcn_cvt_pk_fp8_f32(a, b, w, false); w = __builtin_amdgcn_cvt_pk_fp8_f32(c, d, w, true); return (unsigned)w;
}
__device__ __forceinline__ void conv_load(const ConvDesc& d, float (&v)[32], int lane) {
    const int lo = (lane >> 5) * d.N + (lane & 31);
#pragma unroll
    for (int i = 0; i < 32; ++i) v[i] = __builtin_nontemporal_load((d.src + (size_t)(2 * i) * d.N) + lo);
}
__device__ __forceinline__ void conv_store(const ConvDesc& d, const float (&v)[32], LAS float* scr, int lane) {
#pragma unroll
    for (int i = 0; i < 32; ++i) scr[(2 * i + (lane >> 5)) * 33 + (lane & 31)] = v[i];
    LDS_WAIT(); asm volatile("" ::: "memory");
    const int c = lane & 7;
#pragma unroll
    for (int j = 0; j < 4; ++j) { const int n = (lane >> 3) + 8 * j; const LAS float* s = scr + (8 * c) * 33 + n;
        if (d.f8 == 2) { v2u o; const float q = d.sc; o.x = pk4_i8(cl127(s[0 * 33] * q), cl127(s[1 * 33] * q), cl127(s[2 * 33] * q), cl127(s[3 * 33] * q)); o.y = pk4_i8(cl127(s[4 * 33] * q), cl127(s[5 * 33] * q), cl127(s[6 * 33] * q), cl127(s[7 * 33] * q));
            *(GAS v2u*)(d.dst + (size_t)n * d.K + 8 * c) = o; }
        else if (d.f8) { v2u o; o.x = pk4_fp8(s[0 * 33], s[1 * 33], s[2 * 33], s[3 * 33], (float)(1 << W8_SCL2)); o.y = pk4_fp8(s[4 * 33], s[5 * 33], s[6 * 33], s[7 * 33], (float)(1 << W8_SCL2));
            *(GAS v2u*)(d.dst + (size_t)n * d.K + 8 * c) = o; }
        else { v4u o; o.x = pk2(s[0 * 33], s[1 * 33]); o.y = pk2(s[2 * 33], s[3 * 33]); o.z = pk2(s[4 * 33], s[5 * 33]); o.w = pk2(s[6 * 33], s[7 * 33]);
            *(GAS v4u*)(d.dst + ((size_t)n * d.K + 8 * c) * 2) = o; } }
    LDS_WAIT(); asm volatile("" ::: "memory");
}
constexpr int I_G = (DM / 64) * (DFF / 32), I_D = (DFF / 64) * (DM / 32), I_IN = (DM / 64) * (DIN / 32), I_OUT = (DM / 64) * (DM / 32);
constexpr int I_LAYER = 6 * I_G + I_IN + I_OUT;
static_assert(I_D == I_G && I_LAYER % 4 == 0, "item counts");
#define CONV_PARAMS const float* cs_w_in, const float* cs_w_out, const float* cs_f1g, const float* cs_f1u, const float* cs_f1d, const float* cs_f2g, const float* cs_f2u, const float* cs_f2d
#define CONV_PASS cs_w_in, cs_w_out, cs_f1g, cs_f1u, cs_f1d, cs_f2g, cs_f2u, cs_f2d
#define CONV_INPUTS INP(1), INP(2), INP(3), INP(4), INP(5), INP(6), INP(7), INP(8)
__device__ __forceinline__ ConvDesc conv_desc(CONV_PARAMS, unsigned char* ws, int flat) {
    const int l = flat / I_LAYER; int r = flat - l * I_LAYER;
    unsigned char* wl = ws + WS_W + (size_t)l * W_LAYER;
    const float* W; int K, N, drow, kb, n0, f8 = 0; size_t woff; float sc = 1.f;
    if (r < 2 * I_G || (r >= 3 * I_G + I_IN + I_OUT && r < 5 * I_G + I_IN + I_OUT)) {
        const bool second = r >= 2 * I_G; if (second) r -= 3 * I_G + I_IN + I_OUT; f8 = (((second ? I8_GU2_MASK : I8_GU1_MASK) >> l) & 1u) ? 2 : 0;
        const bool up = r >= I_G; if (up) r -= I_G;
        if (f8 == 2) sc = 1.0f / ((const float*)(ws + WS_TAB + TAB_WSC))[l * 4 + (second ? 2 : 0) + (up ? 1 : 0)];
        W = (second ? (up ? cs_f2u : cs_f2g) : (up ? cs_f1u : cs_f1g)) + (size_t)l * DM * DFF; K = DM; N = DFF; woff = second ? W_GU2 : W_GU1;
        const int nblk = DFF / 32; kb = r / nblk; n0 = 32 * (r - kb * nblk); drow = (n0 >> 7) * 256 + (n0 & 127) + (up ? 128 : 0);
    } else if (r < 3 * I_G) {
        r -= 2 * I_G; f8 = (int)((F8_DN1_MASK >> l) & 1u); W = cs_f1d + (size_t)l * DFF * DM; K = DFF; N = DM; woff = W_DN1; const int nblk = DM / 32; kb = r / nblk; n0 = 32 * (r - kb * nblk); drow = n0;
    } else if (r < 3 * I_G + I_IN) {
        r -= 3 * I_G; W = cs_w_in + (size_t)l * DM * DIN; K = DM; N = DIN; woff = W_WIN; const int nblk = DIN / 32; kb = r / nblk; n0 = 32 * (r - kb * nblk);
        const int tile = n0 >> 8, q = n0 & 255; drow = tile * 256 + ((tile >= 15 && tile <= 18) ? (((q & 63) >> 5) * 128 + (q >> 6) * 32) : q);
    } else if (r < 3 * I_G + I_IN + I_OUT) {
        r -= 3 * I_G + I_IN; W = cs_w_out + (size_t)l * DM * DM; K = DM; N = DM; woff = W_WOUT; const int nblk = DM / 32; kb = r / nblk; n0 = 32 * (r - kb * nblk); drow = n0;
    } else {
        r -= 5 * I_G + I_IN + I_OUT; f8 = (int)((F8_DN2_MASK >> l) & 1u); W = cs_f2d + (size_t)l * DFF * DM; K = DFF; N = DM; woff = W_DN2; const int nblk = DM / 32; kb = r / nblk; n0 = 32 * (r - kb * nblk); drow = n0;
    }
    ConvDesc d; d.src = W + (size_t)(64 * kb) * N + n0; d.dst = wl + woff + (((size_t)drow * K + 64 * kb) << (f8 ? 0 : 1)); d.N = N; d.K = K; d.f8 = f8; d.sc = sc; return d;
}
__device__ __forceinline__ void conv_range(CONV_PARAMS, unsigned char* ws, int first, int stride, int end, LAS float* scr, int lane) {
    if (first >= end) return;
    ConvDesc d = conv_desc(CONV_PASS, ws, first); float v[32]; conv_load(d, v, lane);
#pragma unroll 1
    for (int it = first; it < end; it += stride) {
        const bool more = it + stride < end; ConvDesc dn = d; float vn[32];
        if (more) { dn = conv_desc(CONV_PASS, ws, it + stride); conv_load(dn, vn, lane); }
        conv_store(d, v, scr, lane);
        if (more) { d = dn;
#pragma unroll
            for (int i = 0; i < 32; ++i) v[i] = vn[i]; }
    }
}
constexpr int CONV_K = 13, CONV_SLOT = 1024 * CONV_K, CONV_P0 = 2 * I_G, CONV_R = I_LAYER - 3 * CONV_SLOT, I_ALL = NL * I_LAYER;
static_assert(CONV_R >= 0 && CONV_P0 + 3 * CONV_SLOT + CONV_R == I_LAYER + CONV_P0, "conversion schedule period");
static_assert(CONV_P0 + CONV_SLOT >= 3 * I_G + I_IN + I_OUT && CONV_P0 + 2 * CONV_SLOT >= 5 * I_G + I_IN + I_OUT && CONV_P0 + 3 * CONV_SLOT >= I_LAYER, "each slot must cover what the phases before the next slot need");
__device__ __forceinline__ int t5_bucket(int rel) {
    const int n = rel < 0 ? -rel : rel;
    int b;
    if (n < 8) b = n; else { const int lg = 31 - __builtin_clz((unsigned)(n * n)); b = 8 + (lg - 6); if (b > 15) b = 15; }
    return (rel > 0 ? 16 : 0) + b;
}

struct Args { const float* in[15]; float* out; unsigned char* ws; int ph_lo, ph_hi; };

typedef _Float16 h16x4 __attribute__((ext_vector_type(4)));
template <bool XIN_F32> __device__ __forceinline__ f32x4 row_ldx(const void* X, size_t r, int lane, int j) {
    if constexpr (XIN_F32) return __builtin_nontemporal_load((const GAS f32x4*)((const float*)X + r * DM) + lane + 64 * j);
    else { const h16x4 v = __builtin_nontemporal_load((const GAS h16x4*)((const _Float16*)X + r * DM) + lane + 64 * j); return __builtin_convertvector(v, f32x4); }
}
template <bool XIN_F32, bool XOUT_F32, int H8 = 0>
__device__ __forceinline__ void row_phase(const Frame& F, const void* X, const bf16* Y, void* Xout, bf16* Hout, const float* wpost, const float* wnext, float coef, int r_first, int r_step, float* HS = nullptr) {
    f32x4 x[8]; v2u yb[8];
    if (r_first < S) { const GAS v2u* yr = (const GAS v2u*)(Y + (size_t)r_first * DM) + F.lane;
#pragma unroll
        for (int j = 0; j < 8; ++j) { yb[j] = __builtin_nontemporal_load(yr + 64 * j); x[j] = row_ldx<XIN_F32>(X, (size_t)r_first, F.lane, j); } }
#pragma unroll 1
    for (int k = 0; k < 4; ++k) { const int r = r_first + k * r_step; if (r >= S) break;
        const int rn = r + r_step; const bool more = (k < 3) && (rn < S);
        f32x4 xn[8]; v2u ybn[8];
        if (more) { const GAS v2u* yr = (const GAS v2u*)(Y + (size_t)rn * DM) + F.lane;
#pragma unroll
            for (int j = 0; j < 8; ++j) { ybn[j] = __builtin_nontemporal_load(yr + 64 * j); xn[j] = row_ldx<XIN_F32>(X, (size_t)rn, F.lane, j); } }
        f32x4 y[8]; float s = 0.f;
#pragma unroll
        for (int j = 0; j < 8; ++j) { y[j] = (f32x4){__uint_as_float(yb[j].x << 16), __uint_as_float(yb[j].x & 0xffff0000u), __uint_as_float(yb[j].y << 16), __uint_as_float(yb[j].y & 0xffff0000u)};
            s += (y[j].x * y[j].x + y[j].y * y[j].y) + (y[j].z * y[j].z + y[j].w * y[j].w); }
        const float r1 = coef / sqrtf(wave_sum(s) * (1.f / DM) + EPS); float s2 = 0.f;
#pragma unroll
        for (int j = 0; j < 8; ++j) { const f32x4 w = *((const GAS f32x4*)wpost + F.lane + 64 * j); x[j] = x[j] + y[j] * r1 * w;
            if constexpr (XOUT_F32) __builtin_nontemporal_store(x[j], (GAS f32x4*)((float*)Xout + (size_t)r * DM) + F.lane + 64 * j);
            else __builtin_nontemporal_store(__builtin_convertvector(x[j], h16x4), (GAS h16x4*)((_Float16*)Xout + (size_t)r * DM) + F.lane + 64 * j);
            s2 += (x[j].x * x[j].x + x[j].y * x[j].y) + (x[j].z * x[j].z + x[j].w * x[j].w); }
        if (Hout) { const float r2 = 1.f / sqrtf(wave_sum(s2) * (1.f / DM) + EPS);
            if constexpr (H8 == 2) { GAS unsigned* ho = (GAS unsigned*)((unsigned char*)Hout + (size_t)r * DM) + F.lane;
                f32x4 v[8]; float am = 1e-20f;
#pragma unroll
                for (int j = 0; j < 8; ++j) { const f32x4 w = *((const GAS f32x4*)wnext + F.lane + 64 * j); v[j] = x[j] * r2 * w; am = fmaxf(fmaxf(am, fmaxf(fabsf(v[j].x), fabsf(v[j].y))), fmaxf(fabsf(v[j].z), fabsf(v[j].w))); }
                am = wave_max(am); const float qs = 127.f / am; if (F.lane == 0) HS[r] = am * (1.f / 127.f);
#pragma unroll
                for (int j = 0; j < 8; ++j) ho[64 * j] = pk4_i8(v[j].x * qs, v[j].y * qs, v[j].z * qs, v[j].w * qs); }
            else if constexpr (H8 == 1) { GAS unsigned* ho = (GAS unsigned*)((unsigned char*)Hout + (size_t)r * DM) + F.lane;
#pragma unroll
                for (int j = 0; j < 8; ++j) { const f32x4 w = *((const GAS f32x4*)wnext + F.lane + 64 * j); const f32x4 v = x[j] * r2 * w; ho[64 * j] = pk4_fp8(v.x, v.y, v.z, v.w, (float)(1 << H8_SCL2)); } }
            else { GAS v2u* ho = (GAS v2u*)(Hout + (size_t)r * DM) + F.lane;
#pragma unroll
            for (int j = 0; j < 8; ++j) { const f32x4 w = *((const GAS f32x4*)wnext + F.lane + 64 * j); const f32x4 v = x[j] * r2 * w; v2u o; o.x = pk2(v.x, v.y); o.y = pk2(v.z, v.w); ho[64 * j] = o; } } }
        if (more) {
#pragma unroll
            for (int j = 0; j < 8; ++j) { x[j] = xn[j]; yb[j] = ybn[j]; } }
    }
}
__device__ __forceinline__ void row_first(const Frame& F, const float* Xin, bf16* Hout, const float* wnext) {
    const int gw = F.vcu * NWAVES + F.wave, NGW = F.G * NWAVES;
    for (int r = gw; r < S; r += NGW) {
        const GAS f32x4* xr = (const GAS f32x4*)(Xin + (size_t)r * DM) + F.lane;
        f32x4 x[8]; float s2 = 0.f;
#pragma unroll
        for (int j = 0; j < 8; ++j) { x[j] = xr[64 * j]; s2 += (x[j].x * x[j].x + x[j].y * x[j].y) + (x[j].z * x[j].z + x[j].w * x[j].w); }
        const float r2 = 1.f / sqrtf(wave_sum(s2) * (1.f / DM) + EPS);
        GAS v2u* ho = (GAS v2u*)(Hout + (size_t)r * DM) + F.lane;
#pragma unroll
        for (int j = 0; j < 8; ++j) { const f32x4 w = *((const GAS f32x4*)wnext + F.lane + 64 * j); const f32x4 v = x[j] * r2 * w; v2u o; o.x = pk2(v.x, v.y); o.y = pk2(v.z, v.w); ho[64 * j] = o; }
    }
}

__device__ __forceinline__ unsigned long long rt() { return __builtin_amdgcn_s_memrealtime(); }
#define IDLE_PULL(nwg_, slot_, ks_) do { const int c_ = BID(), g_ = GRD(); \
    if (g_ == 256) { PHASE_FRAME(); const int base_ = CONV_P0 + l * I_LAYER + (slot_) * CONV_SLOT, end_ = base_ + CONV_SLOT < I_ALL ? base_ + CONV_SLOT : I_ALL, mid_ = base_ + (ks_) * 1024 < end_ ? base_ + (ks_) * 1024 : end_; \
        LAS float* scr_ = (LAS float*)(F.lds + RING_OFF + F.wave * 16384); \
          \
        if (c_ >= 128) conv_range(CONV_INPUTS, ws, base_ + (c_ - 128) * NWAVES + F.wave, 1024, mid_, scr_, F.lane); \
        else conv_range(CONV_INPUTS, ws, mid_ + c_ * NWAVES + F.wave, 1024, end_, scr_, F.lane); } } while (0)
#define WSL() ({ GAS unsigned char* p_ = (GAS unsigned char*)args.ws; asm volatile("" : "+s"(p_)); (unsigned char*)p_; })
#define BID() ({ int b_ = (int)blockIdx.x; asm volatile("" : "+s"(b_)); b_; })
#define GRD() ({ int g_ = (int)gridDim.x; asm volatile("" : "+s"(g_)); g_; })
#define INP(i) ({ int i_ = (i); asm volatile("" : "+s"(i_)); (const float*)(const GAS float*)args.in[i_]; })
#define PHASE_FRAME() Frame F = F0; { asm volatile("" : "+s"(F.vcu), "+s"(F.G)); int t_ = threadIdx.x; asm volatile("" : "+v"(t_)); F.tid = t_; F.lane = t_ & 63; F.wave = __builtin_amdgcn_readfirstlane(t_ >> 6); }
typedef pg8::EpiSwiGLUI8<-1> EpiI8; typedef pg8::EpiSwiGLUI8<A8_SCL2> EpiI8o8;
typedef pg8::EpiBf16YT<A8_SCL2 + W8_SCL2> Epi8DN;
__global__ void __launch_bounds__(NWAVES * 64, 2) fwd(Args args) {
    extern __shared__ __attribute__((aligned(16))) unsigned char lds[];
    Frame F0;
    F0.lds = (LAS unsigned char*)lds;
    F0.MISC = (volatile LAS unsigned*)(F0.lds + MISC_OFF);
    F0.tid = threadIdx.x; F0.lane = F0.tid & 63; F0.wave = __builtin_amdgcn_readfirstlane(F0.tid >> 6);
    F0.G = gridDim.x; { const int bx = blockIdx.x; F0.vcu = (F0.G % 8 == 0) ? (bx % 8) * (F0.G / 8) + bx / 8 : bx; }
    F0.ctl = (gu32*)(args.ws + WS_CTL);
    for (int u = F0.tid; u < (LDS_BYTES - LDSCTL_OFF) / 4; u += NWAVES * 64) ((LAS unsigned*)(F0.lds + LDSCTL_OFF))[u] = 0u;
    __syncthreads();
    const int lo = args.ph_lo, hi = args.ph_hi;
    XcdBarrier bar; bar.bar = (unsigned*)(F0.ctl + CW_BAR); bar.x = 0; bar.st = nullptr;
    if (hi - lo > 1) bar = xcd_barrier_post((unsigned*)(F0.ctl + CW_BAR), F0.MISC + 8);
    int ph = 0;
#define PH_ON (lo <= ph && ph < hi)
#define PH_END do { if (lo <= ph && ph + 1 < hi) { XcdBarrier b2_ = bar; { GAS unsigned* bp_ = (GAS unsigned*)bar.bar; asm volatile("" : "+s"(bp_), "+s"(b2_.x)); b2_.bar = (unsigned*)bp_; } xcd_barrier(b2_); } ++ph; } while (0)

    if (PH_ON) {
        PHASE_FRAME(); unsigned char* ws = WSL();
        LAS float* scr = (LAS float*)(F.lds + RING_OFF + F.wave * 16384);
        const int gw = F.vcu * NWAVES + F.wave, NGW = F.G * NWAVES;
        {
            float* wsc = (float*)(ws + WS_TAB + TAB_WSC); LAS float* red = (LAS float*)(F.lds + RING_OFF);
            for (int j = (F.G == 256) ? F.vcu : 0; j < NL * 4; j += (F.G == 256) ? F.G : 1) { const int lj = j >> 2, kd = j & 3;
                const float* W = (kd == 0 ? INP(3) : kd == 1 ? INP(4) : kd == 2 ? INP(6) : INP(7)) + (size_t)lj * DM * DFF;
                float ss = 0.f, am = 0.f;
                for (int i = 0; i < 16; ++i) { const float w = W[(size_t)(F.tid * 16 + i) * 1407]; ss += w * w; am = fmaxf(am, fabsf(w)); }
                ss = wave_sum(ss); am = wave_max(am);
                __syncthreads(); if (F.lane == 0) { red[F.wave] = ss; red[8 + F.wave] = am; } __syncthreads();
                if (F.tid == 0) { float s2 = 0.f, a2 = 0.f; for (int w = 0; w < NWAVES; ++w) { s2 += red[w]; a2 = fmaxf(a2, red[8 + w]); }
                    (void)a2; wsc[j] = fmaxf(4.0f * sqrtf(s2 * (1.f / 8192.f)), 1e-20f) * (1.f / 127.f); }
            }
            VM_WAIT(); __syncthreads();
        }
        conv_range(CONV_INPUTS, ws, gw, NGW, (F.G == 256) ? CONV_P0 : I_LAYER, scr, F.lane);
        {
            float* rtab = (float*)(ws + WS_TAB + TAB_RT); float* ctab = (float*)(ws + WS_TAB + TAB_CT); float* tbt = (float*)(ws + WS_TAB + TAB_TB); float* lbs = (float*)(ws + WS_TAB + TAB_LB);
            const float* hg_lb = INP(12); const float* rel_b = INP(14);
            const int gid = F.vcu * (NWAVES * 64) + F.tid;
            if (gid < 3072) {
                const int pos = gid >> 4, j = gid & 15; const int p = pos < 128 ? pos : pos - 128;
                const float inv = 1.0f / exp2f((float)j * (1.0f / 16.0f) * 13.287712379549449f);
                const float ang = (float)p * inv;
                double rev = (double)ang * 0.15915494309189535; rev -= rint(rev); const float rv = (float)rev;
                float* dst = (pos < 128 ? rtab + pos * 32 : ctab + p * 32) + 2 * j;
                dst[0] = __builtin_amdgcn_cosf(rv); dst[1] = __builtin_amdgcn_sinf(rv);
            }
            if (gid < 12 * 257) { const int h = gid / 257, r = gid - h * 257; tbt[h * 260 + r] = rel_b[t5_bucket(r - 128) * 12 + h] * pg8::LOG2E; }
            if (gid < 1024) {
                float v[NL], mx = -INFINITY;
#pragma unroll
                for (int l = 0; l < NL; ++l) { v[l] = hg_lb[l * 1024 + gid]; mx = fmaxf(mx, v[l]); }
                float sum = 0.f;
#pragma unroll
                for (int l = 0; l < NL; ++l) { v[l] = __expf(v[l] - mx); sum += v[l]; }
                float c = 0.f; lbs[gid] = 0.f;
#pragma unroll
                for (int l = 1; l < NL; ++l) { c += v[l] / sum; lbs[l * 1024 + gid] = c; }
            }
        }
        row_first(F, INP(0), (bf16*)(ws + WS_H), INP(9));
    }
    PH_END;

    for (int l = 0; l < NL; ++l) {
        if (PH_ON) { unsigned char* ws = WSL(); const unsigned char* wl = ws + WS_W + (size_t)l * W_LAYER;
            pg8::StaticOrder so; so.init(S, NGU, GRD(), BID(), ((I8_GU1_MASK >> l) & 1u) ? 8 : pg8::WGM);
            if ((I8_GU1_MASK >> l) & 1u) { pg8::Gemm g{(const bf16*)(ws + WS_H), (const bf16*)(wl + W_GU1), S, NGU, DM / 2};
                const float* hs = (const float*)(ws + WS_TAB + TAB_HS); const float* wsc = (const float*)(ws + WS_TAB + TAB_WSC) + l * 4 + 0;
                if ((F8_DN1_MASK >> l) & 1u) { EpiI8o8 E{(bf16*)(ws + WS_ACT), DFF, hs, wsc[0], wsc[1]}; pg8::gemm_phase<EpiI8o8, pg8::StaticOrder, true, true, 2>(F0.lds + RING_OFF, g, so, E); }
                else { EpiI8 E{(bf16*)(ws + WS_ACT), DFF, hs, wsc[0], wsc[1]}; pg8::gemm_phase<EpiI8, pg8::StaticOrder, true, true, 2>(F0.lds + RING_OFF, g, so, E); } }
            else { pg8::Gemm g{(const bf16*)(ws + WS_H), (const bf16*)(wl + W_GU1), S, NGU, DM};
                pg8::EpiSwiGLU E{(bf16*)(ws + WS_ACT), DFF}; pg8::gemm_phase<pg8::EpiSwiGLU, pg8::StaticOrder, true, true>(F0.lds + RING_OFF, g, so, E); }
            IDLE_PULL(0, 0, ((I8_GU1_MASK >> l) & 1u) ? 11 : CONV_K); }
        PH_END;
        if (PH_ON) { unsigned char* ws = WSL(); const unsigned char* wl = ws + WS_W + (size_t)l * W_LAYER;
            pg8::StaticOrder so; so.init(S, DM, GRD(), BID());
            if ((F8_DN1_MASK >> l) & 1u) { pg8::Gemm g{(const bf16*)(ws + WS_ACT), (const bf16*)(wl + W_DN1), S, DM, DFF / 2};
                Epi8DN E{(bf16*)(ws + WS_Y), DM}; pg8::gemm_phase<Epi8DN, pg8::StaticOrder, false, true, 1>(F0.lds + RING_OFF, g, so, E); }
            else { pg8::Gemm g{(const bf16*)(ws + WS_ACT), (const bf16*)(wl + W_DN1), S, DM, DFF};
                pg8::EpiBf16Y E{(bf16*)(ws + WS_Y), DM}; pg8::gemm_phase<pg8::EpiBf16Y, pg8::StaticOrder, false, true>(F0.lds + RING_OFF, g, so, E); } }
        PH_END;
        if (PH_ON) { PHASE_FRAME(); unsigned char* ws = WSL(); const float* nw = INP(9) + (size_t)l * 6 * DM;
            if (l == 0) row_phase<true, false>(F, INP(0), (const bf16*)(ws + WS_Y), ws + WS_X, (bf16*)(ws + WS_H), nw + 1 * DM, nw + 2 * DM, 0.5f, F.vcu * NWAVES + F.wave, F.G * NWAVES);
            else row_phase<false, false>(F, ws + WS_X, (const bf16*)(ws + WS_Y), ws + WS_X, (bf16*)(ws + WS_H), nw + 1 * DM, nw + 2 * DM, 0.5f, F.vcu * NWAVES + F.wave, F.G * NWAVES); }
        PH_END;
        if (PH_ON) { unsigned char* ws = WSL(); const unsigned char* wl = ws + WS_W + (size_t)l * W_LAYER;
            pg8::Gemm g{(const bf16*)(ws + WS_H), (const bf16*)(wl + W_WIN), S, DIN, DM}; pg8::StaticOrder so; so.init(S, DIN, GRD(), BID());
            unsigned char* Bb = ws + WS_B;
            pg8::EpiWin E{(bf16*)(ws + WS_AQ), (bf16*)(ws + WS_AK), (bf16*)(ws + WS_AV), (bf16*)(ws + WS_CQ), (bf16*)(ws + WS_CK), (bf16*)(ws + WS_CV),
                          Bb,
                          (const float*)(ws + WS_TAB + TAB_LB) + l * 1024, INP(11) + l * 128, (const float*)(ws + WS_TAB + TAB_RT), (const float*)(ws + WS_TAB + TAB_CT)};
            pg8::gemm_phase<pg8::EpiWin, pg8::StaticOrder, true, true>(F0.lds + RING_OFF, g, so, E); IDLE_PULL(0, 1, CONV_K); }
        PH_END;
        if (PH_ON) {
            { unsigned char* ws = WSL(); unsigned char* Bb = ws + WS_B;
              hg::pass1(GRD(), BID(), (const _Float16*)(Bb + WB_FF), (const _Float16*)(Bb + WB_FB), (const bf16*)(Bb + WB_BI), (bf16*)(Bb + WB_P), (float*)(ws + WS_DG), F0.lds + RING_OFF); }
            { unsigned char* ws = WSL();
              const attn_body::bf16* CQ = (const attn_body::bf16*)(ws + WS_CQ); const attn_body::bf16* CK = (const attn_body::bf16*)(ws + WS_CK); const attn_body::bf16* CV = (const attn_body::bf16*)(ws + WS_CV);
              attn_body::bf16* MIXo = (attn_body::bf16*)(ws + WS_MIX);
              const int gA = GRD(); const int bA = (gA == 256) ? ({ int v_ = F0.vcu; asm volatile("" : "+s"(v_)); v_; }) : BID();
              if (gA == 256) {
                { const int u = bA, h = u >> 5, qb = u & 31, kvh = h / 3;
                  attn_body::attn_unit<8, 768, 256, 2048, 0>(qb * 256, S / 64, CQ + h * 64, CK + kvh * 64, CV + kvh * 64, MIXo + 1280 + h * 64, (char*)lds + RING_OFF); }
                { const int su = bA >> 1, half = bA & 1, u = 256 + su, h = u >> 5, qb = u & 31, kvh = h / 3, kt0 = half ? 60 : 0, nt = half ? 68 : 60;
                  float* po = (float*)(ws + WS_PO) + ((size_t)su * 2 + half) * 16384; float* pml = (float*)(ws + WS_PML) + ((size_t)su * 2 + half) * 512;
                  attn_body::attn_unit<8, 768, 256, 2048, 0, true>(qb * 256, nt, CQ + h * 64, CK + kvh * 64 + (size_t)kt0 * 64 * 256, CV + kvh * 64 + (size_t)kt0 * 64 * 256, MIXo, (char*)lds + RING_OFF,
                                                                  nullptr, 0.f, 0, po, pml); }
              } else {
                for (int u = bA; u < 384; u += gA) { const int h = u >> 5, qb = u & 31, kvh = h / 3;
                  attn_body::attn_unit<8, 768, 256, 2048, 0>(qb * 256, S / 64, CQ + h * 64, CK + kvh * 64, CV + kvh * 64, MIXo + 1280 + h * 64, (char*)lds + RING_OFF); }
              } }
            { unsigned char* ws = WSL();
              const attn_body::bf16* AQp = (const attn_body::bf16*)(ws + WS_AQ); const attn_body::bf16* AKp = (const attn_body::bf16*)(ws + WS_AK); const attn_body::bf16* AVp = (const attn_body::bf16*)(ws + WS_AV);
              attn_body::bf16* MIXo = (attn_body::bf16*)(ws + WS_MIX); const float* tbp = (const float*)(ws + WS_TAB + TAB_TB); const float* skp = INP(10) + l * 12;
              const int gB = GRD(); const int vB = (gB == 256) ? ({ int v_ = F0.vcu; asm volatile("" : "+s"(v_)); v_; }) : BID();
              const int nun = (gB == 256) ? ((vB & 1) ? 1 : 2) : (vB < 384 ? (384 - vB + gB - 1) / gB : 0);
              for (int ui = 0; ui < nun; ++ui) { const int u = (gB == 256) ? (ui ? 256 + (vB >> 1) : vB) : vB + ui * gB;
                const int h = u >> 5, qb = u & 31, kvh = h / 3;
                const int t_lo = qb * 4 - 2 < 0 ? 0 : qb * 4 - 2, t_hi = qb * 4 + 6 > S / 64 ? S / 64 : qb * 4 + 6;
                attn_body::attn_unit<8, 768, 256, 2048, 1>(qb * 256, t_hi - t_lo, AQp + h * 64, AKp + kvh * 64 + (size_t)t_lo * 64 * 256, AVp + kvh * 64 + (size_t)t_lo * 64 * 256, MIXo + h * 64, (char*)lds + RING_OFF,
                                                           tbp + h * 260, skp[h] * pg8::LOG2E, t_lo * 64); } }
        }
        PH_END;
        if (PH_ON) { unsigned char* ws = WSL(); hg::scan(GRD(), ({ int v_ = F0.vcu; asm volatile("" : "+s"(v_)); v_; }), (const bf16*)(ws + WS_B + WB_P), (const float*)(ws + WS_DG), (bf16*)(ws + WS_SS)); }
        PH_END;
        if (PH_ON) { unsigned char* ws = WSL(); unsigned char* Bb = ws + WS_B;
            if (GRD() == 256) {
                int t_ = threadIdx.x; asm volatile("" : "+v"(t_)); const int bM = BID(), su = bM >> 1, u = 256 + su, h = u >> 5, qb = u & 31;
                const int row = 128 * (bM & 1) + (t_ >> 2), c0 = (t_ & 3) * 16;
                const float* p0 = (const float*)(ws + WS_PO) + ((size_t)su * 2) * 16384 + row * 64 + c0; const float* p1 = p0 + 16384;
                const float* ml0 = (const float*)(ws + WS_PML) + ((size_t)su * 2) * 512 + row * 2; const float* ml1 = ml0 + 512;
                const float m0 = ml0[0], l0 = ml0[1], m1 = ml1[0], l1 = ml1[1], mm = fmaxf(m0, m1), w0 = __builtin_amdgcn_exp2f(m0 - mm), w1 = __builtin_amdgcn_exp2f(m1 - mm);
                const float inv = 1.0f / (l0 * w0 + l1 * w1), a0 = w0 * inv, a1 = w1 * inv;
                bf16* op = (bf16*)(ws + WS_MIX) + (size_t)(qb * 256 + row) * 2048 + 1280 + h * 64 + c0;
#pragma unroll
                for (int j = 0; j < 2; ++j) { const f32x4 x0 = *(const f32x4*)(p0 + 8 * j), x1 = *(const f32x4*)(p0 + 8 * j + 4), y0 = *(const f32x4*)(p1 + 8 * j), y1 = *(const f32x4*)(p1 + 8 * j + 4);
                    const f32x4 r0 = x0 * a0 + y0 * a1, r1 = x1 * a0 + y1 * a1; v4u o; o.x = pk2(r0.x, r0.y); o.y = pk2(r0.z, r0.w); o.z = pk2(r1.x, r1.y); o.w = pk2(r1.z, r1.w);
                    *(v4u*)(op + 8 * j) = o; }
            }
            hg::pass2(GRD(), BID(), (const bf16*)(Bb + WB_BQ), (const _Float16*)(Bb + WB_FF), (const _Float16*)(Bb + WB_FB), (const bf16*)(Bb + WB_BI), (const bf16*)(Bb + WB_SG), (const bf16*)(ws + WS_SS), INP(13) + l * 128, (bf16*)(ws + WS_MIX), F0.lds + RING_OFF); }
        PH_END;
        if (PH_ON) { unsigned char* ws = WSL(); const unsigned char* wl = ws + WS_W + (size_t)l * W_LAYER;
            pg8::Gemm g{(const bf16*)(ws + WS_MIX), (const bf16*)(wl + W_WOUT), S, DM, DM}; pg8::StaticOrder so; so.init(S, DM, GRD(), BID());
            pg8::EpiBf16Y E{(bf16*)(ws + WS_Y), DM}; pg8::gemm_phase<pg8::EpiBf16Y, pg8::StaticOrder, false, true>(F0.lds + RING_OFF, g, so, E); }
        PH_END;
        if (PH_ON) { PHASE_FRAME(); unsigned char* ws = WSL(); const float* nw = INP(9) + (size_t)l * 6 * DM;
            if ((I8_GU2_MASK >> l) & 1u) row_phase<false, false, 2>(F, ws + WS_X, (const bf16*)(ws + WS_Y), ws + WS_X, (bf16*)(ws + WS_H), nw + 3 * DM, nw + 4 * DM, 1.0f, F.vcu * NWAVES + F.wave, F.G * NWAVES, (float*)(ws + WS_TAB + TAB_HS));
            else row_phase<false, false, 0>(F, ws + WS_X, (const bf16*)(ws + WS_Y), ws + WS_X, (bf16*)(ws + WS_H), nw + 3 * DM, nw + 4 * DM, 1.0f, F.vcu * NWAVES + F.wave, F.G * NWAVES); }
        PH_END;
        if (PH_ON) { unsigned char* ws = WSL(); const unsigned char* wl = ws + WS_W + (size_t)l * W_LAYER;
            pg8::StaticOrder so; so.init(S, NGU, GRD(), BID(), ((I8_GU2_MASK >> l) & 1u) ? 8 : pg8::WGM);
            if ((I8_GU2_MASK >> l) & 1u) { pg8::Gemm g{(const bf16*)(ws + WS_H), (const bf16*)(wl + W_GU2), S, NGU, DM / 2};
                const float* hs = (const float*)(ws + WS_TAB + TAB_HS); const float* wsc = (const float*)(ws + WS_TAB + TAB_WSC) + l * 4 + 2;
                if ((F8_DN2_MASK >> l) & 1u) { EpiI8o8 E{(bf16*)(ws + WS_ACT), DFF, hs, wsc[0], wsc[1]}; pg8::gemm_phase<EpiI8o8, pg8::StaticOrder, true, true, 2>(F0.lds + RING_OFF, g, so, E); }
                else { EpiI8 E{(bf16*)(ws + WS_ACT), DFF, hs, wsc[0], wsc[1]}; pg8::gemm_phase<EpiI8, pg8::StaticOrder, true, true, 2>(F0.lds + RING_OFF, g, so, E); } }
            else { pg8::Gemm g{(const bf16*)(ws + WS_H), (const bf16*)(wl + W_GU2), S, NGU, DM};
                pg8::EpiSwiGLU E{(bf16*)(ws + WS_ACT), DFF}; pg8::gemm_phase<pg8::EpiSwiGLU, pg8::StaticOrder, true, true>(F0.lds + RING_OFF, g, so, E); }
            IDLE_PULL(0, 2, ((I8_GU2_MASK >> l) & 1u) ? 11 : CONV_K); }
        PH_END;
        if (PH_ON) { unsigned char* ws = WSL(); const unsigned char* wl = ws + WS_W + (size_t)l * W_LAYER;
            pg8::StaticOrder so; so.init(S, DM, GRD(), BID());
            if ((F8_DN2_MASK >> l) & 1u) { pg8::Gemm g{(const bf16*)(ws + WS_ACT), (const bf16*)(wl + W_DN2), S, DM, DFF / 2};
                Epi8DN E{(bf16*)(ws + WS_Y), DM}; pg8::gemm_phase<Epi8DN, pg8::StaticOrder, false, true, 1>(F0.lds + RING_OFF, g, so, E); }
            else { pg8::Gemm g{(const bf16*)(ws + WS_ACT), (const bf16*)(wl + W_DN2), S, DM, DFF};
                pg8::EpiBf16Y E{(bf16*)(ws + WS_Y), DM}; pg8::gemm_phase<pg8::EpiBf16Y, pg8::StaticOrder, false, true>(F0.lds + RING_OFF, g, so, E); } }
        PH_END;
        if (PH_ON) { PHASE_FRAME(); unsigned char* ws = WSL(); const float* nw = INP(9) + (size_t)l * 6 * DM; const bool lastl = (l == NL - 1);
            { const int g_ = GRD(); LAS float* scr_ = (LAS float*)(F.lds + RING_OFF + F.wave * 16384);
                if (g_ == 256) { const int base_ = CONV_P0 + l * I_LAYER + 3 * CONV_SLOT, end_ = base_ + CONV_R < I_ALL ? base_ + CONV_R : I_ALL;
                    conv_range(CONV_INPUTS, ws, base_ + F.vcu * NWAVES + F.wave, F.G * NWAVES, end_, scr_, F.lane); }
                else if (!lastl) conv_range(CONV_INPUTS, ws, (l + 1) * I_LAYER + F.vcu * NWAVES + F.wave, F.G * NWAVES, (l + 2) * I_LAYER, scr_, F.lane); }
            if (lastl) row_phase<false, true>(F, ws + WS_X, (const bf16*)(ws + WS_Y), (float*)(GAS float*)args.out, (bf16*)nullptr, nw + 5 * DM, nw + 6 * DM, 0.5f, F.vcu * NWAVES + F.wave, F.G * NWAVES);
            else if ((I8_GU1_MASK >> (l + 1)) & 1u) row_phase<false, false, 2>(F, ws + WS_X, (const bf16*)(ws + WS_Y), ws + WS_X, (bf16*)(ws + WS_H), nw + 5 * DM, nw + 6 * DM, 0.5f, F.vcu * NWAVES + F.wave, F.G * NWAVES, (float*)(ws + WS_TAB + TAB_HS));
            else row_phase<false, false>(F, ws + WS_X, (const bf16*)(ws + WS_Y), ws + WS_X, (bf16*)(ws + WS_H), nw + 5 * DM, nw + 6 * DM, 0.5f, F.vcu * NWAVES + F.wave, F.G * NWAVES); }
        PH_END;
    }
#undef PH_ON
#undef PH_END
}
constexpr int N_PHASES = 1 + NL * 12;

extern "C" void kernel_launch(void* const* d_in, const int* in_sizes, int n_in, void* d_out, int out_size, void* d_ws, size_t ws_size, hipStream_t stream) {
    static int grid = 0;
    if (grid == 0) {
        if (n_in != 15 || in_sizes[0] != S * DM || out_size != S * DM || ws_size < WS_END) { fprintf(stderr, "kernel_launch: unexpected shapes / workspace (n_in %d, in0 %d, out %d, ws %zu < %zu); nothing launched\n", n_in, n_in > 0 ? in_sizes[0] : -1, out_size, ws_size, (size_t)WS_END); grid = -1; return; }
        int dev = 0, cus = 0, per_cu = 0;
        if (hipGetDevice(&dev) != hipSuccess || hipDeviceGetAttribute(&cus, hipDeviceAttributeMultiprocessorCount, dev) != hipSuccess) { grid = -1; return; }
        if (hipFuncSetAttribute((const void*)fwd, hipFuncAttributeMaxDynamicSharedMemorySize, LDS_BYTES) != hipSuccess) { fprintf(stderr, "kernel_launch: hipFuncSetAttribute failed\n"); grid = -1; return; }
        if (hipOccupancyMaxActiveBlocksPerMultiprocessor(&per_cu, (const void*)fwd, NWAVES * 64, LDS_BYTES) != hipSuccess || per_cu < 1)
            fprintf(stderr, "kernel_launch: note: occupancy query reports %d workgroups per CU\n", per_cu);
        (void)hipGetLastError();
        grid = cus;
    }
    if (grid < 0) return;
    if (hipMemsetAsync((char*)d_ws + WS_CTL, 0, CTL_ZERO_BYTES, stream) != hipSuccess) { fprintf(stderr, "kernel_launch: memset failed\n"); return; }
    Args a{};
    for (int i = 0; i < 15; ++i) a.in[i] = (const float*)d_in[i];
    a.out = (float*)d_out; a.ws = (unsigned char*)d_ws;
#if MK_SPLIT
    for (int p = 0; p < N_PHASES; ++p) { a.ph_lo = p; a.ph_hi = p + 1; hipLaunchKernelGGL(fwd, dim3(grid), dim3(NWAVES * 64), LDS_BYTES, stream, a); }
#else
    a.ph_lo = 0; a.ph_hi = N_PHASES;
    hipLaunchKernelGGL(fwd, dim3(grid), dim3(NWAVES * 64), LDS_BYTES, stream, a);
#endif
    const hipError_t le = hipPeekAtLastError();
    if (le != hipSuccess) fprintf(stderr, "kernel_launch: launch failed: %s\n", hipGetErrorName(le));
}
```
